# Optimizing an MI355X kernel written in HIP

```python
import jax, jax.numpy as jnp
from jax import lax
import numpy as np

D_MODEL = 2048
BATCH = 2
SEQ = 4096
DEPTH = 1
DEC_BATCH = 8
DEC_SEQ = 1
PAST_LEN = 16384
PAGE_SIZE = 128

N_HEADS = 8
N_KV_HEADS = 2
HEAD_DIM = 128
Q_PER_KV = N_HEADS // N_KV_HEADS
ATTN_WIDTH = N_HEADS * HEAD_DIM
KV_WIDTH = N_KV_HEADS * HEAD_DIM
IDX_HEADS = 16
IDX_DIM = 128
TOPK_MAX = 256
Q_BLOCK = 128
GMLP_WIDTH = 1024
GMLP_GROUPS = 8
GMLP_GROUP_DIM = GMLP_WIDTH // GMLP_GROUPS
CHUNK = 128
RMS_EPS = 1e-6
LN_EPS = 1e-5
SPLIT_SIZES = (ATTN_WIDTH, KV_WIDTH, KV_WIDTH, IDX_HEADS * IDX_DIM, IDX_HEADS, IDX_DIM, ATTN_WIDTH,
               GMLP_WIDTH, GMLP_WIDTH, GMLP_WIDTH, D_MODEL, D_MODEL)
IN_WIDTH = sum(SPLIT_SIZES)

kernel_name = "dsa_gmlp_gated_hybrid_step"


def rmsnorm(x, g):
    x32 = x.astype(jnp.float32)
    y = x32 * lax.rsqrt(jnp.mean(x32 * x32, axis=-1, keepdims=True) + RMS_EPS)
    return (y * g.astype(jnp.float32)).astype(x.dtype)


def layernorm(x, g, b):
    x32 = x.astype(jnp.float32)
    mu = jnp.mean(x32, axis=-1, keepdims=True)
    xc = x32 - mu
    y = xc * lax.rsqrt(jnp.mean(xc * xc, axis=-1, keepdims=True) + LN_EPS)
    return (y * g.astype(jnp.float32) + b.astype(jnp.float32)).astype(x.dtype)


def in_projection(x, norm_g, w_in):
    h = rmsnorm(x, norm_g) @ w_in
    offs = [int(o) for o in np.cumsum(SPLIT_SIZES)[:-1]]
    return jnp.split(h, offs, axis=-1)


def attn_heads(q, k, v, q_idx, w_idx):
    B, T = q.shape[:2]
    q = q.reshape(B, T, N_KV_HEADS, Q_PER_KV, HEAD_DIM)
    k = k.reshape(B, T, N_KV_HEADS, HEAD_DIM)
    v = v.reshape(B, T, N_KV_HEADS, HEAD_DIM)
    q_idx = q_idx.reshape(B, T, IDX_HEADS, IDX_DIM)
    w_idx = w_idx * (IDX_HEADS ** -0.5)
    return q, k, v, q_idx, w_idx


def dsa_select(q_idx, w_idx, k_idx, q_pos, top_k):
    s = jnp.einsum('bthd,bsd->bths', q_idx, k_idx, preferred_element_type=jnp.float32) * (IDX_DIM ** -0.5)
    score = jnp.einsum('bths,bth->bts', jax.nn.relu(s), w_idx.astype(jnp.float32))
    L = k_idx.shape[1]
    admissible = jnp.arange(L, dtype=jnp.int32)[None, :] <= q_pos[:, None]
    score = jnp.where(admissible[None], score, -jnp.inf)
    _, idx = lax.top_k(score, top_k)
    valid = idx <= q_pos[None, :, None]
    return idx, valid


def sparse_attend(q, k_sel, v_sel, valid):
    B, T = q.shape[:2]
    s = jnp.einsum('btkgd,btskd->btkgs', q, k_sel, preferred_element_type=jnp.float32) * (HEAD_DIM ** -0.5)
    s = jnp.where(valid[:, :, None, None, :], s, -jnp.inf)
    p = jax.nn.softmax(s, axis=-1).astype(v_sel.dtype)
    o = jnp.einsum('btkgs,btskd->btkgd', p, v_sel)
    return o.reshape(B, T, ATTN_WIDTH)


def prompt_attention(q, k, v, q_idx, w_idx, k_idx):
    B, S = q.shape[:2]
    top_k = min(TOPK_MAX, S // 4)
    nb = S // Q_BLOCK

    def to_blocks(a):
        return jnp.moveaxis(a.reshape(B, nb, Q_BLOCK, *a.shape[2:]), 1, 0)

    def one_block(args):
        qb, qib, wb, start = args
        pos = start + jnp.arange(Q_BLOCK, dtype=jnp.int32)
        idx, valid = dsa_select(qib, wb, k_idx, pos, top_k)
        k_sel = jax.vmap(lambda kb, ib: kb[ib])(k, idx)
        v_sel = jax.vmap(lambda vb, ib: vb[ib])(v, idx)
        return sparse_attend(qb, k_sel, v_sel, valid)

    starts = jnp.arange(nb, dtype=jnp.int32) * Q_BLOCK
    out = lax.map(one_block, (to_blocks(q), to_blocks(q_idx), to_blocks(w_idx), starts))
    return jnp.moveaxis(out, 0, 1).reshape(B, S, ATTN_WIDTH)


def gather_rows(pool, new, idx, page_table):
    DB = idx.shape[0]
    past = page_table.shape[1] * PAGE_SIZE
    bidx = jnp.arange(DB)[:, None, None]
    pidx = jnp.minimum(idx, past - 1)
    phys = page_table[bidx, pidx // PAGE_SIZE]
    past_rows = pool[phys, pidx % PAGE_SIZE]
    new_rows = new[bidx, jnp.clip(idx - past, 0, new.shape[1] - 1)]
    is_past = (idx < past).reshape(idx.shape + (1,) * (pool.ndim - 2))
    return jnp.where(is_past, past_rows, new_rows)


def sample_attention(q, k_new, v_new, q_idx, w_idx, k_idx_new, pool_k, pool_v, pool_k_idx, page_table):
    DB, T = q.shape[:2]
    past = page_table.shape[1] * PAGE_SIZE
    k_idx_past = pool_k_idx[page_table].reshape(DB, past, IDX_DIM)
    k_idx_all = jnp.concatenate([k_idx_past, k_idx_new.astype(k_idx_past.dtype)], axis=1)
    top_k = min(TOPK_MAX, (past + T) // 4)
    pos = past + jnp.arange(T, dtype=jnp.int32)
    idx, valid = dsa_select(q_idx, w_idx, k_idx_all, pos, top_k)
    k_sel = gather_rows(pool_k, k_new.astype(pool_k.dtype), idx, page_table)
    v_sel = gather_rows(pool_v, v_new.astype(pool_v.dtype), idx, page_table)
    return sparse_attend(q, k_sel, v_sel, valid)


def gmlp_mix(u, v, ln_g, ln_b, w_s, b_s):
    B, T, W = u.shape
    u = jax.nn.gelu(u, approximate=False)
    vn = layernorm(jax.nn.gelu(v, approximate=False), ln_g, ln_b)
    c = min(T, CHUNK)
    vc = vn.reshape(B, T // c, c, GMLP_GROUPS, GMLP_GROUP_DIM)
    wm = jnp.tril(w_s[:, :c, :c])
    mixed = jnp.einsum('gts,bcsgd->bctgd', wm, vc) + b_s[:, :c].T[None, None, :, :, None]
    return u * mixed.reshape(B, T, W), vn


def merge_out(x, o_a, z_a, o_b, z_b, g_a, g_b, w_proj_a, w_proj_b, w_out):
    y_a = (o_a * jax.nn.silu(z_a)) @ w_proj_a
    y_b = (o_b * jax.nn.silu(z_b)) @ w_proj_b
    mix = jax.nn.sigmoid(g_a) * y_a + jax.nn.sigmoid(g_b) * y_b
    return x + mix @ w_out


def setup_inputs(seed: int = 0) -> dict:
    key = jax.random.key(seed)
    ks = jax.random.split(key, 20)
    n_pages = PAST_LEN // PAGE_SIZE
    used = DEC_BATCH * n_pages
    n_pool = used + (used + 3) // 4
    f = jnp.float32
    x_prompt = jax.random.normal(ks[0], (BATCH, SEQ, D_MODEL), f)
    x_sample = jax.random.normal(ks[1], (DEC_BATCH, DEC_SEQ, D_MODEL), f)
    cache_k = jax.random.normal(ks[2], (DEPTH, n_pool, PAGE_SIZE, N_KV_HEADS, HEAD_DIM), f)
    cache_v = jax.random.normal(ks[3], (DEPTH, n_pool, PAGE_SIZE, N_KV_HEADS, HEAD_DIM), f)
    cache_k_idx = jax.random.normal(ks[4], (DEPTH, n_pool, PAGE_SIZE, IDX_DIM), f)
    page_table = jax.random.permutation(ks[5], n_pool)[:used].reshape(DEC_BATCH, n_pages).astype(jnp.int32)
    norm_in_g = 1.0 + 0.02 * jax.random.normal(ks[6], (DEPTH, D_MODEL), f)
    w_in = jax.random.normal(ks[7], (DEPTH, D_MODEL, IN_WIDTH), f) * D_MODEL ** -0.5
    w_proj_a = jax.random.normal(ks[8], (DEPTH, ATTN_WIDTH, D_MODEL), f) * ATTN_WIDTH ** -0.5
    w_proj_b = jax.random.normal(ks[9], (DEPTH, GMLP_WIDTH, D_MODEL), f) * GMLP_WIDTH ** -0.5
    w_out = jax.random.normal(ks[10], (DEPTH, D_MODEL, D_MODEL), f) * D_MODEL ** -0.5
    ln_g = 1.0 + 0.02 * jax.random.normal(ks[11], (DEPTH, GMLP_WIDTH), f)
    ln_b = 0.02 * jax.random.normal(ks[12], (DEPTH, GMLP_WIDTH), f)
    w_spatial = jax.random.normal(ks[13], (DEPTH, GMLP_GROUPS, CHUNK, CHUNK), f) * CHUNK ** -0.5
    b_spatial = 1.0 + 0.01 * jax.random.normal(ks[14], (DEPTH, GMLP_GROUPS, CHUNK), f)
    norm_f_g = 1.0 + 0.02 * jax.random.normal(ks[15], (D_MODEL,), f)
    return {"x_prompt": x_prompt, "x_sample": x_sample, "cache_k": cache_k, "cache_v": cache_v,
            "cache_k_idx": cache_k_idx, "page_table": page_table, "norm_in_g": norm_in_g, "w_in": w_in,
            "w_proj_a": w_proj_a, "w_proj_b": w_proj_b, "w_out": w_out, "ln_g": ln_g, "ln_b": ln_b,
            "w_spatial": w_spatial, "b_spatial": b_spatial, "norm_f_g": norm_f_g}


def reference(x_prompt, x_sample, cache_k, cache_v, cache_k_idx, page_table, norm_in_g, w_in,
              w_proj_a, w_proj_b, w_out, ln_g, ln_b, w_spatial, b_spatial, norm_f_g):
    xp, xs = x_prompt, x_sample
    kp_l, vp_l, kip_l, ks_l, vs_l, kis_l, gv_l = [], [], [], [], [], [], []
    for l in range(DEPTH):
        q, k, v, qi, wi, ki, za, u, vb, zb, ga, gb = in_projection(xp, norm_in_g[l], w_in[l])
        q, k, v, qi, wi = attn_heads(q, k, v, qi, wi)
        o_a = prompt_attention(q, k, v, qi, wi, ki)
        o_b, _ = gmlp_mix(u, vb, ln_g[l], ln_b[l], w_spatial[l], b_spatial[l])
        xp = merge_out(xp, o_a, za, o_b, zb, ga, gb, w_proj_a[l], w_proj_b[l], w_out[l])
        kp_l.append(k)
        vp_l.append(v)
        kip_l.append(ki)
        q, k, v, qi, wi, ki, za, u, vb, zb, ga, gb = in_projection(xs, norm_in_g[l], w_in[l])
        q, k, v, qi, wi = attn_heads(q, k, v, qi, wi)
        o_a = sample_attention(q, k, v, qi, wi, ki, cache_k[l], cache_v[l], cache_k_idx[l], page_table)
        o_b, vn = gmlp_mix(u, vb, ln_g[l], ln_b[l], w_spatial[l], b_spatial[l])
        xs = merge_out(xs, o_a, za, o_b, zb, ga, gb, w_proj_a[l], w_proj_b[l], w_out[l])
        ks_l.append(k)
        vs_l.append(v)
        kis_l.append(ki)
        gv_l.append(vn)
    y_prompt = rmsnorm(xp, norm_f_g)
    y_sample = rmsnorm(xs, norm_f_g)
    new_k_prompt = jnp.stack(kp_l)
    new_v_prompt = jnp.stack(vp_l)
    new_k_idx_prompt = jnp.stack(kip_l)
    new_k_sample = jnp.stack(ks_l)
    new_v_sample = jnp.stack(vs_l)
    new_k_idx_sample = jnp.stack(kis_l)
    new_gmlp_v_sample = jnp.stack(gv_l)
    return (y_prompt, y_sample, new_k_prompt, new_v_prompt, new_k_idx_prompt,
            new_k_sample, new_v_sample, new_k_idx_sample, new_gmlp_v_sample)
```

```cpp
#include <hip/hip_runtime.h>
#include <cstdio>
#include <cstdint>
#include <cmath>

#ifndef MK_N_LAUNCHES
#define MK_N_LAUNCHES 7
#endif

constexpr int DM = 2048, SEQ = 4096, NBATCH = 2, MP = NBATCH * SEQ, NS = 8, PAST = 16384, NPAGES = 128, PAGE = 128;
constexpr int LDH = 12032;
constexpr int HC_Q = 0, HC_K = 1024, HC_V = 1280, HC_QI = 1536, HC_WI = 3584, HC_KI = 3600, HC_ZA = 3840, HC_U = 4864, HC_VB = 5888, HC_ZB = 6912, HC_GA = 7936, HC_GB = 9984;
constexpr int IN_WIDTH = 11920;
constexpr float QSCALE = 0.08838834764831845f * 1.4426950408889634f;
constexpr float WSCALE = 0.25f * 0.08838834764831845f;
constexpr float RMS_EPS = 1e-6f, LN_EPS = 1e-5f;
constexpr size_t O_YP = 0, O_YS = 16777216, O_KP = 16793600, O_VP = 18890752, O_KIP = 20987904, O_KS = 22036480, O_VS = 22038528, O_KIS = 22040576, O_GV = 22041600, O_END = 22049792;
constexpr size_t MiB = 1u << 20;
constexpr size_t WS_CTL = 0, CTL_ZERO_BYTES = 1 * MiB;
constexpr size_t WS_WTIN = 2 * MiB, WS_WTA = 50 * MiB, WS_WTB = 54 * MiB, WS_WTO = 58 * MiB, WS_XN = 66 * MiB, WS_XNS = 98 * MiB, WS_HS = 99 * MiB, WS_SSC = 100 * MiB;
constexpr size_t WS_OABS = 101 * MiB, WS_MIXS = 101 * MiB + 256 * 1024, WS_XSO = 101 * MiB + 512 * 1024, WS_PS = 102 * MiB, WS_WI = 103 * MiB;
constexpr size_t WS_H = 104 * MiB, WS_OAB = 292 * MiB, WS_MIX = 324 * MiB, WS_SC = 356 * MiB, WS_END = 420 * MiB;
constexpr int SSC_LD = 16448;
static_assert(WS_WTIN + (size_t)LDH * DM * 2 <= WS_WTA && WS_H + (size_t)MP * LDH * 2 <= WS_OAB && WS_WI + (size_t)MP * 16 * 4 <= WS_H, "ws map");
constexpr int CW_Q2 = 64;
constexpr int CW_BAR = 4096;

#define GAS __attribute__((address_space(1)))
#define LAS __attribute__((address_space(3)))
typedef unsigned short bf16;
typedef unsigned v4u __attribute__((ext_vector_type(4)));
typedef unsigned v2u __attribute__((ext_vector_type(2)));
typedef float f32x4 __attribute__((ext_vector_type(4)));
typedef float f32x2 __attribute__((ext_vector_type(2)));
typedef float f32x16 __attribute__((ext_vector_type(16)));
typedef short bf16x8 __attribute__((ext_vector_type(8)));
typedef short s16x4 __attribute__((ext_vector_type(4)));
typedef __bf16 bf16x2_t __attribute__((ext_vector_type(2)));
typedef GAS unsigned gu32;
#define LDS_WAIT() asm volatile("s_waitcnt lgkmcnt(0)" ::: "memory")
#define VM_WAIT() asm volatile("s_waitcnt vmcnt(0)" ::: "memory")

__device__ __forceinline__ unsigned cvtpk(float lo, float hi) { f32x2 v = {lo, hi}; bf16x2_t b = __builtin_convertvector(v, bf16x2_t); return __builtin_bit_cast(unsigned, b); }
__device__ __forceinline__ float bf2f(unsigned short h) { return __uint_as_float((unsigned)h << 16); }
__device__ __forceinline__ float bflo(unsigned w) { return __uint_as_float(w << 16); }
__device__ __forceinline__ float bfhi(unsigned w) { return __uint_as_float(w & 0xffff0000u); }
__device__ __forceinline__ bf16x8 cvt8(f32x4 a, f32x4 b) { v4u w; w.x = cvtpk(a[0], a[1]); w.y = cvtpk(a[2], a[3]); w.z = cvtpk(b[0], b[1]); w.w = cvtpk(b[2], b[3]); return __builtin_bit_cast(bf16x8, w); }
__device__ __forceinline__ float sigmoid_(float x) { return __builtin_amdgcn_rcpf(1.f + __builtin_amdgcn_exp2f(-1.4426950408889634f * x)); }
__device__ __forceinline__ float silu_(float x) { return x * sigmoid_(x); }
__device__ __forceinline__ float wave_sum(float v) {
#pragma unroll
    for (int o = 1; o < 64; o <<= 1) v += __shfl_xor(v, o);
    return v;
}
__device__ __forceinline__ int wave_sum_i(int v) {
#pragma unroll
    for (int o = 1; o < 64; o <<= 1) v += __shfl_xor(v, o);
    return v;
}
__device__ __forceinline__ float wave_max(float v) {
#pragma unroll
    for (int o = 1; o < 64; o <<= 1) v = fmaxf(v, __shfl_xor(v, o));
    return v;
}
__device__ __forceinline__ float wave_min(float v) {
#pragma unroll
    for (int o = 1; o < 64; o <<= 1) v = fminf(v, __shfl_xor(v, o));
    return v;
}

namespace pg8 {
#define PG8_LAS __attribute__((address_space(3)))
typedef unsigned short bf16_t;
typedef unsigned u32x4 __attribute__((ext_vector_type(4)));
constexpr int BM = 256, BK = 64, HALF = 128, HTB = HALF * BK * 2, STAGE_BYTES = 8 * HTB, NXCD = 8, WGM = 8;
__host__ __device__ __forceinline__ int lds_byte(int r, int c) { const int st = (r >> 4) * 2 + (c >> 5), rr = r & 15, cc = c & 31, ob = rr * 64 + cc * 2; return st * 1024 + (ob ^ (((ob >> 9) & 1) << 5)); }
__host__ __device__ __forceinline__ void stage_rc(int b, int& R, int& C) { const int st = b / 1024, sb = b % 1024, swz = sb ^ (((sb >> 9) & 1) << 5); R = (st >> 1) * 16 + swz / 64; C = (st & 1) * 32 + (swz % 64) / 2; }
__host__ __device__ __forceinline__ int perm32(int rho) { const int n = rho >> 4, i = rho & 15; return 8 * (i >> 2) + 4 * n + (i & 3); }
struct Unit { int pm, pn, kind; };
struct Gemm { const bf16_t* A0; const bf16_t* A1; const bf16_t* B0; const bf16_t* B1; int lda, ldb, K; };
struct StaticOrder {
    int nM, nN, nwg, G, c;
    __host__ __device__ void init(int M, int N, int G_, int c_) { nM = M / BM; nN = N / BM; nwg = nM * nN; G = G_; c = c_; }
    __host__ __device__ bool tile(long L, Unit& u) const {
        if (L >= nwg) return false;
        int wgid = (int)L; { const int q = nwg / NXCD, r = nwg % NXCD, xcd = wgid % NXCD, off = wgid / NXCD; wgid = (xcd < r ? xcd * (q + 1) : r * (q + 1) + (xcd - r) * q) + off; }
        const int nig = WGM * nN, gid = wgid / nig, fm = gid * WGM, gsz = (nM - fm) < WGM ? (nM - fm) : WGM;
        u.pm = fm + ((wgid % nig) % gsz); u.pn = (wgid % nig) / gsz; u.kind = 0; return true;
    }
    __host__ __device__ bool next(int i, Unit& u) const { return tile((long)i * G + c, u); }
};
struct PairOrder : StaticOrder {
    __host__ __device__ bool next(int i, Unit& u) const { if (i >= 2) return false; const bool ok = tile((long)c, u); u.kind = i; return ok; }
};

template <class Epi, class Sched, bool ALIGN_EPI = false, bool SP2 = false>
__device__ __forceinline__ void gemm_phase(PG8_LAS unsigned char* lds, const Gemm g, const Sched& S, const Epi& E) {
    const int tid = threadIdx.x, wid = __builtin_amdgcn_readfirstlane(tid >> 6), lane = tid & 63, wr = wid >> 2, wc = wid & 3, fr = lane & 15, fq = lane >> 4;
    const int K = g.K, nt = K / BK;
    unsigned voffA[2], voffB[2];
#pragma unroll
    for (int i = 0; i < 2; ++i) { int R, C; stage_rc(tid * 16 + i * 8192, R, C); const int Rb = Epi::PERM ? ((R & ~31) + perm32(R & 31)) : R;
        voffA[i] = (unsigned)(R * g.lda + C) * 2u; voffB[i] = (unsigned)(Rb * g.ldb + C) * 2u; }
    const size_t kstep = (size_t)(BK * 2);
    const size_t hstepA = (size_t)HALF * g.lda * 2, hstepB = (size_t)HALF * g.ldb * 2;
    const size_t tstepA = 2 * hstepA, tstepB = 2 * hstepB;
    const unsigned ldsw = (unsigned)wid * 1024u;
    const int aoff = lds_byte(wr * 64 + fr, fq * 8), boff = lds_byte(wc * 32 + fr, fq * 8);
#define PG8_SA(b, h) (((b) * 2 + (h)) * HTB)
#define PG8_SB(b, h) ((4 + (b) * 2 + (h)) * HTB)
#define PG8_STAGE(bufoff, gbase, voff) do { _Pragma("unroll") for (int _i = 0; _i < 2; ++_i) \
        __builtin_amdgcn_global_load_lds((const unsigned*)((const char*)(gbase) + (voff)[_i]), (PG8_LAS unsigned*)(lds + (bufoff) + ldsw + _i * 8192), 16, 0, 0); } while (0)
#define PG8_LDA(dst, b, h) do { _Pragma("unroll") for (int m = 0; m < 4; ++m) _Pragma("unroll") for (int k = 0; k < 2; ++k) dst[m][k] = *(const PG8_LAS bf16x8*)(lds + PG8_SA(b, h) + aoff + m * 2048 + k * 1024); } while (0)
#define PG8_LDB(dst, b, h) do { _Pragma("unroll") for (int n = 0; n < 2; ++n) _Pragma("unroll") for (int k = 0; k < 2; ++k) dst[n][k] = *(const PG8_LAS bf16x8*)(lds + PG8_SB(b, h) + boff + n * 2048 + k * 1024); } while (0)
#define PG8_MMA(ai, bj, At, Bt) do { __builtin_amdgcn_s_setprio(1); _Pragma("unroll") for (int m = 0; m < 4; ++m) _Pragma("unroll") for (int n = 0; n < 2; ++n) _Pragma("unroll") for (int k = 0; k < 2; ++k) \
        acc[ai][bj][m][n] = __builtin_amdgcn_mfma_f32_16x16x32_bf16(Bt[n][k], At[m][k], acc[ai][bj][m][n], 0, 0, 0); __builtin_amdgcn_s_setprio(0); } while (0)
#define PG8_WAIT_V(n) asm volatile("s_waitcnt vmcnt(" #n ")" ::: "memory")
#define PG8_WAIT_L(n) asm volatile("s_waitcnt lgkmcnt(" #n ")" ::: "memory")
#define PG8_BAR __builtin_amdgcn_s_barrier()
#define PG8_SCHED __builtin_amdgcn_sched_barrier(0)
#define PG8_OPA(u) ((const char*)((u).kind ? g.A1 : g.A0) + (size_t)(u).pm * tstepA)
#define PG8_OPB(u) ((const char*)((u).kind ? g.B1 : g.B0) + (size_t)(u).pn * tstepB)
    Unit cur, nxt; int ui = 0;
    if (!S.next(0, cur)) return;
    f32x4 acc[2][2][4][2];
#pragma unroll
    for (int a = 0; a < 2; ++a)
#pragma unroll
        for (int b = 0; b < 2; ++b)
#pragma unroll
            for (int m = 0; m < 4; ++m)
#pragma unroll
                for (int n = 0; n < 2; ++n) acc[a][b][m][n] = (f32x4){0.f, 0.f, 0.f, 0.f};
    bf16x8 At[4][2], B0[2][2], B1[2][2];
    const char* cA = PG8_OPA(cur); const char* cB = PG8_OPB(cur);
    if constexpr (SP2) {
        PG8_STAGE(PG8_SB(0, 0), cB, voffB); PG8_STAGE(PG8_SB(0, 1), cB + hstepB, voffB); PG8_STAGE(PG8_SA(0, 0), cA, voffA); PG8_STAGE(PG8_SA(0, 1), cA + hstepA, voffA);
        if (wr == 1) PG8_BAR;
        PG8_WAIT_V(2); PG8_BAR;
        PG8_STAGE(PG8_SB(1, 0), cB + kstep, voffB); PG8_STAGE(PG8_SA(1, 0), cA + kstep, voffA); PG8_STAGE(PG8_SB(1, 1), cB + hstepB + kstep, voffB);
        PG8_WAIT_V(6); PG8_BAR;
    } else {
        PG8_STAGE(PG8_SB(0, 0), cB, voffB); PG8_STAGE(PG8_SA(0, 0), cA, voffA); PG8_STAGE(PG8_SB(0, 1), cB + hstepB, voffB); PG8_STAGE(PG8_SA(0, 1), cA + hstepA, voffA);
        if (wr == 1) PG8_BAR;
        PG8_WAIT_V(4); PG8_BAR;
        PG8_STAGE(PG8_SB(1, 0), cB + kstep, voffB); PG8_STAGE(PG8_SA(1, 0), cA + kstep, voffA); PG8_STAGE(PG8_SB(1, 1), cB + hstepB + kstep, voffB);
        PG8_WAIT_V(6); PG8_BAR;
    }
    for (;;) {
        const bool has_next = S.next(ui + 1, nxt);
        const char* nA = has_next ? PG8_OPA(nxt) : cA; const char* nB = has_next ? PG8_OPB(nxt) : cB;
        for (int t = 0; t < nt; t += 2) {
            const bool last = (t == nt - 2);
            const char* a1 = cA + (size_t)(t + 1) * kstep;
            const char* a2 = last ? nA : cA + (size_t)(t + 2) * kstep; const char* b2 = last ? nB : cB + (size_t)(t + 2) * kstep;
            const char* a3 = a2 + kstep; const char* b3 = b2 + kstep;
            if constexpr (SP2) {
            PG8_LDB(B0, 0, 0); PG8_LDB(B1, 0, 1); PG8_SCHED; PG8_LDA(At, 0, 0); PG8_STAGE(PG8_SA(1, 1), a1 + hstepA, voffA);
            PG8_WAIT_V(8); PG8_WAIT_L(0); PG8_BAR; PG8_MMA(0, 0, At, B0); PG8_MMA(0, 1, At, B1); PG8_BAR; PG8_SCHED;
            PG8_LDA(At, 0, 1); PG8_STAGE(PG8_SB(0, 0), b2, voffB); PG8_STAGE(PG8_SB(0, 1), b2 + hstepB, voffB); PG8_STAGE(PG8_SA(0, 0), a2, voffA);
            PG8_WAIT_V(8); PG8_WAIT_L(0); PG8_BAR; PG8_MMA(1, 0, At, B0); PG8_MMA(1, 1, At, B1); PG8_BAR; PG8_SCHED;
            PG8_LDB(B0, 1, 0); PG8_LDB(B1, 1, 1); PG8_SCHED; PG8_LDA(At, 1, 0); PG8_STAGE(PG8_SA(0, 1), a2 + hstepA, voffA);
            PG8_WAIT_V(8); PG8_WAIT_L(0); PG8_BAR; PG8_MMA(0, 0, At, B0); PG8_MMA(0, 1, At, B1); PG8_BAR; PG8_SCHED;
            PG8_LDA(At, 1, 1); PG8_STAGE(PG8_SB(1, 0), b3, voffB); PG8_STAGE(PG8_SB(1, 1), b3 + hstepB, voffB); PG8_STAGE(PG8_SA(1, 0), a3, voffA);
            PG8_WAIT_V(8); PG8_WAIT_L(0); PG8_BAR; PG8_MMA(1, 0, At, B0); PG8_MMA(1, 1, At, B1); PG8_BAR; PG8_SCHED;
            } else {
            PG8_LDB(B0, 0, 0); PG8_SCHED; PG8_LDA(At, 0, 0); PG8_STAGE(PG8_SA(1, 1), a1 + hstepA, voffA);
            PG8_WAIT_L(8); PG8_BAR; PG8_WAIT_L(0); PG8_MMA(0, 0, At, B0); PG8_BAR; PG8_SCHED;
            PG8_LDB(B1, 0, 1); PG8_STAGE(PG8_SB(0, 0), b2, voffB);
            PG8_BAR; PG8_WAIT_L(0); PG8_MMA(0, 1, At, B1); PG8_BAR;
            PG8_LDA(At, 0, 1); PG8_STAGE(PG8_SA(0, 0), a2, voffA);
            PG8_BAR; PG8_WAIT_L(0); PG8_MMA(1, 0, At, B0); PG8_BAR; PG8_SCHED;
            PG8_STAGE(PG8_SB(0, 1), b2 + hstepB, voffB);
            PG8_WAIT_V(6); PG8_BAR; PG8_MMA(1, 1, At, B1); PG8_BAR;
            PG8_LDB(B0, 1, 0); PG8_SCHED; PG8_LDA(At, 1, 0); PG8_STAGE(PG8_SA(0, 1), a2 + hstepA, voffA);
            PG8_WAIT_L(8); PG8_BAR; PG8_WAIT_L(0); PG8_MMA(0, 0, At, B0); PG8_BAR; PG8_SCHED;
            PG8_LDB(B1, 1, 1); PG8_STAGE(PG8_SB(1, 0), b3, voffB);
            PG8_BAR; PG8_WAIT_L(0); PG8_MMA(0, 1, At, B1); PG8_BAR;
            PG8_LDA(At, 1, 1); PG8_STAGE(PG8_SA(1, 0), a3, voffA);
            PG8_BAR; PG8_WAIT_L(0); PG8_MMA(1, 0, At, B0); PG8_BAR; PG8_SCHED;
            PG8_STAGE(PG8_SB(1, 1), b3 + hstepB, voffB);
            PG8_WAIT_V(6); PG8_BAR; PG8_MMA(1, 1, At, B1); PG8_BAR;
            }
        }
        if constexpr (ALIGN_EPI) { if (wr == 0) PG8_BAR; }
        if constexpr (!Epi::AFTER_DRAIN) { E(acc, cur, wr, wc, fr, fq); }
        if (!has_next) break;
        if (!(Epi::KEEP && cur.kind == 0)) {
#pragma unroll
        for (int a = 0; a < 2; ++a)
#pragma unroll
            for (int b = 0; b < 2; ++b)
#pragma unroll
                for (int m = 0; m < 4; ++m)
#pragma unroll
                    for (int n = 0; n < 2; ++n) acc[a][b][m][n] = (f32x4){0.f, 0.f, 0.f, 0.f};
        }
        cur = nxt; cA = nA; cB = nB; ++ui;
        if constexpr (ALIGN_EPI) { if (wr == 1) PG8_BAR; }
    }
    PG8_WAIT_V(0);
    if constexpr (!ALIGN_EPI) { if (wr == 0) PG8_BAR; }
    PG8_BAR;
    if constexpr (Epi::AFTER_DRAIN) { E.fused(acc, cur, wr, wc, fr, fq, lds, wid, lane); }
#undef PG8_SA
#undef PG8_SB
#undef PG8_STAGE
#undef PG8_LDA
#undef PG8_LDB
#undef PG8_MMA
#undef PG8_WAIT_V
#undef PG8_WAIT_L
#undef PG8_BAR
#undef PG8_SCHED
#undef PG8_OPA
#undef PG8_OPB
}

__device__ __forceinline__ f32x2 gelu_pk(f32x2 v) {
    const f32x2 av = __builtin_elementwise_abs(v), d = av * 0.2316418882f + 1.0f;
    f32x2 t; t.x = __builtin_amdgcn_rcpf(d.x); t.y = __builtin_amdgcn_rcpf(d.y);
    f32x2 q = t * 0.5307027145f + (-0.7265760135f); q = q * t + 0.7107068705f; q = q * t + (-0.142248368f); q = q * t + 0.127414796f; q = q * t;
    const f32x2 s = (v * v) * (-0.72134752044f);
    f32x2 e; e.x = __builtin_amdgcn_exp2f(s.x); e.y = __builtin_amdgcn_exp2f(s.y);
    const f32x2 m = v * (q * e), r = v - m;
    f32x2 o; o.x = v.x < 0.f ? m.x : r.x; o.y = v.y < 0.f ? m.y : r.y; return o;
}

struct EpiInProj {
    static constexpr bool PERM = true, AFTER_DRAIN = false, KEEP = false;
    bf16_t* H; float* out; float* WI;
    __device__ __forceinline__ void operator()(f32x4 (&acc)[2][2][4][2], const Unit& u, int wr, int wc, int fr, int fq) const {
        const int pn = u.pn;
        int act;
        if (pn < 4) act = 1; else if (pn == 4) act = 5; else if (pn == 5) act = 6; else if (pn < 14) act = 0; else if (pn == 14) act = 7;
        else if (pn < 19) act = 2; else if (pn < 27) act = 3; else if (pn < 31) act = 2; else act = 4;
        const int row0 = u.pm * BM + wr * 64 + fr, col0 = pn * BM + wc * 32 + 8 * fq;
#pragma unroll
        for (int ai = 0; ai < 2; ++ai)
#pragma unroll
            for (int m = 0; m < 4; ++m) { const int row = row0 + ai * HALF + m * 16; bf16_t* hrow = H + (size_t)row * LDH;
#pragma unroll
                for (int bj = 0; bj < 2; ++bj) { f32x4 v0 = acc[ai][bj][m][0], v1 = acc[ai][bj][m][1]; const int c = col0 + bj * HALF;
                    bool st = true;
                    if (act == 1) { v0 = v0 * QSCALE; v1 = v1 * QSCALE; }
                    else if (act == 2) {
#pragma unroll
                        for (int j = 0; j < 4; ++j) { v0[j] = silu_(v0[j]); v1[j] = silu_(v1[j]); } }
                    else if (act == 3) { f32x2 a = gelu_pk((f32x2){v0[0], v0[1]}), b = gelu_pk((f32x2){v0[2], v0[3]}), cc = gelu_pk((f32x2){v1[0], v1[1]}), d = gelu_pk((f32x2){v1[2], v1[3]});
                        v0 = (f32x4){a.x, a.y, b.x, b.y}; v1 = (f32x4){cc.x, cc.y, d.x, d.y}; }
                    else if (act == 4) {
#pragma unroll
                        for (int j = 0; j < 4; ++j) { v0[j] = sigmoid_(v0[j]); v1[j] = sigmoid_(v1[j]); } }
                    else if (act == 5) { float* o = out + O_KP + (size_t)row * 256 + (c - HC_K); *(f32x4*)o = v0; *(f32x4*)(o + 4) = v1; }
                    else if (act == 6) { float* o = out + O_VP + (size_t)row * 256 + (c - HC_V); *(f32x4*)o = v0; *(f32x4*)(o + 4) = v1; }
                    else if (act == 7) { const int cl = c - HC_WI;
                        if (cl < 16) { float* o = WI + (size_t)row * 16 + cl; *(f32x4*)o = v0 * WSCALE; *(f32x4*)(o + 4) = v1 * WSCALE; st = false; }
                        else if (cl < 144) { float* o = out + O_KIP + (size_t)row * 128 + (cl - 16); *(f32x4*)o = v0; *(f32x4*)(o + 4) = v1; }
                        else st = false; }
                    if (st) { u32x4 w; w.x = cvtpk(v0[0], v0[1]); w.y = cvtpk(v0[2], v0[3]); w.z = cvtpk(v1[0], v1[1]); w.w = cvtpk(v1[2], v1[3]); *(u32x4*)(hrow + c) = w; } } }
    }
};
struct EpiMix {
    static constexpr bool PERM = true, AFTER_DRAIN = false, KEEP = true;
    const bf16_t* H; bf16_t* MIX;
    __device__ __forceinline__ void operator()(f32x4 (&acc)[2][2][4][2], const Unit& u, int wr, int wc, int fr, int fq) const {
        const int row0 = u.pm * BM + wr * 64 + fr, col0 = u.pn * BM + wc * 32 + 8 * fq;
#pragma unroll
        for (int ai = 0; ai < 2; ++ai)
#pragma unroll
            for (int m = 0; m < 4; ++m) { const int row = row0 + ai * HALF + m * 16; const bf16_t* hrow = H + (size_t)row * LDH;
#pragma unroll
                for (int bj = 0; bj < 2; ++bj) { const int c = col0 + bj * HALF;
                    const u32x4 gb = *(const u32x4*)(hrow + HC_GB + c);
                    float b[8] = {bflo(gb.x), bfhi(gb.x), bflo(gb.y), bfhi(gb.y), bflo(gb.z), bfhi(gb.z), bflo(gb.w), bfhi(gb.w)};
                    if (u.kind == 0) {
                        const u32x4 ga = *(const u32x4*)(hrow + HC_GA + c);
                        float a[8] = {bflo(ga.x), bfhi(ga.x), bflo(ga.y), bfhi(ga.y), bflo(ga.z), bfhi(ga.z), bflo(ga.w), bfhi(ga.w)};
#pragma unroll
                        for (int j = 0; j < 4; ++j) { acc[ai][bj][m][0][j] *= a[j] * __builtin_amdgcn_rcpf(fmaxf(b[j], 1e-30f)); acc[ai][bj][m][1][j] *= a[4 + j] * __builtin_amdgcn_rcpf(fmaxf(b[4 + j], 1e-30f)); }
                    } else {
                        f32x4 v0 = acc[ai][bj][m][0], v1 = acc[ai][bj][m][1];
#pragma unroll
                        for (int j = 0; j < 4; ++j) { v0[j] *= b[j]; v1[j] *= b[4 + j]; }
                        u32x4 w; w.x = cvtpk(v0[0], v0[1]); w.y = cvtpk(v0[2], v0[3]); w.z = cvtpk(v1[0], v1[1]); w.w = cvtpk(v1[2], v1[3]); *(u32x4*)(MIX + (size_t)row * DM + c) = w; } } }
    }
};
struct EpiOut {
    static constexpr bool PERM = false, AFTER_DRAIN = true, KEEP = false;
    const float* X; float* out; float* PS;
    __device__ __forceinline__ void fused(f32x4 (&acc)[2][2][4][2], const Unit& u, int wr, int wc, int fr, int fq, PG8_LAS unsigned char* lds, int wid, int lane) const {
        PG8_LAS float* P = (PG8_LAS float*)lds;
        const int col0 = u.pn * BM + wc * 32 + 4 * fq;
#pragma unroll
        for (int ai = 0; ai < 2; ++ai)
#pragma unroll
            for (int m = 0; m < 4; ++m) { const int rl = ai * HALF + wr * 64 + m * 16 + fr; const size_t off = (size_t)(u.pm * BM + rl) * DM + col0; float s = 0.f;
#pragma unroll
                for (int bj = 0; bj < 2; ++bj)
#pragma unroll
                    for (int n = 0; n < 2; ++n) { const f32x4 xv = *(const f32x4*)(X + off + bj * HALF + n * 16); const f32x4 v = acc[ai][bj][m][n] + xv;
                        *(f32x4*)(out + off + bj * HALF + n * 16) = v; s += (v[0] * v[0] + v[1] * v[1]) + (v[2] * v[2] + v[3] * v[3]); }
                s += __shfl_xor(s, 16); s += __shfl_xor(s, 32);
                if (fq == 0) P[rl * 4 + wc] = s; }
        asm volatile("s_waitcnt lgkmcnt(0)" ::: "memory"); __builtin_amdgcn_s_barrier(); asm volatile("" ::: "memory");
        const int tid = wid * 64 + lane;
        if (tid < 256) { const float t = (P[tid * 4 + 0] + P[tid * 4 + 1]) + (P[tid * 4 + 2] + P[tid * 4 + 3]); PS[(size_t)(u.pm * BM + tid) * 8 + u.pn] = t; }
    }
};
}

constexpr int RING_OFF = 0, RING_BYTES = 131072;
constexpr int LDSCTL_OFF = RING_BYTES, MISC_OFF = LDSCTL_OFF + 320;
constexpr int LDS_BYTES = 147456;

#define XB_TMO      128
#define XB_XCNT(j)  (256  + 64 * (j))
#define XB_XSUB(j)  (1280 + 64 * (j))
#define XB_XGEN(j)  (2304 + 64 * (j))
#define XB_TOP      3328
#define XB_TOPGEN   3392
#define XCD_BAR_WORDS 3456
#define XB_SPIN_CAP (1u << 18)
__device__ __forceinline__ unsigned xb_ld(unsigned* p)              { return __hip_atomic_load(p, __ATOMIC_RELAXED, __HIP_MEMORY_SCOPE_AGENT); }
__device__ __forceinline__ unsigned xb_add(unsigned* p, unsigned v) { return __hip_atomic_fetch_add(p, v, __ATOMIC_RELAXED, __HIP_MEMORY_SCOPE_AGENT); }
__device__ __forceinline__ unsigned xb_xcc_id() { return (unsigned)__builtin_amdgcn_s_getreg((3 << 11) | 20) & 0xFu; }
#define XB_SPIN(cond, bar) do { unsigned _sp = 0; while (cond) { __builtin_amdgcn_s_sleep(1); \
    if ((++_sp & 255u) == 0u) { if (xb_ld(&(bar)[XB_TMO])) break; if (_sp > XB_SPIN_CAP) { atomicAdd(&(bar)[XB_TMO], 1u); break; } } } } while (0)
struct XcdBarrier { unsigned* bar; unsigned x; volatile LAS unsigned* st; };
__device__ __forceinline__ XcdBarrier xcd_barrier_post(unsigned* bar, volatile LAS unsigned* st) {
    XcdBarrier b; b.bar = bar; b.x = xb_xcc_id(); b.st = st;
    if (threadIdx.x == 0) (void)xb_add(&bar[XB_XCNT(b.x)], 1u);
    return b;
}
__device__ __forceinline__ void xcd_barrier_complete(unsigned* bar, unsigned x, unsigned& nloc, unsigned& nx) {
    const unsigned G = gridDim.x * gridDim.y * gridDim.z;
    unsigned sum, cnt, mine, sp = 0u;
    for (;;) {
        sum = 0u; cnt = 0u; mine = 0u;
#pragma unroll
        for (unsigned j = 0; j < 16; ++j) { const unsigned c = xb_ld(&bar[XB_XCNT(j)]); sum += c; cnt += (c > 0u) ? 1u : 0u; mine = (j == x) ? c : mine; }
        if (sum == G) break;
        __builtin_amdgcn_s_sleep(1);
        if ((++sp & 255u) == 0u) { if (xb_ld(&bar[XB_TMO])) break; if (sp > XB_SPIN_CAP) { atomicAdd(&bar[XB_TMO], 1u); break; } }
    }
    nloc = mine > 0u ? mine : 1u; nx = cnt > 0u ? cnt : 1u;
}
__device__ __forceinline__ void xcd_barrier(const XcdBarrier& b) {
    asm volatile("s_waitcnt vmcnt(0)" ::: "memory");
    __syncthreads();
    if (threadIdx.x == 0) {
        unsigned* bar = b.bar;
        __builtin_amdgcn_s_waitcnt(0);
        unsigned nloc = b.st[0], nx = b.st[1];
        if (nloc == 0u) { xcd_barrier_complete(bar, b.x, nloc, nx); b.st[0] = nloc; b.st[1] = nx; }
        const unsigned old = xb_add(&bar[XB_XSUB(b.x)], 1u);
        const unsigned gen = old / nloc;
        if (old + 1u == (gen + 1u) * nloc) {
            __builtin_amdgcn_fence(__ATOMIC_RELEASE, "agent");
            asm volatile("s_waitcnt vmcnt(0)" ::: "memory");
            const unsigned og = xb_add(&bar[XB_TOP], 1u);
            const unsigned tg = og / nx;
            if (og + 1u == (tg + 1u) * nx) xb_add(&bar[XB_TOPGEN], 1u);
            else XB_SPIN(xb_ld(&bar[XB_TOPGEN]) == tg, bar);
            __builtin_amdgcn_fence(__ATOMIC_ACQUIRE, "agent");
            xb_add(&bar[XB_XGEN(b.x)], 1u);
            asm volatile("s_waitcnt vmcnt(0)" ::: "memory");
        } else {
            XB_SPIN(xb_ld(&bar[XB_XGEN(b.x)]) == gen, bar);
            __builtin_amdgcn_fence(__ATOMIC_ACQUIRE, "agent");
            asm volatile("s_waitcnt vmcnt(0)" ::: "memory");
        }
    }
    __syncthreads();
}

struct Args { const void* in[16]; float* out; unsigned char* ws; int ph_lo, ph_hi, li, pad; };
#define WSB(off) ((bf16*)(F.ws + (off)))
#define WSF(off) ((float*)(F.ws + (off)))
struct In { const float *xp, *xs, *ck, *cv, *cki, *gin, *win, *wpa, *wpb, *wo, *lng, *lnb, *wsp, *bsp, *gf; const int* pt; };
struct Ctx {
    LAS unsigned char* lds; int tid, lane, wave, G, bid;
    float* out; unsigned char* ws;
};

__device__ __forceinline__ unsigned f2bf(float f) { unsigned u = __builtin_bit_cast(unsigned, f); return (u + 0x7fffu + ((u >> 16) & 1u)) >> 16; }
__device__ __forceinline__ unsigned pk2(float lo, float hi) { return f2bf(lo) | (f2bf(hi) << 16); }
__device__ __forceinline__ void p0_transpose_item(const float* W, int K, int Nsrc, bf16* WT, bool remap, LAS float* scr, int kb, int nb, int lane) {
    const int k0 = 64 * kb, n0 = 32 * nb;
    const int nd = n0 + (lane & 31); int ns = nd; bool ok = true;
    if (remap) { if (nd >= 3840) ns = nd - 112; else if (nd >= 3728) ok = false; }
#pragma unroll 8
    for (int i = 0; i < 32; ++i) { const int kk = 2 * i + (lane >> 5); scr[kk * 33 + (lane & 31)] = ok ? W[(size_t)(k0 + kk) * Nsrc + ns] : 0.f; }
    LDS_WAIT(); asm volatile("" ::: "memory");
    const int c = lane & 7;
#pragma unroll
    for (int j = 0; j < 4; ++j) { const int n = (lane >> 3) + 8 * j; const LAS float* s = scr + (8 * c) * 33 + n;
        v4u o; o.x = pk2(s[0 * 33], s[1 * 33]); o.y = pk2(s[2 * 33], s[3 * 33]); o.z = pk2(s[4 * 33], s[5 * 33]); o.w = pk2(s[6 * 33], s[7 * 33]);
        *(GAS v4u*)(WT + (size_t)(n0 + n) * K + k0 + 8 * c) = o; }
    LDS_WAIT(); asm volatile("" ::: "memory");
}
__device__ __forceinline__ void rms_row_to_bf16(const float* xrow, const float* g, bf16* orow, int lane) {
    const f32x4* xr = (const f32x4*)xrow + lane; const f32x4* gr = (const f32x4*)g + lane;
    f32x4 v[8]; float s = 0.f;
#pragma unroll
    for (int j = 0; j < 8; ++j) { v[j] = xr[64 * j]; s += (v[j].x * v[j].x + v[j].y * v[j].y) + (v[j].z * v[j].z + v[j].w * v[j].w); }
    const float rstd = 1.0f / sqrtf(wave_sum(s) * (1.f / DM) + RMS_EPS);
    v2u* o8 = (v2u*)orow + lane;
#pragma unroll
    for (int j = 0; j < 8; ++j) { const f32x4 gg = gr[64 * j]; v2u w; w.x = cvtpk(v[j].x * rstd * gg.x, v[j].y * rstd * gg.y); w.y = cvtpk(v[j].z * rstd * gg.z, v[j].w * rstd * gg.w); o8[64 * j] = w; }
}
__device__ __forceinline__ void p0_prologue(Ctx& F, const In& I) {
    LAS float* scr = (LAS float*)(F.lds + RING_OFF + F.wave * 8448);
    const int gw = F.bid * 8 + F.wave, NGW = F.G * 8;
    constexpr int NB_IN = LDH / 32, I_IN = (DM / 64) * NB_IN;
    constexpr int I_A = (1024 / 64) * (DM / 32), I_O = (DM / 64) * (DM / 32);
    constexpr int NITEMS = I_IN + 2 * I_A + I_O;
    for (int it = gw; it < NITEMS; it += NGW) {
        int r = it;
        if (r < I_IN) { p0_transpose_item(I.win, DM, IN_WIDTH, WSB(WS_WTIN), true, scr, r / NB_IN, r % NB_IN, F.lane); continue; } r -= I_IN;
        if (r < I_A) { p0_transpose_item(I.wpa, 1024, DM, WSB(WS_WTA), false, scr, r / (DM / 32), r % (DM / 32), F.lane); continue; } r -= I_A;
        if (r < I_A) { p0_transpose_item(I.wpb, 1024, DM, WSB(WS_WTB), false, scr, r / (DM / 32), r % (DM / 32), F.lane); continue; } r -= I_A;
        p0_transpose_item(I.wo, DM, DM, WSB(WS_WTO), false, scr, r / (DM / 32), r % (DM / 32), F.lane);
    }
    for (int m = gw; m < MP + NS; m += NGW) {
        if (m < MP) rms_row_to_bf16(I.xp + (size_t)m * DM, I.gin, WSB(WS_XN) + (size_t)m * DM, F.lane);
        else rms_row_to_bf16(I.xs + (size_t)(m - MP) * DM, I.gin, WSB(WS_XNS) + (size_t)(m - MP) * DM, F.lane);
    }
}

__device__ __forceinline__ f32x4 sgemv_part(const bf16* X, int ldx, const bf16* Wt, int ldw, int n0, int kbeg, int nsteps, int lane) {
    const int r = lane & 15, q = lane >> 4;
    f32x4 acc = {0.f, 0.f, 0.f, 0.f};
    const bf16* xp = X + (size_t)(r & 7) * ldx + kbeg + 8 * q; const bf16* wp = Wt + (size_t)(n0 + r) * ldw + kbeg + 8 * q;
    const bf16x8 z = {0, 0, 0, 0, 0, 0, 0, 0};
#pragma unroll 4
    for (int st = 0; st < nsteps; ++st) {
        bf16x8 a = *(const bf16x8*)(xp + 32 * st); if (r >= 8) a = z;
        const bf16x8 b = *(const bf16x8*)(wp + 32 * st);
        acc = __builtin_amdgcn_mfma_f32_16x16x32_bf16(a, b, acc, 0, 0, 0);
    }
    return acc;
}
__device__ __forceinline__ f32x4 block_reduce8(f32x4 v, LAS float* red, int wave, int lane) {
    *(LAS f32x4*)(red + (wave * 64 + lane) * 4) = v;
    __syncthreads();
    f32x4 s = {0.f, 0.f, 0.f, 0.f};
    if (wave == 0) {
#pragma unroll
        for (int w = 0; w < 8; ++w) s += *(LAS f32x4*)(red + (w * 64 + lane) * 4);
    }
    __syncthreads();
    return s;
}
__device__ __forceinline__ void finish_sample_col(Ctx& F, int s, int n, float v) {
    float h = v;
    if (n < HC_K) h = v * QSCALE;
    else if (n < HC_V) F.out[O_KS + s * 256 + (n - HC_K)] = v;
    else if (n < HC_QI) F.out[O_VS + s * 256 + (n - HC_V)] = v;
    else if (n < HC_WI) {}
    else if (n < HC_KI) h = v * WSCALE;
    else if (n < 3728) F.out[O_KIS + s * 128 + (n - HC_KI)] = v;
    else if (n < HC_ZA) h = 0.f;
    else if (n < HC_U) h = silu_(v);
    else if (n < HC_ZB) h = 0.5f * v * (1.0f + erff(v * 0.70710678118654752f));
    else if (n < HC_GA) h = silu_(v);
    else h = sigmoid_(v);
    WSF(WS_HS)[(size_t)s * LDH + n] = h;
}
__device__ __forceinline__ void p1_sample_inproj(Ctx& F) {
    LAS float* red = (LAS float*)(F.lds + RING_OFF);
    for (int it = F.bid; it < LDH / 16; it += F.G) {
        const int n0 = 16 * it;
        f32x4 a = sgemv_part(WSB(WS_XNS), DM, WSB(WS_WTIN), DM, n0, F.wave * 256, 8, F.lane);
        a = block_reduce8(a, red, F.wave, F.lane);
        if (F.wave == 0 && F.lane < 32) {
#pragma unroll
            for (int j = 0; j < 4; ++j) finish_sample_col(F, 4 * (F.lane >> 4) + j, n0 + (F.lane & 15), a[j]);
        }
    }
    __syncthreads();
}

template <int NREG>
__device__ __forceinline__ void wave_select256(const float (&s)[NREG], int n_valid, int lane, LAS unsigned short* list) {
    float mx = -INFINITY, mn = INFINITY;
#pragma unroll
    for (int i = 0; i < NREG; ++i) { mx = fmaxf(mx, s[i]); mn = fminf(mn, s[i] == -INFINITY ? INFINITY : s[i]); }
    mx = wave_max(mx); mn = wave_min(mn);
    float lo = mn, hi = INFINITY; int clo = n_valid, chi = 0;
    float hv = mx;
    for (int it = 0; it < 64 && clo != 256; ++it) {
        float mid;
        if (it & 1) mid = 0.5f * lo + 0.5f * hv;
        else { const float fr = ((float)clo - 255.5f) / (float)(clo - chi); mid = lo + (hv - lo) * fr; }
        if (!(mid > lo)) mid = 0.5f * lo + 0.5f * hv;
        if (!(mid > lo) || !(mid < hi)) { if (hi == INFINITY && hv > lo) mid = hv; else break; }
        int c = 0;
#pragma unroll
        for (int i = 0; i < NREG; ++i) c += (s[i] >= mid) ? 1 : 0;
        c = wave_sum_i(c);
        if (c >= 256) { lo = mid; clo = c; } else { hi = mid; hv = mid; chi = c; }
    }
    int base = 0, rem = 256 - chi;
#pragma unroll
    for (int i = 0; i < NREG; ++i) {
        const bool a = s[i] >= hi, b = (s[i] >= lo) && !a;
        const unsigned long long mb = __ballot(b);
        const int rb = __builtin_amdgcn_mbcnt_hi((unsigned)(mb >> 32), __builtin_amdgcn_mbcnt_lo((unsigned)mb, 0));
        const bool take = a || (b && rb < rem);
        const unsigned long long mt = __ballot(take);
        const int pos = base + __builtin_amdgcn_mbcnt_hi((unsigned)(mt >> 32), __builtin_amdgcn_mbcnt_lo((unsigned)mt, 0));
        if (take && pos < 256) list[pos] = (unsigned short)(i * 64 + lane);
        base += __builtin_popcountll(mt);
        const int nb = __builtin_popcountll(mb); rem = rem > nb ? rem - nb : 0;
    }
    LDS_WAIT();
}

struct RowSrc { const unsigned short* Hb; const float* ck; const float* cv; const int* pt; const float* knew; const float* vnew; };
template <bool SAMPLE>
__device__ __forceinline__ void attn_part(const RowSrc& R, int g, const LAS unsigned short* list, int k0, int nstep, int nsel, LAS unsigned char* vst, const bf16x8 (&qf)[4], float& m_out, float& l_out, f32x4 (&o)[8], int lane) {
    const int r16 = lane & 15, q4 = lane >> 4;
    float m = -1e30f, l = 0.f;
#pragma unroll
    for (int db = 0; db < 8; ++db) o[db] = (f32x4){0.f, 0.f, 0.f, 0.f};
    const LAS unsigned char* vb = vst + (4 * q4 + (r16 >> 2)) * 288 + (r16 & 3) * 8;
#pragma unroll 1
    for (int ks = 0; ks < nstep; ++ks) {
        const int sb = k0 + ks * 32;
        bf16x8 ka[2][4]; v4u vw[8];
#pragma unroll
        for (int grp = 0; grp < 2; ++grp) {
            const int slot = sb + grp * 16 + r16; const int key = list[slot < nsel ? slot : 0];
            if constexpr (!SAMPLE) {
                const unsigned short* kp = R.Hb + (size_t)key * LDH + HC_K + g * 128 + 8 * q4;
#pragma unroll
                for (int st = 0; st < 4; ++st) ka[grp][st] = *(const bf16x8*)(kp + 32 * st);
            } else {
                const float* kp = (key < PAST) ? R.ck + ((size_t)(R.pt[key >> 7] * PAGE + (key & 127)) * 2 + g) * 128 : R.knew + g * 128;
                kp += 8 * q4;
#pragma unroll
                for (int st = 0; st < 4; ++st) ka[grp][st] = cvt8(*(const f32x4*)(kp + 32 * st), *(const f32x4*)(kp + 32 * st + 4));
            }
        }
#pragma unroll
        for (int i = 0; i < 8; ++i) {
            const int slot = sb + 4 * i + q4; const int key = list[slot < nsel ? slot : 0];
            if constexpr (!SAMPLE) vw[i] = *(const v4u*)(R.Hb + (size_t)key * LDH + HC_V + g * 128 + r16 * 8);
            else { const float* vp = (key < PAST) ? R.cv + ((size_t)(R.pt[key >> 7] * PAGE + (key & 127)) * 2 + g) * 128 : R.vnew + g * 128;
                   vw[i] = __builtin_bit_cast(v4u, cvt8(*(const f32x4*)(vp + r16 * 8), *(const f32x4*)(vp + r16 * 8 + 4))); }
        }
        f32x4 c[2];
#pragma unroll
        for (int grp = 0; grp < 2; ++grp) {
            c[grp] = (f32x4){0.f, 0.f, 0.f, 0.f};
#pragma unroll
            for (int st = 0; st < 4; ++st) c[grp] = __builtin_amdgcn_mfma_f32_16x16x32_bf16(ka[grp][st], qf[st], c[grp], 0, 0, 0);
#pragma unroll
            for (int r = 0; r < 4; ++r) { const int sl = sb + grp * 16 + 4 * q4 + r; c[grp][r] = sl < nsel ? c[grp][r] : -1e30f; }
        }
        float ml = fmaxf(fmaxf(fmaxf(c[0][0], c[0][1]), fmaxf(c[0][2], c[0][3])), fmaxf(fmaxf(c[1][0], c[1][1]), fmaxf(c[1][2], c[1][3])));
        ml = fmaxf(ml, __shfl_xor(ml, 16)); ml = fmaxf(ml, __shfl_xor(ml, 32));
        const float mn = fmaxf(m, ml), f = __builtin_amdgcn_exp2f(m - mn);
        m = mn; l *= f;
#pragma unroll
        for (int db = 0; db < 8; ++db) o[db] = o[db] * f;
#pragma unroll
        for (int grp = 0; grp < 2; ++grp)
#pragma unroll
            for (int r = 0; r < 4; ++r) { const float p = __builtin_amdgcn_exp2f(c[grp][r] - m); c[grp][r] = p; l += p; }
        v4u pw; pw.x = cvtpk(c[0][0], c[0][1]); pw.y = cvtpk(c[0][2], c[0][3]); pw.z = cvtpk(c[1][0], c[1][1]); pw.w = cvtpk(c[1][2], c[1][3]);
        const bf16x8 pf = __builtin_bit_cast(bf16x8, pw);
#pragma unroll
        for (int i = 0; i < 8; ++i) *(LAS v4u*)(vst + (4 * i + q4) * 288 + r16 * 16) = vw[i];
        LDS_WAIT();
#pragma unroll
        for (int db = 0; db < 8; ++db) {
            const s16x4 lo = __builtin_bit_cast(s16x4, __builtin_amdgcn_ds_read_tr16_b64_v4i16((LAS s16x4*)(vb + db * 32)));
            const s16x4 hi = __builtin_bit_cast(s16x4, __builtin_amdgcn_ds_read_tr16_b64_v4i16((LAS s16x4*)(vb + 16 * 288 + db * 32)));
            const bf16x8 vf = {lo[0], lo[1], lo[2], lo[3], hi[0], hi[1], hi[2], hi[3]};
            o[db] = __builtin_amdgcn_mfma_f32_16x16x32_bf16(vf, pf, o[db], 0, 0, 0);
        }
        LDS_WAIT();
    }
    l += __shfl_xor(l, 16); l += __shfl_xor(l, 32);
    m_out = m; l_out = l;
}

__device__ __forceinline__ void p2_prompt_item(Ctx& F, int item) {
    const int qb = 255 - (item >> 1), b = item & 1, q0 = qb * 16, rowbase = b * SEQ;
    const int nkeys = q0 + 16, ntile = (nkeys + 63) >> 6;
    int lane = F.lane, w = F.wave, tid = F.tid;
    asm volatile("" : "+v"(lane), "+v"(tid)); asm volatile("" : "+s"(w));
    LAS unsigned char* kbuf = F.lds + RING_OFF;
    LAS unsigned short* list = (LAS unsigned short*)(F.lds + RING_OFF + 32768 + w * 9728);
    LAS unsigned char* vst = F.lds + RING_OFF + 32768 + w * 9728 + 512;
    float* SCb = WSF(WS_SC) + (size_t)F.bid * (16 * 4096);
    const bf16* Hb = WSB(WS_H) + (size_t)rowbase * LDH;
    {
        const int r = lane & 31, hi = lane >> 5;
        bf16x8 qf[8]; float wv[16];
        { const int tq = q0 + 2 * w + ((r >> 2) & 1), head = (r & 3) + 4 * (r >> 3);
          const bf16* qsrc = Hb + (size_t)tq * LDH + HC_QI + head * 128 + 8 * hi;
#pragma unroll
          for (int st = 0; st < 8; ++st) qf[st] = *(const bf16x8*)(qsrc + 16 * st);
          const f32x4* wp = (const f32x4*)(WSF(WS_WI) + (size_t)(rowbase + q0 + 2 * w + hi) * 16);
#pragma unroll
          for (int j = 0; j < 4; ++j) { const f32x4 t = wp[j]; wv[4 * j] = t[0]; wv[4 * j + 1] = t[1]; wv[4 * j + 2] = t[2]; wv[4 * j + 3] = t[3]; } }
        const int tql = q0 + 2 * w + hi;
        v4u pre[2];
        const int skey[2] = {tid >> 4, (tid + 512) >> 4}; const int sc_[2] = {tid & 15, tid & 15};
#pragma unroll
        for (int i = 0; i < 2; ++i) pre[i] = *(const v4u*)(Hb + (size_t)skey[i] * LDH + HC_KI + sc_[i] * 8);
#pragma unroll
        for (int i = 0; i < 2; ++i) *(LAS v4u*)(kbuf + skey[i] * 256 + ((sc_[i] ^ (skey[i] & 15)) * 16)) = pre[i];
        __syncthreads();
        for (int kt = 0; kt < ntile; ++kt) {
            const bool more = kt + 1 < ntile;
            if (more) {
#pragma unroll
                for (int i = 0; i < 2; ++i) pre[i] = *(const v4u*)(Hb + (size_t)(64 * (kt + 1) + skey[i]) * LDH + HC_KI + sc_[i] * 8);
            }
            const LAS unsigned char* buf = kbuf + (kt & 1) * 16384;
#pragma unroll
            for (int sub = 0; sub < 2; ++sub) {
                f32x16 c = {};
#pragma unroll
                for (int st = 0; st < 8; ++st) { const bf16x8 bfr = *(const LAS bf16x8*)(buf + (sub * 32 + r) * 256 + (((2 * st + hi) ^ (r & 15)) * 16)); c = __builtin_amdgcn_mfma_f32_32x32x16_bf16(qf[st], bfr, c, 0, 0, 0); }
                float s = 0.f;
#pragma unroll
                for (int j = 0; j < 16; ++j) s += wv[j] * fmaxf(c[j], 0.f);
                const int key = 64 * kt + 32 * sub + r;
                SCb[(2 * w + hi) * 4096 + key] = key <= tql ? s : -INFINITY;
            }
            if (more) {
                LAS unsigned char* nb = kbuf + ((kt + 1) & 1) * 16384;
#pragma unroll
                for (int i = 0; i < 2; ++i) *(LAS v4u*)(nb + skey[i] * 256 + ((sc_[i] ^ (skey[i] & 15)) * 16)) = pre[i];
            }
            __syncthreads();
        }
    }
    __syncthreads();
#pragma unroll 1
    for (int qq = 0; qq < 2; ++qq) {
        const int ql = 2 * w + qq, t = q0 + ql, n = t + 1;
        int nsel;
        if (n <= 256) {
#pragma unroll
            for (int j = 0; j < 4; ++j) list[lane + 64 * j] = (unsigned short)(lane + 64 * j);
            LDS_WAIT(); nsel = n;
        } else {
            float s[64]; int ln = lane; asm volatile("" : "+v"(ln));
#pragma unroll
            for (int i = 0; i < 64; ++i) { const float v = SCb[ql * 4096 + i * 64 + lane]; s[i] = (ln <= t - i * 64) ? v : -INFINITY; }
#ifndef NO_SEL
            wave_select256<64>(s, n, lane, list); nsel = 256;
#else
            nsel = 256; list[lane] = (unsigned short)(s[3] > 0.f);
#endif
        }
        asm volatile("" : "+v"(lane) :: "memory"); __builtin_amdgcn_sched_barrier(0);
        RowSrc R; R.Hb = Hb; R.ck = nullptr; R.cv = nullptr; R.pt = nullptr; R.knew = nullptr; R.vnew = nullptr;
        const int r16 = lane & 15, q4 = lane >> 4;
#pragma unroll 1
        for (int g = 0; g < 2; ++g) {
            bf16x8 qf[4]; const bf16x8 z = {0, 0, 0, 0, 0, 0, 0, 0};
            const bf16* qp = Hb + (size_t)t * LDH + HC_Q + (g * 4 + (r16 & 3)) * 128 + 8 * q4;
#pragma unroll
            for (int st = 0; st < 4; ++st) { qf[st] = *(const bf16x8*)(qp + 32 * st); if (r16 >= 4) qf[st] = z; }
            float m, l; f32x4 o[8];
#ifndef NO_ATT
            attn_part<false>(R, g, list, 0, 8, nsel, vst, qf, m, l, o, lane);
#else
            m = 0.f; l = 1.f; for (int db = 0; db < 8; ++db) o[db] = (f32x4){1.f, 1.f, 1.f, 1.f};
#endif
            if (r16 < 4) {
                const float rl = 1.0f / l;
                const bf16* zp = Hb + (size_t)t * LDH + HC_ZA + (g * 4 + r16) * 128 + 4 * q4;
                bf16* op = WSB(WS_OAB) + (size_t)(rowbase + t) * DM + (g * 4 + r16) * 128 + 4 * q4;
#pragma unroll
                for (int db = 0; db < 8; ++db) { const v2u zz = *(const v2u*)(zp + db * 16);
                    v2u ww; ww.x = cvtpk(o[db][0] * rl * bflo(zz.x), o[db][1] * rl * bfhi(zz.x)); ww.y = cvtpk(o[db][2] * rl * bflo(zz.y), o[db][3] * rl * bfhi(zz.y));
                    *(v2u*)(op + db * 16) = ww; }
            }
        }
    }
}
__device__ __forceinline__ void p2_gmlp_item(Ctx& F, const In& I, int c) {
    int lane = F.lane, w = F.wave, tid = F.tid; const int r0 = c * 128;
    asm volatile("" : "+v"(lane), "+v"(tid)); asm volatile("" : "+s"(w));
    LAS unsigned char* tile = F.lds + RING_OFF;
    LAS float* smu = (LAS float*)(F.lds + RING_OFF + 36864); LAS float* srs = smu + 128;
    for (int rr = 0; rr < 16; ++rr) {
        const int row = 16 * w + rr; const bf16* p = WSB(WS_H) + (size_t)(r0 + row) * LDH + HC_VB;
        const v4u a = *(const v4u*)(p + lane * 8), b = *(const v4u*)(p + 512 + lane * 8);
        float x[16] = {bflo(a.x), bfhi(a.x), bflo(a.y), bfhi(a.y), bflo(a.z), bfhi(a.z), bflo(a.w), bfhi(a.w), bflo(b.x), bfhi(b.x), bflo(b.y), bfhi(b.y), bflo(b.z), bfhi(b.z), bflo(b.w), bfhi(b.w)};
        float s = 0.f;
#pragma unroll
        for (int j = 0; j < 16; ++j) s += x[j];
        const float mu = wave_sum(s) * (1.f / 1024.f); float qv = 0.f;
#pragma unroll
        for (int j = 0; j < 16; ++j) { const float d = x[j] - mu; qv += d * d; }
        const float rs = 1.0f / sqrtf(wave_sum(qv) * (1.f / 1024.f) + LN_EPS);
        if (lane == 0) { smu[row] = mu; srs[row] = rs; }
    }
    __syncthreads();
    const int i16 = lane & 15, q4 = lane >> 4, t = 16 * w + i16, nks = (w >> 1) + 1;
    for (int g = 0; g < 8; ++g) {
#pragma unroll
        for (int i = 0; i < 4; ++i) { const int p = tid + 512 * i, row = p >> 4, ch = p & 15;
            *(LAS v4u*)(tile + row * 288 + ch * 16) = *(const v4u*)(WSB(WS_H) + (size_t)(r0 + row) * LDH + HC_VB + g * 128 + ch * 8); }
        __syncthreads();
        f32x4 acc[8];
#pragma unroll
        for (int db = 0; db < 8; ++db) acc[db] = (f32x4){0.f, 0.f, 0.f, 0.f};
        float c1 = 0.f, c2 = 0.f;
        for (int ks = 0; ks < nks; ++ks) {
            const int s0 = 32 * ks + 8 * q4;
            const float* wrow = I.wsp + ((size_t)(g * 128 + t) * 128 + s0);
            const f32x4 w0 = *(const f32x4*)wrow, w1 = *(const f32x4*)(wrow + 4);
            float wv[8] = {w0[0], w0[1], w0[2], w0[3], w1[0], w1[1], w1[2], w1[3]};
#pragma unroll
            for (int j = 0; j < 8; ++j) { const int s = s0 + j; const float x = (s <= t) ? wv[j] : 0.f; c2 += x; const float xp = x * srs[s]; c1 += xp * smu[s]; wv[j] = xp; }
            const bf16x8 wf = cvt8((f32x4){wv[0], wv[1], wv[2], wv[3]}, (f32x4){wv[4], wv[5], wv[6], wv[7]});
            const LAS unsigned char* vb = tile + (32 * ks + 8 * q4 + (i16 >> 2)) * 288 + (i16 & 3) * 8;
#pragma unroll
            for (int db = 0; db < 8; ++db) {
                const s16x4 lo = __builtin_bit_cast(s16x4, __builtin_amdgcn_ds_read_tr16_b64_v4i16((LAS s16x4*)(vb + db * 32)));
                const s16x4 hi = __builtin_bit_cast(s16x4, __builtin_amdgcn_ds_read_tr16_b64_v4i16((LAS s16x4*)(vb + 4 * 288 + db * 32)));
                const bf16x8 vf = {lo[0], lo[1], lo[2], lo[3], hi[0], hi[1], hi[2], hi[3]};
                acc[db] = __builtin_amdgcn_mfma_f32_16x16x32_bf16(vf, wf, acc[db], 0, 0, 0);
            }
        }
        c1 += __shfl_xor(c1, 16); c1 += __shfl_xor(c1, 32); c2 += __shfl_xor(c2, 16); c2 += __shfl_xor(c2, 32);
        const float bt = I.bsp[g * 128 + t];
        const bf16* hrow = WSB(WS_H) + (size_t)(r0 + t) * LDH; bf16* orow = WSB(WS_OAB) + (size_t)(r0 + t) * DM + 1024;
#pragma unroll
        for (int db = 0; db < 8; ++db) { const int ch0 = g * 128 + db * 16 + 4 * q4;
            const f32x4 lg = *(const f32x4*)(I.lng + ch0), lb = *(const f32x4*)(I.lnb + ch0);
            const v2u uu = *(const v2u*)(hrow + HC_U + ch0), zz = *(const v2u*)(hrow + HC_ZB + ch0);
            float mx[4];
#pragma unroll
            for (int r = 0; r < 4; ++r) mx[r] = lg[r] * (acc[db][r] - c1) + lb[r] * c2 + bt;
            v2u ww; ww.x = cvtpk(bflo(uu.x) * mx[0] * bflo(zz.x), bfhi(uu.x) * mx[1] * bfhi(zz.x)); ww.y = cvtpk(bflo(uu.y) * mx[2] * bflo(zz.y), bfhi(uu.y) * mx[3] * bfhi(zz.y));
            *(v2u*)(orow + ch0) = ww; }
        __syncthreads();
    }
}
__device__ __forceinline__ void p2_sscore_item(Ctx& F, const In& I, int item) {
    int lane = F.lane, w = F.wave; asm volatile("" : "+v"(lane)); asm volatile("" : "+s"(w));
    const int s = item >> 4, page = (item & 15) * 8 + w, r16 = lane & 15, q4 = lane >> 4;
    const float* hs = WSF(WS_HS) + (size_t)s * LDH;
    bf16x8 qf[4];
#pragma unroll
    for (int st = 0; st < 4; ++st) { const float* p = hs + HC_QI + r16 * 128 + st * 32 + 8 * q4; qf[st] = cvt8(*(const f32x4*)p, *(const f32x4*)(p + 4)); }
    const f32x4 wv = *(const f32x4*)(hs + HC_WI + 4 * q4);
    const int phys = I.pt[s * NPAGES + page];
    const float* kb = I.cki + (size_t)phys * PAGE * 128;
    for (int grp = 0; grp < 8; ++grp) {
        const float* kp = kb + (size_t)(grp * 16 + r16) * 128 + 8 * q4;
        f32x4 c = {0.f, 0.f, 0.f, 0.f};
#pragma unroll
        for (int st = 0; st < 4; ++st) { const bf16x8 kf = cvt8(*(const f32x4*)(kp + 32 * st), *(const f32x4*)(kp + 32 * st + 4)); c = __builtin_amdgcn_mfma_f32_16x16x32_bf16(qf[st], kf, c, 0, 0, 0); }
        float v = wv[0] * fmaxf(c[0], 0.f) + wv[1] * fmaxf(c[1], 0.f) + wv[2] * fmaxf(c[2], 0.f) + wv[3] * fmaxf(c[3], 0.f);
        v += __shfl_xor(v, 16); v += __shfl_xor(v, 32);
        if (lane < 16) WSF(WS_SSC)[(size_t)s * SSC_LD + page * 128 + grp * 16 + lane] = v;
    }
}

__device__ __forceinline__ void p3_sample_item(Ctx& F, const In& I, int s) {
    const int lane = F.lane, w = F.wave, tid = F.tid, r16 = lane & 15, q4 = lane >> 4;
    LAS unsigned short* cand = (LAS unsigned short*)(F.lds + RING_OFF);
    LAS unsigned short* fin = (LAS unsigned short*)(F.lds + RING_OFF + 4096);
    LAS unsigned short* tmp = (LAS unsigned short*)(F.lds + RING_OFF + 4608);
    LAS float* snew = (LAS float*)(F.lds + RING_OFF + 5120);
    LAS float* comb = (LAS float*)(F.lds + RING_OFF + 8192);
    LAS unsigned char* vst = F.lds + RING_OFF + 32768 + w * 9216;
    const float* hs = WSF(WS_HS) + (size_t)s * LDH;
    float* ssc = WSF(WS_SSC) + (size_t)s * SSC_LD;
    if (w == 0) {
        const int h = lane >> 2, part = lane & 3; float d = 0.f;
        const float* qp = hs + HC_QI + h * 128 + part * 32; const float* kp = hs + HC_KI + part * 32;
#pragma unroll
        for (int j = 0; j < 32; ++j) d += bf2f((unsigned short)f2bf(qp[j])) * bf2f((unsigned short)f2bf(kp[j]));
        d += __shfl_xor(d, 1); d += __shfl_xor(d, 2);
        float cn = (part == 0) ? hs[HC_WI + h] * fmaxf(d, 0.f) : 0.f;
        cn = wave_sum(cn);
        if (lane == 0) { snew[0] = cn; ssc[PAST] = cn; }
    }
    {
        float sv[32];
#pragma unroll
        for (int i = 0; i < 32; ++i) sv[i] = ssc[w * 2048 + i * 64 + lane];
        wave_select256<32>(sv, 2048, lane, cand + w * 256);
    }
    __syncthreads();
    if (w == 0) {
        float sv[33];
#pragma unroll
        for (int i = 0; i < 32; ++i) { const int cidx = i * 64 + lane; const int key = (cidx >> 8) * 2048 + cand[cidx]; sv[i] = ssc[key]; }
        sv[32] = lane == 0 ? snew[0] : -INFINITY;
        wave_select256<33>(sv, 2049, lane, tmp);
#pragma unroll
        for (int j = 0; j < 4; ++j) { const int slot = tmp[lane + 64 * j]; fin[lane + 64 * j] = (unsigned short)(slot >= 2048 ? PAST : (slot >> 8) * 2048 + cand[slot]); }
        LDS_WAIT();
    }
    __syncthreads();
    {
        const int g = w & 1, part = w >> 1;
        RowSrc R; R.Hb = nullptr; R.ck = I.ck; R.cv = I.cv; R.pt = I.pt + s * NPAGES; R.knew = F.out + O_KS + s * 256; R.vnew = F.out + O_VS + s * 256;
        bf16x8 qf[4]; const bf16x8 z = {0, 0, 0, 0, 0, 0, 0, 0};
        const float* qp = hs + HC_Q + (g * 4 + (r16 & 3)) * 128 + 8 * q4;
#pragma unroll
        for (int st = 0; st < 4; ++st) { qf[st] = cvt8(*(const f32x4*)(qp + 32 * st), *(const f32x4*)(qp + 32 * st + 4)); if (r16 >= 4) qf[st] = z; }
        float m, l; f32x4 o[8];
        attn_part<true>(R, g, fin, part * 64, 2, 256, vst, qf, m, l, o, lane);
        LAS float* cw = comb + w * 520;
        if (r16 < 4) {
            if (q4 == 0) { cw[r16] = m; cw[4 + r16] = l; }
#pragma unroll
            for (int db = 0; db < 8; ++db)
#pragma unroll
                for (int r = 0; r < 4; ++r) cw[8 + (db * 16 + 4 * q4 + r) * 4 + r16] = o[db][r];
        }
    }
    __syncthreads();
    for (int e = tid; e < 1024; e += 512) {
        const int hh = e >> 7, d = e & 127, g = hh >> 2, h = hh & 3;
        float M = -1e30f;
#pragma unroll
        for (int p = 0; p < 4; ++p) M = fmaxf(M, comb[(g + 2 * p) * 520 + h]);
        float num = 0.f, den = 0.f;
#pragma unroll
        for (int p = 0; p < 4; ++p) { const LAS float* cw = comb + (g + 2 * p) * 520; const float f = __builtin_amdgcn_exp2f(cw[h] - M); num += cw[8 + d * 4 + h] * f; den += cw[4 + h] * f; }
        const float v = num / den * hs[HC_ZA + hh * 128 + d];
        WSB(WS_OABS)[(size_t)s * DM + hh * 128 + d] = (bf16)f2bf(v);
    }
    if (w == 1) {
        float x[16]; float sum = 0.f;
#pragma unroll
        for (int j = 0; j < 16; ++j) { x[j] = hs[HC_VB + lane + 64 * j]; sum += x[j]; }
        const float mu = wave_sum(sum) * (1.f / 1024.f); float qv = 0.f;
#pragma unroll
        for (int j = 0; j < 16; ++j) { const float d = x[j] - mu; qv += d * d; }
        const float rs = 1.0f / sqrtf(wave_sum(qv) * (1.f / 1024.f) + LN_EPS);
#pragma unroll
        for (int j = 0; j < 16; ++j) { const int ch = lane + 64 * j, g = ch >> 7;
            const float vn = (x[j] - mu) * rs * I.lng[ch] + I.lnb[ch];
            F.out[O_GV + s * 1024 + ch] = vn;
            const float ob = hs[HC_U + ch] * (I.wsp[(size_t)g * 128 * 128] * vn + I.bsp[g * 128]) * hs[HC_ZB + ch];
            WSB(WS_OABS)[(size_t)s * DM + 1024 + ch] = (bf16)f2bf(ob); }
    }
    __syncthreads();
}

__global__ void __launch_bounds__(512, 2) mk_fwd(Args args) {
    extern __shared__ __attribute__((aligned(16))) unsigned char lds_raw[];
    Ctx F;
    F.lds = (LAS unsigned char*)lds_raw;
    F.tid = threadIdx.x; F.lane = F.tid & 63; F.wave = __builtin_amdgcn_readfirstlane(F.tid >> 6); F.G = gridDim.x; F.bid = blockIdx.x;
    F.out = args.out; F.ws = args.ws;
    volatile LAS unsigned* MISC = (volatile LAS unsigned*)(F.lds + MISC_OFF);
    for (int u = F.tid; u < (LDS_BYTES - LDSCTL_OFF) / 4; u += 512) ((LAS unsigned*)(F.lds + LDSCTL_OFF))[u] = 0u;
    __syncthreads();
    XcdBarrier bar; bar.bar = (unsigned*)(((gu32*)(F.ws + WS_CTL)) + CW_BAR); bar.x = 0; bar.st = nullptr;
    if (MK_N_LAUNCHES == 1) bar = xcd_barrier_post((unsigned*)(((gu32*)(F.ws + WS_CTL)) + CW_BAR), MISC + 8);
    const int lo = args.ph_lo, hi = args.ph_hi;
#ifndef PH_MASK
#define PH_MASK 0x7f
#endif
#define IN(k) (((PH_MASK >> (k)) & 1) && lo <= (k) && (k) < hi)
#define SEAM(k) do { if (IN(k) && IN((k) + 1)) xcd_barrier(bar); } while (0)

    if (IN(0)) { In I{}; I.win = (const float*)args.in[7]; I.wpa = (const float*)args.in[8]; I.wpb = (const float*)args.in[9]; I.wo = (const float*)args.in[10]; I.xp = (const float*)args.in[0]; I.xs = (const float*)args.in[1]; I.gin = (const float*)args.in[6]; p0_prologue(F, I); }
    SEAM(0);
    if (IN(1)) {
        p1_sample_inproj(F);
        pg8::Gemm g{WSB(WS_XN), WSB(WS_XN), WSB(WS_WTIN), WSB(WS_WTIN), DM, DM, DM}; pg8::StaticOrder S; S.init(MP, LDH, F.G, F.bid);
        pg8::EpiInProj E{WSB(WS_H), F.out, WSF(WS_WI)};
        pg8::gemm_phase<pg8::EpiInProj, pg8::StaticOrder, true, true>(F.lds + RING_OFF, g, S, E);
    }
    SEAM(1);
    if (IN(2)) {
        In I{}; I.cki = (const float*)args.in[4]; I.pt = (const int*)args.in[5]; I.lng = (const float*)args.in[11]; I.lnb = (const float*)args.in[12]; I.wsp = (const float*)args.in[13]; I.bsp = (const float*)args.in[14];
        LAS int* slot = (LAS int*)(F.lds + LDSCTL_OFF);
        for (;;) {
            __syncthreads();
            if (F.tid == 0) *slot = (int)__hip_atomic_fetch_add((unsigned*)(((gu32*)(F.ws + WS_CTL)) + CW_Q2), 1u, __ATOMIC_RELAXED, __HIP_MEMORY_SCOPE_AGENT);
            __syncthreads();
            const int item = __builtin_amdgcn_readfirstlane(*slot);
            if (item >= 512 + 64 + 128) break;
#ifndef P2SEL
#define P2SEL 7
#endif
            if (item < 512) { if (P2SEL & 1) p2_prompt_item(F, item); }
            else if (item < 576) { if (P2SEL & 2) p2_gmlp_item(F, I, item - 512); }
            else { if (P2SEL & 4) p2_sscore_item(F, I, item - 576); }
        }
    }
    SEAM(2);
    if (IN(3)) {
        if (F.bid < NS) { In I{}; I.ck = (const float*)args.in[2]; I.cv = (const float*)args.in[3]; I.pt = (const int*)args.in[5]; I.lng = (const float*)args.in[11]; I.lnb = (const float*)args.in[12]; I.wsp = (const float*)args.in[13]; I.bsp = (const float*)args.in[14]; p3_sample_item(F, I, F.bid); }
        pg8::Gemm g{WSB(WS_OAB), WSB(WS_OAB) + 1024, WSB(WS_WTA), WSB(WS_WTB), DM, 1024, 1024}; pg8::PairOrder S; S.init(MP, DM, F.G, F.bid);
        pg8::EpiMix E{WSB(WS_H), WSB(WS_MIX)};
        pg8::gemm_phase<pg8::EpiMix, pg8::PairOrder, true, true>(F.lds + RING_OFF, g, S, E);
    }
    SEAM(3);
    if (IN(4)) {
        if (F.bid < 128) {
            LAS float* red = (LAS float*)(F.lds + RING_OFF);
            const int n0 = 16 * F.bid;
            f32x4 ya = sgemv_part(WSB(WS_OABS), DM, WSB(WS_WTA), 1024, n0, F.wave * 128, 4, F.lane);
            f32x4 yb = sgemv_part(WSB(WS_OABS) + 1024, DM, WSB(WS_WTB), 1024, n0, F.wave * 128, 4, F.lane);
            ya = block_reduce8(ya, red, F.wave, F.lane); yb = block_reduce8(yb, red, F.wave, F.lane);
            if (F.wave == 0 && F.lane < 32) {
#pragma unroll
                for (int j = 0; j < 4; ++j) { const int s = 4 * (F.lane >> 4) + j, n = n0 + (F.lane & 15);
                    const float v = WSF(WS_HS)[(size_t)s * LDH + HC_GA + n] * ya[j] + WSF(WS_HS)[(size_t)s * LDH + HC_GB + n] * yb[j];
                    WSB(WS_MIXS)[(size_t)s * DM + n] = (bf16)f2bf(v); }
            }
            __syncthreads();
        }
        pg8::Gemm g{WSB(WS_MIX), WSB(WS_MIX), WSB(WS_WTO), WSB(WS_WTO), DM, DM, DM}; pg8::StaticOrder S; S.init(MP, DM, F.G, F.bid);
        pg8::EpiOut E{(const float*)args.in[0], F.out, WSF(WS_PS)};
        pg8::gemm_phase<pg8::EpiOut, pg8::StaticOrder, false, true>(F.lds + RING_OFF, g, S, E);
    }
    SEAM(4);
    if (IN(5)) {
        if (F.bid < 128) {
            LAS float* red = (LAS float*)(F.lds + RING_OFF);
            const int n0 = 16 * F.bid;
            f32x4 y = sgemv_part(WSB(WS_MIXS), DM, WSB(WS_WTO), DM, n0, F.wave * 256, 8, F.lane);
            y = block_reduce8(y, red, F.wave, F.lane);
            if (F.wave == 0 && F.lane < 32) {
#pragma unroll
                for (int j = 0; j < 4; ++j) { const int s = 4 * (F.lane >> 4) + j, n = n0 + (F.lane & 15); WSF(WS_XSO)[(size_t)s * DM + n] = ((const float*)args.in[1])[(size_t)s * DM + n] + y[j]; }
            }
        }
        const int gw = F.bid * 8 + F.wave, NGW = F.G * 8;
        for (int m = gw; m < MP; m += NGW) {
            const f32x4 p0 = *(const f32x4*)(WSF(WS_PS) + (size_t)m * 8), p1 = *(const f32x4*)(WSF(WS_PS) + (size_t)m * 8 + 4);
            const float ss = ((p0[0] + p0[1]) + (p0[2] + p0[3])) + ((p1[0] + p1[1]) + (p1[2] + p1[3]));
            const float rstd = 1.0f / sqrtf(ss * (1.f / DM) + RMS_EPS);
            f32x4* row = (f32x4*)(F.out + O_YP + (size_t)m * DM) + F.lane; const f32x4* gr = (const f32x4*)args.in[15] + F.lane;
#pragma unroll
            for (int j = 0; j < 8; ++j) { const f32x4 v = row[64 * j], gg = gr[64 * j]; row[64 * j] = v * rstd * gg; }
        }
    }
    SEAM(5);
    if (IN(6)) {
        const int gw = F.bid * 8 + F.wave;
        if (gw < NS) {
            const f32x4* xr = (const f32x4*)(WSF(WS_XSO) + (size_t)gw * DM) + F.lane; const f32x4* gr = (const f32x4*)args.in[15] + F.lane;
            f32x4 v[8]; float s = 0.f;
#pragma unroll
            for (int j = 0; j < 8; ++j) { v[j] = xr[64 * j]; s += (v[j].x * v[j].x + v[j].y * v[j].y) + (v[j].z * v[j].z + v[j].w * v[j].w); }
            const float rstd = 1.0f / sqrtf(wave_sum(s) * (1.f / DM) + RMS_EPS);
            f32x4* o = (f32x4*)(F.out + O_YS + (size_t)gw * DM) + F.lane;
#pragma unroll
            for (int j = 0; j < 8; ++j) o[64 * j] = v[j] * rstd * gr[64 * j];
        }
    }
#undef IN
#undef SEAM
}

extern "C" void kernel_launch(void* const* d_in, const int* in_sizes, int n_in, void* d_out, int out_size, void* d_ws, size_t ws_size, hipStream_t stream) {
    static int grid = 0;
    if (grid == 0) {
        if (n_in != 16 || out_size != (int)O_END || ws_size < WS_END) { fprintf(stderr, "kernel_launch: unexpected shapes: n_in %d out %d ws %zu\n", n_in, out_size, ws_size); grid = -1; return; }
        int dev = 0, cus = 0;
        if (hipGetDevice(&dev) != hipSuccess || hipDeviceGetAttribute(&cus, hipDeviceAttributeMultiprocessorCount, dev) != hipSuccess) { grid = -1; return; }
        if (hipFuncSetAttribute((const void*)mk_fwd, hipFuncAttributeMaxDynamicSharedMemorySize, LDS_BYTES) != hipSuccess) { fprintf(stderr, "kernel_launch: hipFuncSetAttribute failed\n"); grid = -1; return; }
        int per_cu = 0;
        if (hipOccupancyMaxActiveBlocksPerMultiprocessor(&per_cu, (const void*)mk_fwd, 512, LDS_BYTES) != hipSuccess || per_cu < 1) fprintf(stderr, "kernel_launch: occupancy query reports %d\n", per_cu);
        (void)hipGetLastError();
        grid = cus;
        if (grid != 256) fprintf(stderr, "kernel_launch: %d CUs; this kernel is laid out for 256\n", grid);
    }
    if (grid < 0) return;
    (void)hipMemsetAsync((char*)d_ws + WS_CTL, 0, CTL_ZERO_BYTES, stream);
    Args a{};
    for (int i = 0; i < 16; ++i) a.in[i] = d_in[i];
    a.out = (float*)d_out; a.ws = (unsigned char*)d_ws;
    constexpr int NPH = 7;
    if (MK_N_LAUNCHES == 1) { a.ph_lo = 0; a.ph_hi = NPH; a.li = 0; hipLaunchKernelGGL(mk_fwd, dim3(grid), dim3(512), LDS_BYTES, stream, a); }
    else for (int p = 0; p < NPH; ++p) { a.ph_lo = p; a.ph_hi = p + 1; a.li = p; hipLaunchKernelGGL(mk_fwd, dim3(grid), dim3(512), LDS_BYTES, stream, a); }
}
```

```cpp
#include <hip/hip_runtime.h>
#include <cstdio>
#include <cstdint>
#include <cmath>

#ifndef MK_N_LAUNCHES
#define MK_N_LAUNCHES 1
#endif

constexpr int DM = 2048, SEQ = 4096, NBATCH = 2, MP = NBATCH * SEQ, NS = 8, PAST = 16384, NPAGES = 128, PAGE = 128;
constexpr int LDH = 12032;
constexpr int HC_Q = 0, HC_K = 1024, HC_V = 1280, HC_QI = 1536, HC_WI = 3584, HC_KI = 3600, HC_ZA = 3840, HC_U = 4864, HC_VB = 5888, HC_ZB = 6912, HC_GA = 7936, HC_GB = 9984;
constexpr int IN_WIDTH = 11920;
constexpr float QSCALE = 0.08838834764831845f * 1.4426950408889634f;
constexpr float WSCALE = 0.25f * 0.08838834764831845f;
constexpr float RMS_EPS = 1e-6f, LN_EPS = 1e-5f;
constexpr size_t O_YP = 0, O_YS = 16777216, O_KP = 16793600, O_VP = 18890752, O_KIP = 20987904, O_KS = 22036480, O_VS = 22038528, O_KIS = 22040576, O_GV = 22041600, O_END = 22049792;
constexpr size_t MiB = 1u << 20;
constexpr size_t WS_CTL = 0, CTL_ZERO_BYTES = 1 * MiB;
constexpr size_t WS_WTIN = 2 * MiB, WS_WTA = 50 * MiB, WS_WTB = 54 * MiB, WS_WTO = 58 * MiB, WS_XN = 66 * MiB, WS_XNS = 98 * MiB, WS_HS = 99 * MiB, WS_SSC = 100 * MiB;
constexpr size_t WS_OABS = 101 * MiB, WS_MIXS = 101 * MiB + 256 * 1024, WS_XSO = 101 * MiB + 512 * 1024, WS_PS = 102 * MiB, WS_WI = 103 * MiB;
constexpr size_t WS_H = 104 * MiB, WS_OAB = 292 * MiB, WS_MIX = 324 * MiB, WS_SC = 356 * MiB, WS_END = 420 * MiB;
constexpr int SSC_LD = 16448;
static_assert(WS_WTIN + (size_t)LDH * DM * 2 <= WS_WTA && WS_H + (size_t)MP * LDH * 2 <= WS_OAB && WS_WI + (size_t)MP * 16 * 4 <= WS_H, "ws map");
constexpr int CW_Q2 = 64;
constexpr int CW_BAR = 4096;

#define GAS __attribute__((address_space(1)))
#define LAS __attribute__((address_space(3)))
typedef unsigned short bf16;
typedef unsigned v4u __attribute__((ext_vector_type(4)));
typedef unsigned v2u __attribute__((ext_vector_type(2)));
typedef float f32x4 __attribute__((ext_vector_type(4)));
typedef float f32x2 __attribute__((ext_vector_type(2)));
typedef float f32x16 __attribute__((ext_vector_type(16)));
typedef short bf16x8 __attribute__((ext_vector_type(8)));
typedef short s16x4 __attribute__((ext_vector_type(4)));
typedef __bf16 bf16x2_t __attribute__((ext_vector_type(2)));
typedef GAS unsigned gu32;
#define LDS_WAIT() asm volatile("s_waitcnt lgkmcnt(0)" ::: "memory")
#define VM_WAIT() asm volatile("s_waitcnt vmcnt(0)" ::: "memory")

__device__ __forceinline__ unsigned cvtpk(float lo, float hi) { f32x2 v = {lo, hi}; bf16x2_t b = __builtin_convertvector(v, bf16x2_t); return __builtin_bit_cast(unsigned, b); }
__device__ __forceinline__ float bf2f(unsigned short h) { return __uint_as_float((unsigned)h << 16); }
__device__ __forceinline__ float bflo(unsigned w) { return __uint_as_float(w << 16); }
__device__ __forceinline__ float bfhi(unsigned w) { return __uint_as_float(w & 0xffff0000u); }
__device__ __forceinline__ bf16x8 cvt8(f32x4 a, f32x4 b) { v4u w; w.x = cvtpk(a[0], a[1]); w.y = cvtpk(a[2], a[3]); w.z = cvtpk(b[0], b[1]); w.w = cvtpk(b[2], b[3]); return __builtin_bit_cast(bf16x8, w); }
__device__ __forceinline__ float sigmoid_(float x) { return __builtin_amdgcn_rcpf(1.f + __builtin_amdgcn_exp2f(-1.4426950408889634f * x)); }
__device__ __forceinline__ float silu_(float x) { return x * sigmoid_(x); }
__device__ __forceinline__ float wave_sum(float v) {
#pragma unroll
    for (int o = 1; o < 64; o <<= 1) v += __shfl_xor(v, o);
    return v;
}
__device__ __forceinline__ int wave_sum_i(int v) {
#pragma unroll
    for (int o = 1; o < 64; o <<= 1) v += __shfl_xor(v, o);
    return v;
}
__device__ __forceinline__ float wave_max(float v) {
#pragma unroll
    for (int o = 1; o < 64; o <<= 1) v = fmaxf(v, __shfl_xor(v, o));
    return v;
}
__device__ __forceinline__ float wave_min(float v) {
#pragma unroll
    for (int o = 1; o < 64; o <<= 1) v = fminf(v, __shfl_xor(v, o));
    return v;
}

namespace pg8 {
#define PG8_LAS __attribute__((address_space(3)))
typedef unsigned short bf16_t;
typedef unsigned u32x4 __attribute__((ext_vector_type(4)));
constexpr int BM = 256, BK = 64, HALF = 128, HTB = HALF * BK * 2, STAGE_BYTES = 8 * HTB, NXCD = 8, WGM = 8;
__host__ __device__ __forceinline__ int lds_byte(int r, int c) { const int st = (r >> 4) * 2 + (c >> 5), rr = r & 15, cc = c & 31, ob = rr * 64 + cc * 2; return st * 1024 + (ob ^ (((ob >> 9) & 1) << 5)); }
__host__ __device__ __forceinline__ void stage_rc(int b, int& R, int& C) { const int st = b / 1024, sb = b % 1024, swz = sb ^ (((sb >> 9) & 1) << 5); R = (st >> 1) * 16 + swz / 64; C = (st & 1) * 32 + (swz % 64) / 2; }
__host__ __device__ __forceinline__ int perm32(int rho) { const int n = rho >> 4, i = rho & 15; return 8 * (i >> 2) + 4 * n + (i & 3); }
struct Unit { int pm, pn, kind; };
struct Gemm { const bf16_t* A0; const bf16_t* A1; const bf16_t* B0; const bf16_t* B1; int lda, ldb, K; };
struct StaticOrder {
    int nM, nN, nwg, G, c;
    __host__ __device__ void init(int M, int N, int G_, int c_) { nM = M / BM; nN = N / BM; nwg = nM * nN; G = G_; c = c_; }
    __host__ __device__ bool tile(long L, Unit& u) const {
        if (L >= nwg) return false;
        int wgid = (int)L; { const int q = nwg / NXCD, r = nwg % NXCD, xcd = wgid % NXCD, off = wgid / NXCD; wgid = (xcd < r ? xcd * (q + 1) : r * (q + 1) + (xcd - r) * q) + off; }
        const int nig = WGM * nN, gid = wgid / nig, fm = gid * WGM, gsz = (nM - fm) < WGM ? (nM - fm) : WGM;
        u.pm = fm + ((wgid % nig) % gsz); u.pn = (wgid % nig) / gsz; u.kind = 0; return true;
    }
    __host__ __device__ bool next(int i, Unit& u) const { return tile((long)i * G + c, u); }
};
struct PairOrder : StaticOrder {
    __host__ __device__ bool next(int i, Unit& u) const { if (i >= 2) return false; const bool ok = tile((long)c, u); u.kind = i; return ok; }
};

template <class Epi, class Sched, bool ALIGN_EPI = false, bool SP2 = false>
__device__ __forceinline__ void gemm_phase(PG8_LAS unsigned char* lds, const Gemm g, const Sched& S, const Epi& E) {
    const int tid = threadIdx.x, wid = __builtin_amdgcn_readfirstlane(tid >> 6), lane = tid & 63, wr = wid >> 2, wc = wid & 3, fr = lane & 15, fq = lane >> 4;
    const int K = g.K, nt = K / BK;
    unsigned voffA[2], voffB[2];
#pragma unroll
    for (int i = 0; i < 2; ++i) { int R, C; stage_rc(tid * 16 + i * 8192, R, C); const int Rb = Epi::PERM ? ((R & ~31) + perm32(R & 31)) : R;
        voffA[i] = (unsigned)(R * g.lda + C) * 2u; voffB[i] = (unsigned)(Rb * g.ldb + C) * 2u; }
    const size_t kstep = (size_t)(BK * 2);
    const size_t hstepA = (size_t)HALF * g.lda * 2, hstepB = (size_t)HALF * g.ldb * 2;
    const size_t tstepA = 2 * hstepA, tstepB = 2 * hstepB;
    const unsigned ldsw = (unsigned)wid * 1024u;
    const int aoff = lds_byte(wr * 64 + fr, fq * 8), boff = lds_byte(wc * 32 + fr, fq * 8);
#define PG8_SA(b, h) (((b) * 2 + (h)) * HTB)
#define PG8_SB(b, h) ((4 + (b) * 2 + (h)) * HTB)
#define PG8_STAGE(bufoff, gbase, voff) do { _Pragma("unroll") for (int _i = 0; _i < 2; ++_i) \
        __builtin_amdgcn_global_load_lds((const unsigned*)((const char*)(gbase) + (voff)[_i]), (PG8_LAS unsigned*)(lds + (bufoff) + ldsw + _i * 8192), 16, 0, 0); } while (0)
#define PG8_LDA(dst, b, h) do { _Pragma("unroll") for (int m = 0; m < 4; ++m) _Pragma("unroll") for (int k = 0; k < 2; ++k) dst[m][k] = *(const PG8_LAS bf16x8*)(lds + PG8_SA(b, h) + aoff + m * 2048 + k * 1024); } while (0)
#define PG8_LDB(dst, b, h) do { _Pragma("unroll") for (int n = 0; n < 2; ++n) _Pragma("unroll") for (int k = 0; k < 2; ++k) dst[n][k] = *(const PG8_LAS bf16x8*)(lds + PG8_SB(b, h) + boff + n * 2048 + k * 1024); } while (0)
#define PG8_MMA(ai, bj, At, Bt) do { __builtin_amdgcn_s_setprio(1); _Pragma("unroll") for (int m = 0; m < 4; ++m) _Pragma("unroll") for (int n = 0; n < 2; ++n) _Pragma("unroll") for (int k = 0; k < 2; ++k) \
        acc[ai][bj][m][n] = __builtin_amdgcn_mfma_f32_16x16x32_bf16(Bt[n][k], At[m][k], acc[ai][bj][m][n], 0, 0, 0); __builtin_amdgcn_s_setprio(0); } while (0)
#define PG8_WAIT_V(n) asm volatile("s_waitcnt vmcnt(" #n ")" ::: "memory")
#define PG8_WAIT_L(n) asm volatile("s_waitcnt lgkmcnt(" #n ")" ::: "memory")
#define PG8_BAR __builtin_amdgcn_s_barrier()
#define PG8_SCHED __builtin_amdgcn_sched_barrier(0)
#define PG8_OPA(u) ((const char*)((u).kind ? g.A1 : g.A0) + (size_t)(u).pm * tstepA)
#define PG8_OPB(u) ((const char*)((u).kind ? g.B1 : g.B0) + (size_t)(u).pn * tstepB)
    Unit cur, nxt; int ui = 0;
    if (!S.next(0, cur)) return;
    f32x4 acc[2][2][4][2];
#pragma unroll
    for (int a = 0; a < 2; ++a)
#pragma unroll
        for (int b = 0; b < 2; ++b)
#pragma unroll
            for (int m = 0; m < 4; ++m)
#pragma unroll
                for (int n = 0; n < 2; ++n) acc[a][b][m][n] = (f32x4){0.f, 0.f, 0.f, 0.f};
    bf16x8 At[4][2], B0[2][2], B1[2][2];
    const char* cA = PG8_OPA(cur); const char* cB = PG8_OPB(cur);
    if constexpr (SP2) {
        PG8_STAGE(PG8_SB(0, 0), cB, voffB); PG8_STAGE(PG8_SB(0, 1), cB + hstepB, voffB); PG8_STAGE(PG8_SA(0, 0), cA, voffA); PG8_STAGE(PG8_SA(0, 1), cA + hstepA, voffA);
        if (wr == 1) PG8_BAR;
        PG8_WAIT_V(2); PG8_BAR;
        PG8_STAGE(PG8_SB(1, 0), cB + kstep, voffB); PG8_STAGE(PG8_SA(1, 0), cA + kstep, voffA); PG8_STAGE(PG8_SB(1, 1), cB + hstepB + kstep, voffB);
        PG8_WAIT_V(6); PG8_BAR;
    } else {
        PG8_STAGE(PG8_SB(0, 0), cB, voffB); PG8_STAGE(PG8_SA(0, 0), cA, voffA); PG8_STAGE(PG8_SB(0, 1), cB + hstepB, voffB); PG8_STAGE(PG8_SA(0, 1), cA + hstepA, voffA);
        if (wr == 1) PG8_BAR;
        PG8_WAIT_V(4); PG8_BAR;
        PG8_STAGE(PG8_SB(1, 0), cB + kstep, voffB); PG8_STAGE(PG8_SA(1, 0), cA + kstep, voffA); PG8_STAGE(PG8_SB(1, 1), cB + hstepB + kstep, voffB);
        PG8_WAIT_V(6); PG8_BAR;
    }
    for (;;) {
        const bool has_next = S.next(ui + 1, nxt);
        const char* nA = has_next ? PG8_OPA(nxt) : cA; const char* nB = has_next ? PG8_OPB(nxt) : cB;
        for (int t = 0; t < nt; t += 2) {
            const bool last = (t == nt - 2);
            const char* a1 = cA + (size_t)(t + 1) * kstep;
            const char* a2 = last ? nA : cA + (size_t)(t + 2) * kstep; const char* b2 = last ? nB : cB + (size_t)(t + 2) * kstep;
            const char* a3 = a2 + kstep; const char* b3 = b2 + kstep;
            if constexpr (SP2) {
            PG8_LDB(B0, 0, 0); PG8_LDB(B1, 0, 1); PG8_SCHED; PG8_LDA(At, 0, 0); PG8_STAGE(PG8_SA(1, 1), a1 + hstepA, voffA);
            PG8_WAIT_V(8); PG8_WAIT_L(0); PG8_BAR; PG8_MMA(0, 0, At, B0); PG8_MMA(0, 1, At, B1); PG8_BAR; PG8_SCHED;
            PG8_LDA(At, 0, 1); PG8_STAGE(PG8_SB(0, 0), b2, voffB); PG8_STAGE(PG8_SB(0, 1), b2 + hstepB, voffB); PG8_STAGE(PG8_SA(0, 0), a2, voffA);
            PG8_WAIT_V(8); PG8_WAIT_L(0); PG8_BAR; PG8_MMA(1, 0, At, B0); PG8_MMA(1, 1, At, B1); PG8_BAR; PG8_SCHED;
            PG8_LDB(B0, 1, 0); PG8_LDB(B1, 1, 1); PG8_SCHED; PG8_LDA(At, 1, 0); PG8_STAGE(PG8_SA(0, 1), a2 + hstepA, voffA);
            PG8_WAIT_V(8); PG8_WAIT_L(0); PG8_BAR; PG8_MMA(0, 0, At, B0); PG8_MMA(0, 1, At, B1); PG8_BAR; PG8_SCHED;
            PG8_LDA(At, 1, 1); PG8_STAGE(PG8_SB(1, 0), b3, voffB); PG8_STAGE(PG8_SB(1, 1), b3 + hstepB, voffB); PG8_STAGE(PG8_SA(1, 0), a3, voffA);
            PG8_WAIT_V(8); PG8_WAIT_L(0); PG8_BAR; PG8_MMA(1, 0, At, B0); PG8_MMA(1, 1, At, B1); PG8_BAR; PG8_SCHED;
            } else {
            PG8_LDB(B0, 0, 0); PG8_SCHED; PG8_LDA(At, 0, 0); PG8_STAGE(PG8_SA(1, 1), a1 + hstepA, voffA);
            PG8_WAIT_L(8); PG8_BAR; PG8_WAIT_L(0); PG8_MMA(0, 0, At, B0); PG8_BAR; PG8_SCHED;
            PG8_LDB(B1, 0, 1); PG8_STAGE(PG8_SB(0, 0), b2, voffB);
            PG8_BAR; PG8_WAIT_L(0); PG8_MMA(0, 1, At, B1); PG8_BAR;
            PG8_LDA(At, 0, 1); PG8_STAGE(PG8_SA(0, 0), a2, voffA);
            PG8_BAR; PG8_WAIT_L(0); PG8_MMA(1, 0, At, B0); PG8_BAR; PG8_SCHED;
            PG8_STAGE(PG8_SB(0, 1), b2 + hstepB, voffB);
            PG8_WAIT_V(6); PG8_BAR; PG8_MMA(1, 1, At, B1); PG8_BAR;
            PG8_LDB(B0, 1, 0); PG8_SCHED; PG8_LDA(At, 1, 0); PG8_STAGE(PG8_SA(0, 1), a2 + hstepA, voffA);
            PG8_WAIT_L(8); PG8_BAR; PG8_WAIT_L(0); PG8_MMA(0, 0, At, B0); PG8_BAR; PG8_SCHED;
            PG8_LDB(B1, 1, 1); PG8_STAGE(PG8_SB(1, 0), b3, voffB);
            PG8_BAR; PG8_WAIT_L(0); PG8_MMA(0, 1, At, B1); PG8_BAR;
            PG8_LDA(At, 1, 1); PG8_STAGE(PG8_SA(1, 0), a3, voffA);
            PG8_BAR; PG8_WAIT_L(0); PG8_MMA(1, 0, At, B0); PG8_BAR; PG8_SCHED;
            PG8_STAGE(PG8_SB(1, 1), b3 + hstepB, voffB);
            PG8_WAIT_V(6); PG8_BAR; PG8_MMA(1, 1, At, B1); PG8_BAR;
            }
        }
        if constexpr (ALIGN_EPI) { if (wr == 0) PG8_BAR; }
        if constexpr (!Epi::AFTER_DRAIN) { E(acc, cur, wr, wc, fr, fq); }
        if (!has_next) break;
        if (!(Epi::KEEP && cur.kind == 0)) {
#pragma unroll
        for (int a = 0; a < 2; ++a)
#pragma unroll
            for (int b = 0; b < 2; ++b)
#pragma unroll
                for (int m = 0; m < 4; ++m)
#pragma unroll
                    for (int n = 0; n < 2; ++n) acc[a][b][m][n] = (f32x4){0.f, 0.f, 0.f, 0.f};
        }
        cur = nxt; cA = nA; cB = nB; ++ui;
        if constexpr (ALIGN_EPI) { if (wr == 1) PG8_BAR; }
    }
    PG8_WAIT_V(0);
    if constexpr (!ALIGN_EPI) { if (wr == 0) PG8_BAR; }
    PG8_BAR;
    if constexpr (Epi::AFTER_DRAIN) { E.fused(acc, cur, wr, wc, fr, fq, lds, wid, lane); }
#undef PG8_SA
#undef PG8_SB
#undef PG8_STAGE
#undef PG8_LDA
#undef PG8_LDB
#undef PG8_MMA
#undef PG8_WAIT_V
#undef PG8_WAIT_L
#undef PG8_BAR
#undef PG8_SCHED
#undef PG8_OPA
#undef PG8_OPB
}

__device__ __forceinline__ f32x2 gelu_pk(f32x2 v) {
    const f32x2 av = __builtin_elementwise_abs(v), d = av * 0.2316418882f + 1.0f;
    f32x2 t; t.x = __builtin_amdgcn_rcpf(d.x); t.y = __builtin_amdgcn_rcpf(d.y);
    f32x2 q = t * 0.5307027145f + (-0.7265760135f); q = q * t + 0.7107068705f; q = q * t + (-0.142248368f); q = q * t + 0.127414796f; q = q * t;
    const f32x2 s = (v * v) * (-0.72134752044f);
    f32x2 e; e.x = __builtin_amdgcn_exp2f(s.x); e.y = __builtin_amdgcn_exp2f(s.y);
    const f32x2 m = v * (q * e), r = v - m;
    f32x2 o; o.x = v.x < 0.f ? m.x : r.x; o.y = v.y < 0.f ? m.y : r.y; return o;
}

struct EpiInProj {
    static constexpr bool PERM = true, AFTER_DRAIN = false, KEEP = false;
    bf16_t* H; float* out; float* WI;
    __device__ __forceinline__ void operator()(f32x4 (&acc)[2][2][4][2], const Unit& u, int wr, int wc, int fr, int fq) const {
        const int pn = u.pn;
        int act;
        if (pn < 4) act = 1; else if (pn == 4) act = 5; else if (pn == 5) act = 6; else if (pn < 14) act = 0; else if (pn == 14) act = 7;
        else if (pn < 19) act = 2; else if (pn < 27) act = 3; else if (pn < 31) act = 2; else act = 4;
        const int row0 = u.pm * BM + wr * 64 + fr, col0 = pn * BM + wc * 32 + 8 * fq;
#pragma unroll
        for (int ai = 0; ai < 2; ++ai)
#pragma unroll
            for (int m = 0; m < 4; ++m) { const int row = row0 + ai * HALF + m * 16; bf16_t* hrow = H + (size_t)row * LDH;
#pragma unroll
                for (int bj = 0; bj < 2; ++bj) { f32x4 v0 = acc[ai][bj][m][0], v1 = acc[ai][bj][m][1]; const int c = col0 + bj * HALF;
                    bool st = true;
                    if (act == 1) { v0 = v0 * QSCALE; v1 = v1 * QSCALE; }
                    else if (act == 2) {
#pragma unroll
                        for (int j = 0; j < 4; ++j) { v0[j] = silu_(v0[j]); v1[j] = silu_(v1[j]); } }
                    else if (act == 3) { f32x2 a = gelu_pk((f32x2){v0[0], v0[1]}), b = gelu_pk((f32x2){v0[2], v0[3]}), cc = gelu_pk((f32x2){v1[0], v1[1]}), d = gelu_pk((f32x2){v1[2], v1[3]});
                        v0 = (f32x4){a.x, a.y, b.x, b.y}; v1 = (f32x4){cc.x, cc.y, d.x, d.y}; }
                    else if (act == 4) {
#pragma unroll
                        for (int j = 0; j < 4; ++j) { v0[j] = sigmoid_(v0[j]); v1[j] = sigmoid_(v1[j]); } }
                    else if (act == 5) { float* o = out + O_KP + (size_t)row * 256 + (c - HC_K); *(f32x4*)o = v0; *(f32x4*)(o + 4) = v1; }
                    else if (act == 6) { float* o = out + O_VP + (size_t)row * 256 + (c - HC_V); *(f32x4*)o = v0; *(f32x4*)(o + 4) = v1; }
                    else if (act == 7) { const int cl = c - HC_WI;
                        if (cl < 16) { float* o = WI + (size_t)row * 16 + cl; *(f32x4*)o = v0 * WSCALE; *(f32x4*)(o + 4) = v1 * WSCALE; st = false; }
                        else if (cl < 144) { float* o = out + O_KIP + (size_t)row * 128 + (cl - 16); *(f32x4*)o = v0; *(f32x4*)(o + 4) = v1; }
                        else st = false; }
                    if (st) { u32x4 w; w.x = cvtpk(v0[0], v0[1]); w.y = cvtpk(v0[2], v0[3]); w.z = cvtpk(v1[0], v1[1]); w.w = cvtpk(v1[2], v1[3]); *(u32x4*)(hrow + c) = w; } } }
    }
};
struct EpiMix {
    static constexpr bool PERM = true, AFTER_DRAIN = false, KEEP = true;
    const bf16_t* H; bf16_t* MIX;
    __device__ __forceinline__ void operator()(f32x4 (&acc)[2][2][4][2], const Unit& u, int wr, int wc, int fr, int fq) const {
        const int row0 = u.pm * BM + wr * 64 + fr, col0 = u.pn * BM + wc * 32 + 8 * fq;
#pragma unroll
        for (int ai = 0; ai < 2; ++ai)
#pragma unroll
            for (int m = 0; m < 4; ++m) { const int row = row0 + ai * HALF + m * 16; const bf16_t* hrow = H + (size_t)row * LDH;
#pragma unroll
                for (int bj = 0; bj < 2; ++bj) { const int c = col0 + bj * HALF;
                    const u32x4 gb = *(const u32x4*)(hrow + HC_GB + c);
                    float b[8] = {bflo(gb.x), bfhi(gb.x), bflo(gb.y), bfhi(gb.y), bflo(gb.z), bfhi(gb.z), bflo(gb.w), bfhi(gb.w)};
                    if (u.kind == 0) {
                        const u32x4 ga = *(const u32x4*)(hrow + HC_GA + c);
                        float a[8] = {bflo(ga.x), bfhi(ga.x), bflo(ga.y), bfhi(ga.y), bflo(ga.z), bfhi(ga.z), bflo(ga.w), bfhi(ga.w)};
#pragma unroll
                        for (int j = 0; j < 4; ++j) { acc[ai][bj][m][0][j] *= a[j] * __builtin_amdgcn_rcpf(fmaxf(b[j], 1e-30f)); acc[ai][bj][m][1][j] *= a[4 + j] * __builtin_amdgcn_rcpf(fmaxf(b[4 + j], 1e-30f)); }
                    } else {
                        f32x4 v0 = acc[ai][bj][m][0], v1 = acc[ai][bj][m][1];
#pragma unroll
                        for (int j = 0; j < 4; ++j) { v0[j] *= b[j]; v1[j] *= b[4 + j]; }
                        u32x4 w; w.x = cvtpk(v0[0], v0[1]); w.y = cvtpk(v0[2], v0[3]); w.z = cvtpk(v1[0], v1[1]); w.w = cvtpk(v1[2], v1[3]); *(u32x4*)(MIX + (size_t)row * DM + c) = w; } } }
    }
};
struct EpiOut {
    static constexpr bool PERM = false, AFTER_DRAIN = true, KEEP = false;
    const float* X; float* out; float* PS;
    __device__ __forceinline__ void fused(f32x4 (&acc)[2][2][4][2], const Unit& u, int wr, int wc, int fr, int fq, PG8_LAS unsigned char* lds, int wid, int lane) const {
        PG8_LAS float* P = (PG8_LAS float*)lds;
        const int col0 = u.pn * BM + wc * 32 + 4 * fq;
#pragma unroll
        for (int ai = 0; ai < 2; ++ai)
#pragma unroll
            for (int m = 0; m < 4; ++m) { const int rl = ai * HALF + wr * 64 + m * 16 + fr; const size_t off = (size_t)(u.pm * BM + rl) * DM + col0; float s = 0.f;
#pragma unroll
                for (int bj = 0; bj < 2; ++bj)
#pragma unroll
                    for (int n = 0; n < 2; ++n) { const f32x4 xv = *(const f32x4*)(X + off + bj * HALF + n * 16); const f32x4 v = acc[ai][bj][m][n] + xv;
                        *(f32x4*)(out + off + bj * HALF + n * 16) = v; s += (v[0] * v[0] + v[1] * v[1]) + (v[2] * v[2] + v[3] * v[3]); }
                s += __shfl_xor(s, 16); s += __shfl_xor(s, 32);
                if (fq == 0) P[rl * 4 + wc] = s; }
        asm volatile("s_waitcnt lgkmcnt(0)" ::: "memory"); __builtin_amdgcn_s_barrier(); asm volatile("" ::: "memory");
        const int tid = wid * 64 + lane;
        if (tid < 256) { const float t = (P[tid * 4 + 0] + P[tid * 4 + 1]) + (P[tid * 4 + 2] + P[tid * 4 + 3]); PS[(size_t)(u.pm * BM + tid) * 8 + u.pn] = t; }
    }
};
}

constexpr int RING_OFF = 0, RING_BYTES = 131072;
constexpr int LDSCTL_OFF = RING_BYTES, MISC_OFF = LDSCTL_OFF + 320;
constexpr int LDS_BYTES = 147456;

#define XB_TMO      128
#define XB_XCNT(j)  (256  + 64 * (j))
#define XB_XSUB(j)  (1280 + 64 * (j))
#define XB_XGEN(j)  (2304 + 64 * (j))
#define XB_TOP      3328
#define XB_TOPGEN   3392
#define XCD_BAR_WORDS 3456
#define XB_SPIN_CAP (1u << 18)
__device__ __forceinline__ unsigned xb_ld(unsigned* p)              { return __hip_atomic_load(p, __ATOMIC_RELAXED, __HIP_MEMORY_SCOPE_AGENT); }
__device__ __forceinline__ unsigned xb_add(unsigned* p, unsigned v) { return __hip_atomic_fetch_add(p, v, __ATOMIC_RELAXED, __HIP_MEMORY_SCOPE_AGENT); }
__device__ __forceinline__ unsigned xb_xcc_id() { return (unsigned)__builtin_amdgcn_s_getreg((3 << 11) | 20) & 0xFu; }
#define XB_SPIN(cond, bar) do { unsigned _sp = 0; while (cond) { __builtin_amdgcn_s_sleep(1); \
    if ((++_sp & 255u) == 0u) { if (xb_ld(&(bar)[XB_TMO])) break; if (_sp > XB_SPIN_CAP) { atomicAdd(&(bar)[XB_TMO], 1u); break; } } } } while (0)
struct XcdBarrier { unsigned* bar; unsigned x; volatile LAS unsigned* st; };
__device__ __forceinline__ XcdBarrier xcd_barrier_post(unsigned* bar, volatile LAS unsigned* st) {
    XcdBarrier b; b.bar = bar; b.x = xb_xcc_id(); b.st = st;
    if (threadIdx.x == 0) (void)xb_add(&bar[XB_XCNT(b.x)], 1u);
    return b;
}
__device__ __forceinline__ void xcd_barrier_complete(unsigned* bar, unsigned x, unsigned& nloc, unsigned& nx) {
    const unsigned G = gridDim.x * gridDim.y * gridDim.z;
    unsigned sum, cnt, mine, sp = 0u;
    for (;;) {
        sum = 0u; cnt = 0u; mine = 0u;
#pragma unroll
        for (unsigned j = 0; j < 16; ++j) { const unsigned c = xb_ld(&bar[XB_XCNT(j)]); sum += c; cnt += (c > 0u) ? 1u : 0u; mine = (j == x) ? c : mine; }
        if (sum == G) break;
        __builtin_amdgcn_s_sleep(1);
        if ((++sp & 255u) == 0u) { if (xb_ld(&bar[XB_TMO])) break; if (sp > XB_SPIN_CAP) { atomicAdd(&bar[XB_TMO], 1u); break; } }
    }
    nloc = mine > 0u ? mine : 1u; nx = cnt > 0u ? cnt : 1u;
}
__device__ __forceinline__ void xcd_barrier(const XcdBarrier& b) {
    asm volatile("s_waitcnt vmcnt(0)" ::: "memory");
    __syncthreads();
    if (threadIdx.x == 0) {
        unsigned* bar = b.bar;
        __builtin_amdgcn_s_waitcnt(0);
        unsigned nloc = b.st[0], nx = b.st[1];
        if (nloc == 0u) { xcd_barrier_complete(bar, b.x, nloc, nx); b.st[0] = nloc; b.st[1] = nx; }
        const unsigned old = xb_add(&bar[XB_XSUB(b.x)], 1u);
        const unsigned gen = old / nloc;
        if (old + 1u == (gen + 1u) * nloc) {
            __builtin_amdgcn_fence(__ATOMIC_RELEASE, "agent");
            asm volatile("s_waitcnt vmcnt(0)" ::: "memory");
            const unsigned og = xb_add(&bar[XB_TOP], 1u);
            const unsigned tg = og / nx;
            if (og + 1u == (tg + 1u) * nx) xb_add(&bar[XB_TOPGEN], 1u);
            else XB_SPIN(xb_ld(&bar[XB_TOPGEN]) == tg, bar);
            __builtin_amdgcn_fence(__ATOMIC_ACQUIRE, "agent");
            xb_add(&bar[XB_XGEN(b.x)], 1u);
            asm volatile("s_waitcnt vmcnt(0)" ::: "memory");
        } else {
            XB_SPIN(xb_ld(&bar[XB_XGEN(b.x)]) == gen, bar);
            __builtin_amdgcn_fence(__ATOMIC_ACQUIRE, "agent");
            asm volatile("s_waitcnt vmcnt(0)" ::: "memory");
        }
    }
    __syncthreads();
}

struct Args { const void* in[16]; float* out; unsigned char* ws; int ph_lo, ph_hi, li, pad; };
#define WSB(off) ((bf16*)(F.ws + (off)))
#define WSF(off) ((float*)(F.ws + (off)))
struct In { const float *xp, *xs, *ck, *cv, *cki, *gin, *win, *wpa, *wpb, *wo, *lng, *lnb, *wsp, *bsp, *gf; const int* pt; };
struct Ctx {
    LAS unsigned char* lds; int tid, lane, wave, G, bid;
    float* out; unsigned char* ws;
};

__device__ __forceinline__ unsigned f2bf(float f) { unsigned u = __builtin_bit_cast(unsigned, f); return (u + 0x7fffu + ((u >> 16) & 1u)) >> 16; }
__device__ __forceinline__ unsigned pk2(float lo, float hi) { return f2bf(lo) | (f2bf(hi) << 16); }
__device__ __forceinline__ void p0_transpose_item(const float* W, int K, int Nsrc, bf16* WT, bool remap, LAS float* scr, int kb, int nb, int lane) {
    const int k0 = 64 * kb, n0 = 32 * nb;
    const int nd = n0 + (lane & 31); int ns = nd; bool ok = true;
    if (remap) { if (nd >= 3840) ns = nd - 112; else if (nd >= 3728) ok = false; }
#pragma unroll 8
    for (int i = 0; i < 32; ++i) { const int kk = 2 * i + (lane >> 5); scr[kk * 33 + (lane & 31)] = ok ? W[(size_t)(k0 + kk) * Nsrc + ns] : 0.f; }
    LDS_WAIT(); asm volatile("" ::: "memory");
    const int c = lane & 7;
#pragma unroll
    for (int j = 0; j < 4; ++j) { const int n = (lane >> 3) + 8 * j; const LAS float* s = scr + (8 * c) * 33 + n;
        v4u o; o.x = pk2(s[0 * 33], s[1 * 33]); o.y = pk2(s[2 * 33], s[3 * 33]); o.z = pk2(s[4 * 33], s[5 * 33]); o.w = pk2(s[6 * 33], s[7 * 33]);
        *(GAS v4u*)(WT + (size_t)(n0 + n) * K + k0 + 8 * c) = o; }
    LDS_WAIT(); asm volatile("" ::: "memory");
}
__device__ __forceinline__ void rms_row_to_bf16(const float* xrow, const float* g, bf16* orow, int lane) {
    const f32x4* xr = (const f32x4*)xrow + lane; const f32x4* gr = (const f32x4*)g + lane;
    f32x4 v[8]; float s = 0.f;
#pragma unroll
    for (int j = 0; j < 8; ++j) { v[j] = xr[64 * j]; s += (v[j].x * v[j].x + v[j].y * v[j].y) + (v[j].z * v[j].z + v[j].w * v[j].w); }
    const float rstd = 1.0f / sqrtf(wave_sum(s) * (1.f / DM) + RMS_EPS);
    v2u* o8 = (v2u*)orow + lane;
#pragma unroll
    for (int j = 0; j < 8; ++j) { const f32x4 gg = gr[64 * j]; v2u w; w.x = cvtpk(v[j].x * rstd * gg.x, v[j].y * rstd * gg.y); w.y = cvtpk(v[j].z * rstd * gg.z, v[j].w * rstd * gg.w); o8[64 * j] = w; }
}
__device__ __forceinline__ void p0_prologue(Ctx& F, const In& I) {
    LAS float* scr = (LAS float*)(F.lds + RING_OFF + F.wave * 8448);
    const int gw = F.bid * 8 + F.wave, NGW = F.G * 8;
    constexpr int NB_IN = LDH / 32, I_IN = (DM / 64) * NB_IN;
    constexpr int I_A = (1024 / 64) * (DM / 32), I_O = (DM / 64) * (DM / 32);
    constexpr int NITEMS = I_IN + 2 * I_A + I_O;
    for (int it = gw; it < NITEMS; it += NGW) {
        int r = it;
        if (r < I_IN) { p0_transpose_item(I.win, DM, IN_WIDTH, WSB(WS_WTIN), true, scr, r / NB_IN, r % NB_IN, F.lane); continue; } r -= I_IN;
        if (r < I_A) { p0_transpose_item(I.wpa, 1024, DM, WSB(WS_WTA), false, scr, r / (DM / 32), r % (DM / 32), F.lane); continue; } r -= I_A;
        if (r < I_A) { p0_transpose_item(I.wpb, 1024, DM, WSB(WS_WTB), false, scr, r / (DM / 32), r % (DM / 32), F.lane); continue; } r -= I_A;
        p0_transpose_item(I.wo, DM, DM, WSB(WS_WTO), false, scr, r / (DM / 32), r % (DM / 32), F.lane);
    }
    for (int m = gw; m < MP + NS; m += NGW) {
        if (m < MP) rms_row_to_bf16(I.xp + (size_t)m * DM, I.gin, WSB(WS_XN) + (size_t)m * DM, F.lane);
        else rms_row_to_bf16(I.xs + (size_t)(m - MP) * DM, I.gin, WSB(WS_XNS) + (size_t)(m - MP) * DM, F.lane);
    }
}

__device__ __forceinline__ f32x4 sgemv_part(const bf16* X, int ldx, const bf16* Wt, int ldw, int n0, int kbeg, int nsteps, int lane) {
    const int r = lane & 15, q = lane >> 4;
    f32x4 acc = {0.f, 0.f, 0.f, 0.f};
    const bf16* xp = X + (size_t)(r & 7) * ldx + kbeg + 8 * q; const bf16* wp = Wt + (size_t)(n0 + r) * ldw + kbeg + 8 * q;
    const bf16x8 z = {0, 0, 0, 0, 0, 0, 0, 0};
#pragma unroll 4
    for (int st = 0; st < nsteps; ++st) {
        bf16x8 a = *(const bf16x8*)(xp + 32 * st); if (r >= 8) a = z;
        const bf16x8 b = *(const bf16x8*)(wp + 32 * st);
        acc = __builtin_amdgcn_mfma_f32_16x16x32_bf16(a, b, acc, 0, 0, 0);
    }
    return acc;
}
__device__ __forceinline__ f32x4 block_reduce8(f32x4 v, LAS float* red, int wave, int lane) {
    *(LAS f32x4*)(red + (wave * 64 + lane) * 4) = v;
    __syncthreads();
    f32x4 s = {0.f, 0.f, 0.f, 0.f};
    if (wave == 0) {
#pragma unroll
        for (int w = 0; w < 8; ++w) s += *(LAS f32x4*)(red + (w * 64 + lane) * 4);
    }
    __syncthreads();
    return s;
}
__device__ __forceinline__ void finish_sample_col(Ctx& F, int s, int n, float v) {
    float h = v;
    if (n < HC_K) h = v * QSCALE;
    else if (n < HC_V) F.out[O_KS + s * 256 + (n - HC_K)] = v;
    else if (n < HC_QI) F.out[O_VS + s * 256 + (n - HC_V)] = v;
    else if (n < HC_WI) {}
    else if (n < HC_KI) h = v * WSCALE;
    else if (n < 3728) F.out[O_KIS + s * 128 + (n - HC_KI)] = v;
    else if (n < HC_ZA) h = 0.f;
    else if (n < HC_U) h = silu_(v);
    else if (n < HC_ZB) h = 0.5f * v * (1.0f + erff(v * 0.70710678118654752f));
    else if (n < HC_GA) h = silu_(v);
    else h = sigmoid_(v);
    WSF(WS_HS)[(size_t)s * LDH + n] = h;
}
__device__ __forceinline__ void p1_sample_inproj(Ctx& F) {
    LAS float* red = (LAS float*)(F.lds + RING_OFF);
    for (int it = F.bid; it < LDH / 16; it += F.G) {
        const int n0 = 16 * it;
        f32x4 a = sgemv_part(WSB(WS_XNS), DM, WSB(WS_WTIN), DM, n0, F.wave * 256, 8, F.lane);
        a = block_reduce8(a, red, F.wave, F.lane);
        if (F.wave == 0 && F.lane < 32) {
#pragma unroll
            for (int j = 0; j < 4; ++j) finish_sample_col(F, 4 * (F.lane >> 4) + j, n0 + (F.lane & 15), a[j]);
        }
    }
    __syncthreads();
}

template <int NREG>
__device__ __forceinline__ void wave_select256(const float (&s)[NREG], int n_valid, int lane, LAS unsigned short* list) {
    float mx = -INFINITY, mn = INFINITY;
#pragma unroll
    for (int i = 0; i < NREG; ++i) { mx = fmaxf(mx, s[i]); mn = fminf(mn, s[i] == -INFINITY ? INFINITY : s[i]); }
    mx = wave_max(mx); mn = wave_min(mn);
    float lo = mn, hi = INFINITY; int clo = n_valid, chi = 0;
    float hv = mx;
    for (int it = 0; it < 64 && clo != 256; ++it) {
        float mid;
        if (it & 1) mid = 0.5f * lo + 0.5f * hv;
        else { const float fr = ((float)clo - 255.5f) / (float)(clo - chi); mid = lo + (hv - lo) * fr; }
        if (!(mid > lo)) mid = 0.5f * lo + 0.5f * hv;
        if (!(mid > lo) || !(mid < hi)) { if (hi == INFINITY && hv > lo) mid = hv; else break; }
        int c = 0;
#pragma unroll
        for (int i = 0; i < NREG; ++i) c += (s[i] >= mid) ? 1 : 0;
        c = wave_sum_i(c);
        if (c >= 256) { lo = mid; clo = c; } else { hi = mid; hv = mid; chi = c; }
    }
    int base = 0, rem = 256 - chi;
#pragma unroll
    for (int i = 0; i < NREG; ++i) {
        const bool a = s[i] >= hi, b = (s[i] >= lo) && !a;
        const unsigned long long mb = __ballot(b);
        const int rb = __builtin_amdgcn_mbcnt_hi((unsigned)(mb >> 32), __builtin_amdgcn_mbcnt_lo((unsigned)mb, 0));
        const bool take = a || (b && rb < rem);
        const unsigned long long mt = __ballot(take);
        const int pos = base + __builtin_amdgcn_mbcnt_hi((unsigned)(mt >> 32), __builtin_amdgcn_mbcnt_lo((unsigned)mt, 0));
        if (take && pos < 256) list[pos] = (unsigned short)(i * 64 + lane);
        base += __builtin_popcountll(mt);
        const int nb = __builtin_popcountll(mb); rem = rem > nb ? rem - nb : 0;
    }
    LDS_WAIT();
}

struct RowSrc { const unsigned short* Hb; const float* ck; const float* cv; const int* pt; const float* knew; const float* vnew; };
template <bool SAMPLE>
__device__ __forceinline__ void attn_part(const RowSrc& R, int g, const LAS unsigned short* list, int k0, int nstep, int nsel, LAS unsigned char* vst, const bf16x8 (&qf)[4], float& m_out, float& l_out, f32x4 (&o)[8], int lane) {
    const int r16 = lane & 15, q4 = lane >> 4;
    float m = -1e30f, l = 0.f;
#pragma unroll
    for (int db = 0; db < 8; ++db) o[db] = (f32x4){0.f, 0.f, 0.f, 0.f};
    const LAS unsigned char* vb = vst + (4 * q4 + (r16 >> 2)) * 288 + (r16 & 3) * 8;
#pragma unroll 1
    for (int ks = 0; ks < nstep; ++ks) {
        const int sb = k0 + ks * 32;
        bf16x8 ka[2][4]; v4u vw[8];
#pragma unroll
        for (int grp = 0; grp < 2; ++grp) {
            const int slot = sb + grp * 16 + r16; const int key = list[slot < nsel ? slot : 0];
            if constexpr (!SAMPLE) {
                const unsigned short* kp = R.Hb + (size_t)key * LDH + HC_K + g * 128 + 8 * q4;
#pragma unroll
                for (int st = 0; st < 4; ++st) ka[grp][st] = *(const bf16x8*)(kp + 32 * st);
            } else {
                const float* kp = (key < PAST) ? R.ck + ((size_t)(R.pt[key >> 7] * PAGE + (key & 127)) * 2 + g) * 128 : R.knew + g * 128;
                kp += 8 * q4;
#pragma unroll
                for (int st = 0; st < 4; ++st) ka[grp][st] = cvt8(*(const f32x4*)(kp + 32 * st), *(const f32x4*)(kp + 32 * st + 4));
            }
        }
#pragma unroll
        for (int i = 0; i < 8; ++i) {
            const int slot = sb + 4 * i + q4; const int key = list[slot < nsel ? slot : 0];
            if constexpr (!SAMPLE) vw[i] = *(const v4u*)(R.Hb + (size_t)key * LDH + HC_V + g * 128 + r16 * 8);
            else { const float* vp = (key < PAST) ? R.cv + ((size_t)(R.pt[key >> 7] * PAGE + (key & 127)) * 2 + g) * 128 : R.vnew + g * 128;
                   vw[i] = __builtin_bit_cast(v4u, cvt8(*(const f32x4*)(vp + r16 * 8), *(const f32x4*)(vp + r16 * 8 + 4))); }
        }
        f32x4 c[2];
#pragma unroll
        for (int grp = 0; grp < 2; ++grp) {
            c[grp] = (f32x4){0.f, 0.f, 0.f, 0.f};
#pragma unroll
            for (int st = 0; st < 4; ++st) c[grp] = __builtin_amdgcn_mfma_f32_16x16x32_bf16(ka[grp][st], qf[st], c[grp], 0, 0, 0);
#pragma unroll
            for (int r = 0; r < 4; ++r) { const int sl = sb + grp * 16 + 4 * q4 + r; c[grp][r] = sl < nsel ? c[grp][r] : -1e30f; }
        }
        float ml = fmaxf(fmaxf(fmaxf(c[0][0], c[0][1]), fmaxf(c[0][2], c[0][3])), fmaxf(fmaxf(c[1][0], c[1][1]), fmaxf(c[1][2], c[1][3])));
        ml = fmaxf(ml, __shfl_xor(ml, 16)); ml = fmaxf(ml, __shfl_xor(ml, 32));
        const float mn = fmaxf(m, ml), f = __builtin_amdgcn_exp2f(m - mn);
        m = mn; l *= f;
#pragma unroll
        for (int db = 0; db < 8; ++db) o[db] = o[db] * f;
#pragma unroll
        for (int grp = 0; grp < 2; ++grp)
#pragma unroll
            for (int r = 0; r < 4; ++r) { const float p = __builtin_amdgcn_exp2f(c[grp][r] - m); c[grp][r] = p; l += p; }
        v4u pw; pw.x = cvtpk(c[0][0], c[0][1]); pw.y = cvtpk(c[0][2], c[0][3]); pw.z = cvtpk(c[1][0], c[1][1]); pw.w = cvtpk(c[1][2], c[1][3]);
        const bf16x8 pf = __builtin_bit_cast(bf16x8, pw);
#pragma unroll
        for (int i = 0; i < 8; ++i) *(LAS v4u*)(vst + (4 * i + q4) * 288 + r16 * 16) = vw[i];
        LDS_WAIT();
#pragma unroll
        for (int db = 0; db < 8; ++db) {
            const s16x4 lo = __builtin_bit_cast(s16x4, __builtin_amdgcn_ds_read_tr16_b64_v4i16((LAS s16x4*)(vb + db * 32)));
            const s16x4 hi = __builtin_bit_cast(s16x4, __builtin_amdgcn_ds_read_tr16_b64_v4i16((LAS s16x4*)(vb + 16 * 288 + db * 32)));
            const bf16x8 vf = {lo[0], lo[1], lo[2], lo[3], hi[0], hi[1], hi[2], hi[3]};
            o[db] = __builtin_amdgcn_mfma_f32_16x16x32_bf16(vf, pf, o[db], 0, 0, 0);
        }
        LDS_WAIT();
    }
    l += __shfl_xor(l, 16); l += __shfl_xor(l, 32);
    m_out = m; l_out = l;
}

__device__ __forceinline__ void p2_prompt_item(Ctx& F, int item) {
    const int qb = 255 - (item >> 1), b = item & 1, q0 = qb * 16, rowbase = b * SEQ;
    const int nkeys = q0 + 16, ntile = (nkeys + 63) >> 6;
    int lane = F.lane, w = F.wave, tid = F.tid;
    asm volatile("" : "+v"(lane), "+v"(tid)); asm volatile("" : "+s"(w));
    LAS unsigned char* kbuf = F.lds + RING_OFF;
    LAS unsigned short* list = (LAS unsigned short*)(F.lds + RING_OFF + 32768 + w * 9728);
    LAS unsigned char* vst = F.lds + RING_OFF + 32768 + w * 9728 + 512;
    float* SCb = WSF(WS_SC) + (size_t)F.bid * (16 * 4096);
    const bf16* Hb = WSB(WS_H) + (size_t)rowbase * LDH;
    {
        const int r = lane & 31, hi = lane >> 5;
        bf16x8 qf[8]; float wv[16];
        { const int tq = q0 + 2 * w + ((r >> 2) & 1), head = (r & 3) + 4 * (r >> 3);
          const bf16* qsrc = Hb + (size_t)tq * LDH + HC_QI + head * 128 + 8 * hi;
#pragma unroll
          for (int st = 0; st < 8; ++st) qf[st] = *(const bf16x8*)(qsrc + 16 * st);
          const f32x4* wp = (const f32x4*)(WSF(WS_WI) + (size_t)(rowbase + q0 + 2 * w + hi) * 16);
#pragma unroll
          for (int j = 0; j < 4; ++j) { const f32x4 t = wp[j]; wv[4 * j] = t[0]; wv[4 * j + 1] = t[1]; wv[4 * j + 2] = t[2]; wv[4 * j + 3] = t[3]; } }
        const int tql = q0 + 2 * w + hi;
        v4u pre[2];
        const int skey[2] = {tid >> 4, (tid + 512) >> 4}; const int sc_[2] = {tid & 15, tid & 15};
#pragma unroll
        for (int i = 0; i < 2; ++i) pre[i] = *(const v4u*)(Hb + (size_t)skey[i] * LDH + HC_KI + sc_[i] * 8);
#pragma unroll
        for (int i = 0; i < 2; ++i) *(LAS v4u*)(kbuf + skey[i] * 256 + ((sc_[i] ^ (skey[i] & 15)) * 16)) = pre[i];
        __syncthreads();
        for (int kt = 0; kt < ntile; ++kt) {
            const bool more = kt + 1 < ntile;
            if (more) {
#pragma unroll
                for (int i = 0; i < 2; ++i) pre[i] = *(const v4u*)(Hb + (size_t)(64 * (kt + 1) + skey[i]) * LDH + HC_KI + sc_[i] * 8);
            }
            const LAS unsigned char* buf = kbuf + (kt & 1) * 16384;
#pragma unroll
            for (int sub = 0; sub < 2; ++sub) {
                f32x16 c = {};
#pragma unroll
                for (int st = 0; st < 8; ++st) { const bf16x8 bfr = *(const LAS bf16x8*)(buf + (sub * 32 + r) * 256 + (((2 * st + hi) ^ (r & 15)) * 16)); c = __builtin_amdgcn_mfma_f32_32x32x16_bf16(qf[st], bfr, c, 0, 0, 0); }
                float s = 0.f;
#pragma unroll
                for (int j = 0; j < 16; ++j) s += wv[j] * fmaxf(c[j], 0.f);
                const int key = 64 * kt + 32 * sub + r;
                SCb[(2 * w + hi) * 4096 + key] = key <= tql ? s : -INFINITY;
            }
            if (more) {
                LAS unsigned char* nb = kbuf + ((kt + 1) & 1) * 16384;
#pragma unroll
                for (int i = 0; i < 2; ++i) *(LAS v4u*)(nb + skey[i] * 256 + ((sc_[i] ^ (skey[i] & 15)) * 16)) = pre[i];
            }
            __syncthreads();
        }
    }
    __syncthreads();
#pragma unroll 1
    for (int qq = 0; qq < 2; ++qq) {
        const int ql = 2 * w + qq, t = q0 + ql, n = t + 1;
        int nsel;
        if (n <= 256) {
#pragma unroll
            for (int j = 0; j < 4; ++j) list[lane + 64 * j] = (unsigned short)(lane + 64 * j);
            LDS_WAIT(); nsel = n;
        } else {
            float s[64]; int ln = lane; asm volatile("" : "+v"(ln));
#pragma unroll
            for (int i = 0; i < 64; ++i) { const float v = SCb[ql * 4096 + i * 64 + lane]; s[i] = (ln <= t - i * 64) ? v : -INFINITY; }
#ifndef NO_SEL
            wave_select256<64>(s, n, lane, list); nsel = 256;
#else
            nsel = 256; list[lane] = (unsigned short)(s[3] > 0.f);
#endif
        }
        asm volatile("" : "+v"(lane) :: "memory"); __builtin_amdgcn_sched_barrier(0);
        RowSrc R; R.Hb = Hb; R.ck = nullptr; R.cv = nullptr; R.pt = nullptr; R.knew = nullptr; R.vnew = nullptr;
        const int r16 = lane & 15, q4 = lane >> 4;
#pragma unroll 1
        for (int g = 0; g < 2; ++g) {
            bf16x8 qf[4]; const bf16x8 z = {0, 0, 0, 0, 0, 0, 0, 0};
            const bf16* qp = Hb + (size_t)t * LDH + HC_Q + (g * 4 + (r16 & 3)) * 128 + 8 * q4;
#pragma unroll
            for (int st = 0; st < 4; ++st) { qf[st] = *(const bf16x8*)(qp + 32 * st); if (r16 >= 4) qf[st] = z; }
            float m, l; f32x4 o[8];
#ifndef NO_ATT
            attn_part<false>(R, g, list, 0, 8, nsel, vst, qf, m, l, o, lane);
#else
            m = 0.f; l = 1.f; for (int db = 0; db < 8; ++db) o[db] = (f32x4){1.f, 1.f, 1.f, 1.f};
#endif
            if (r16 < 4) {
                const float rl = 1.0f / l;
                const bf16* zp = Hb + (size_t)t * LDH + HC_ZA + (g * 4 + r16) * 128 + 4 * q4;
                bf16* op = WSB(WS_OAB) + (size_t)(rowbase + t) * DM + (g * 4 + r16) * 128 + 4 * q4;
#pragma unroll
                for (int db = 0; db < 8; ++db) { const v2u zz = *(const v2u*)(zp + db * 16);
                    v2u ww; ww.x = cvtpk(o[db][0] * rl * bflo(zz.x), o[db][1] * rl * bfhi(zz.x)); ww.y = cvtpk(o[db][2] * rl * bflo(zz.y), o[db][3] * rl * bfhi(zz.y));
                    *(v2u*)(op + db * 16) = ww; }
            }
        }
    }
}
__device__ __forceinline__ void p2_gmlp_item(Ctx& F, const In& I, int c) {
    int lane = F.lane, w = F.wave, tid = F.tid; const int r0 = c * 128;
    asm volatile("" : "+v"(lane), "+v"(tid)); asm volatile("" : "+s"(w));
    LAS unsigned char* tile = F.lds + RING_OFF;
    LAS float* smu = (LAS float*)(F.lds + RING_OFF + 36864); LAS float* srs = smu + 128;
    for (int rr = 0; rr < 16; ++rr) {
        const int row = 16 * w + rr; const bf16* p = WSB(WS_H) + (size_t)(r0 + row) * LDH + HC_VB;
        const v4u a = *(const v4u*)(p + lane * 8), b = *(const v4u*)(p + 512 + lane * 8);
        float x[16] = {bflo(a.x), bfhi(a.x), bflo(a.y), bfhi(a.y), bflo(a.z), bfhi(a.z), bflo(a.w), bfhi(a.w), bflo(b.x), bfhi(b.x), bflo(b.y), bfhi(b.y), bflo(b.z), bfhi(b.z), bflo(b.w), bfhi(b.w)};
        float s = 0.f;
#pragma unroll
        for (int j = 0; j < 16; ++j) s += x[j];
        const float mu = wave_sum(s) * (1.f / 1024.f); float qv = 0.f;
#pragma unroll
        for (int j = 0; j < 16; ++j) { const float d = x[j] - mu; qv += d * d; }
        const float rs = 1.0f / sqrtf(wave_sum(qv) * (1.f / 1024.f) + LN_EPS);
        if (lane == 0) { smu[row] = mu; srs[row] = rs; }
    }
    __syncthreads();
    const int i16 = lane & 15, q4 = lane >> 4, t = 16 * w + i16, nks = (w >> 1) + 1;
    for (int g = 0; g < 8; ++g) {
#pragma unroll
        for (int i = 0; i < 4; ++i) { const int p = tid + 512 * i, row = p >> 4, ch = p & 15;
            *(LAS v4u*)(tile + row * 288 + ch * 16) = *(const v4u*)(WSB(WS_H) + (size_t)(r0 + row) * LDH + HC_VB + g * 128 + ch * 8); }
        __syncthreads();
        f32x4 acc[8];
#pragma unroll
        for (int db = 0; db < 8; ++db) acc[db] = (f32x4){0.f, 0.f, 0.f, 0.f};
        float c1 = 0.f, c2 = 0.f;
        for (int ks = 0; ks < nks; ++ks) {
            const int s0 = 32 * ks + 8 * q4;
            const float* wrow = I.wsp + ((size_t)(g * 128 + t) * 128 + s0);
            const f32x4 w0 = *(const f32x4*)wrow, w1 = *(const f32x4*)(wrow + 4);
            float wv[8] = {w0[0], w0[1], w0[2], w0[3], w1[0], w1[1], w1[2], w1[3]};
#pragma unroll
            for (int j = 0; j < 8; ++j) { const int s = s0 + j; const float x = (s <= t) ? wv[j] : 0.f; c2 += x; const float xp = x * srs[s]; c1 += xp * smu[s]; wv[j] = xp; }
            const bf16x8 wf = cvt8((f32x4){wv[0], wv[1], wv[2], wv[3]}, (f32x4){wv[4], wv[5], wv[6], wv[7]});
            const LAS unsigned char* vb = tile + (32 * ks + 8 * q4 + (i16 >> 2)) * 288 + (i16 & 3) * 8;
#pragma unroll
            for (int db = 0; db < 8; ++db) {
                const s16x4 lo = __builtin_bit_cast(s16x4, __builtin_amdgcn_ds_read_tr16_b64_v4i16((LAS s16x4*)(vb + db * 32)));
                const s16x4 hi = __builtin_bit_cast(s16x4, __builtin_amdgcn_ds_read_tr16_b64_v4i16((LAS s16x4*)(vb + 4 * 288 + db * 32)));
                const bf16x8 vf = {lo[0], lo[1], lo[2], lo[3], hi[0], hi[1], hi[2], hi[3]};
                acc[db] = __builtin_amdgcn_mfma_f32_16x16x32_bf16(vf, wf, acc[db], 0, 0, 0);
            }
        }
        c1 += __shfl_xor(c1, 16); c1 += __shfl_xor(c1, 32); c2 += __shfl_xor(c2, 16); c2 += __shfl_xor(c2, 32);
        const float bt = I.bsp[g * 128 + t];
        const bf16* hrow = WSB(WS_H) + (size_t)(r0 + t) * LDH; bf16* orow = WSB(WS_OAB) + (size_t)(r0 + t) * DM + 1024;
#pragma unroll
        for (int db = 0; db < 8; ++db) { const int ch0 = g * 128 + db * 16 + 4 * q4;
            const f32x4 lg = *(const f32x4*)(I.lng + ch0), lb = *(const f32x4*)(I.lnb + ch0);
            const v2u uu = *(const v2u*)(hrow + HC_U + ch0), zz = *(const v2u*)(hrow + HC_ZB + ch0);
            float mx[4];
#pragma unroll
            for (int r = 0; r < 4; ++r) mx[r] = lg[r] * (acc[db][r] - c1) + lb[r] * c2 + bt;
            v2u ww; ww.x = cvtpk(bflo(uu.x) * mx[0] * bflo(zz.x), bfhi(uu.x) * mx[1] * bfhi(zz.x)); ww.y = cvtpk(bflo(uu.y) * mx[2] * bflo(zz.y), bfhi(uu.y) * mx[3] * bfhi(zz.y));
            *(v2u*)(orow + ch0) = ww; }
        __syncthreads();
    }
}
__device__ __forceinline__ void p2_sscore_item(Ctx& F, const In& I, int item) {
    int lane = F.lane, w = F.wave; asm volatile("" : "+v"(lane)); asm volatile("" : "+s"(w));
    const int s = item >> 4, page = (item & 15) * 8 + w, r16 = lane & 15, q4 = lane >> 4;
    const float* hs = WSF(WS_HS) + (size_t)s * LDH;
    bf16x8 qf[4];
#pragma unroll
    for (int st = 0; st < 4; ++st) { const float* p = hs + HC_QI + r16 * 128 + st * 32 + 8 * q4; qf[st] = cvt8(*(const f32x4*)p, *(const f32x4*)(p + 4)); }
    const f32x4 wv = *(const f32x4*)(hs + HC_WI + 4 * q4);
    const int phys = I.pt[s * NPAGES + page];
    const float* kb = I.cki + (size_t)phys * PAGE * 128;
    for (int grp = 0; grp < 8; ++grp) {
        const float* kp = kb + (size_t)(grp * 16 + r16) * 128 + 8 * q4;
        f32x4 c = {0.f, 0.f, 0.f, 0.f};
#pragma unroll
        for (int st = 0; st < 4; ++st) { const bf16x8 kf = cvt8(*(const f32x4*)(kp + 32 * st), *(const f32x4*)(kp + 32 * st + 4)); c = __builtin_amdgcn_mfma_f32_16x16x32_bf16(qf[st], kf, c, 0, 0, 0); }
        float v = wv[0] * fmaxf(c[0], 0.f) + wv[1] * fmaxf(c[1], 0.f) + wv[2] * fmaxf(c[2], 0.f) + wv[3] * fmaxf(c[3], 0.f);
        v += __shfl_xor(v, 16); v += __shfl_xor(v, 32);
        if (lane < 16) WSF(WS_SSC)[(size_t)s * SSC_LD + page * 128 + grp * 16 + lane] = v;
    }
}

__device__ __forceinline__ void p3_sample_item(Ctx& F, const In& I, int s) {
    const int lane = F.lane, w = F.wave, tid = F.tid, r16 = lane & 15, q4 = lane >> 4;
    LAS unsigned short* cand = (LAS unsigned short*)(F.lds + RING_OFF);
    LAS unsigned short* fin = (LAS unsigned short*)(F.lds + RING_OFF + 4096);
    LAS unsigned short* tmp = (LAS unsigned short*)(F.lds + RING_OFF + 4608);
    LAS float* snew = (LAS float*)(F.lds + RING_OFF + 5120);
    LAS float* comb = (LAS float*)(F.lds + RING_OFF + 8192);
    LAS unsigned char* vst = F.lds + RING_OFF + 32768 + w * 9216;
    const float* hs = WSF(WS_HS) + (size_t)s * LDH;
    float* ssc = WSF(WS_SSC) + (size_t)s * SSC_LD;
    if (w == 0) {
        const int h = lane >> 2, part = lane & 3; float d = 0.f;
        const float* qp = hs + HC_QI + h * 128 + part * 32; const float* kp = hs + HC_KI + part * 32;
#pragma unroll
        for (int j = 0; j < 32; ++j) d += bf2f((unsigned short)f2bf(qp[j])) * bf2f((unsigned short)f2bf(kp[j]));
        d += __shfl_xor(d, 1); d += __shfl_xor(d, 2);
        float cn = (part == 0) ? hs[HC_WI + h] * fmaxf(d, 0.f) : 0.f;
        cn = wave_sum(cn);
        if (lane == 0) { snew[0] = cn; ssc[PAST] = cn; }
    }
    {
        float sv[32];
#pragma unroll
        for (int i = 0; i < 32; ++i) sv[i] = ssc[w * 2048 + i * 64 + lane];
        wave_select256<32>(sv, 2048, lane, cand + w * 256);
    }
    __syncthreads();
    if (w == 0) {
        float sv[33];
#pragma unroll
        for (int i = 0; i < 32; ++i) { const int cidx = i * 64 + lane; const int key = (cidx >> 8) * 2048 + cand[cidx]; sv[i] = ssc[key]; }
        sv[32] = lane == 0 ? snew[0] : -INFINITY;
        wave_select256<33>(sv, 2049, lane, tmp);
#pragma unroll
        for (int j = 0; j < 4; ++j) { const int slot = tmp[lane + 64 * j]; fin[lane + 64 * j] = (unsigned short)(slot >= 2048 ? PAST : (slot >> 8) * 2048 + cand[slot]); }
        LDS_WAIT();
    }
    __syncthreads();
    {
        const int g = w & 1, part = w >> 1;
        RowSrc R; R.Hb = nullptr; R.ck = I.ck; R.cv = I.cv; R.pt = I.pt + s * NPAGES; R.knew = F.out + O_KS + s * 256; R.vnew = F.out + O_VS + s * 256;
        bf16x8 qf[4]; const bf16x8 z = {0, 0, 0, 0, 0, 0, 0, 0};
        const float* qp = hs + HC_Q + (g * 4 + (r16 & 3)) * 128 + 8 * q4;
#pragma unroll
        for (int st = 0; st < 4; ++st) { qf[st] = cvt8(*(const f32x4*)(qp + 32 * st), *(const f32x4*)(qp + 32 * st + 4)); if (r16 >= 4) qf[st] = z; }
        float m, l; f32x4 o[8];
        attn_part<true>(R, g, fin, part * 64, 2, 256, vst, qf, m, l, o, lane);
        LAS float* cw = comb + w * 520;
        if (r16 < 4) {
            if (q4 == 0) { cw[r16] = m; cw[4 + r16] = l; }
#pragma unroll
            for (int db = 0; db < 8; ++db)
#pragma unroll
                for (int r = 0; r < 4; ++r) cw[8 + (db * 16 + 4 * q4 + r) * 4 + r16] = o[db][r];
        }
    }
    __syncthreads();
    for (int e = tid; e < 1024; e += 512) {
        const int hh = e >> 7, d = e & 127, g = hh >> 2, h = hh & 3;
        float M = -1e30f;
#pragma unroll
        for (int p = 0; p < 4; ++p) M = fmaxf(M, comb[(g + 2 * p) * 520 + h]);
        float num = 0.f, den = 0.f;
#pragma unroll
        for (int p = 0; p < 4; ++p) { const LAS float* cw = comb + (g + 2 * p) * 520; const float f = __builtin_amdgcn_exp2f(cw[h] - M); num += cw[8 + d * 4 + h] * f; den += cw[4 + h] * f; }
        const float v = num / den * hs[HC_ZA + hh * 128 + d];
        WSB(WS_OABS)[(size_t)s * DM + hh * 128 + d] = (bf16)f2bf(v);
    }
    if (w == 1) {
        float x[16]; float sum = 0.f;
#pragma unroll
        for (int j = 0; j < 16; ++j) { x[j] = hs[HC_VB + lane + 64 * j]; sum += x[j]; }
        const float mu = wave_sum(sum) * (1.f / 1024.f); float qv = 0.f;
#pragma unroll
        for (int j = 0; j < 16; ++j) { const float d = x[j] - mu; qv += d * d; }
        const float rs = 1.0f / sqrtf(wave_sum(qv) * (1.f / 1024.f) + LN_EPS);
#pragma unroll
        for (int j = 0; j < 16; ++j) { const int ch = lane + 64 * j, g = ch >> 7;
            const float vn = (x[j] - mu) * rs * I.lng[ch] + I.lnb[ch];
            F.out[O_GV + s * 1024 + ch] = vn;
            const float ob = hs[HC_U + ch] * (I.wsp[(size_t)g * 128 * 128] * vn + I.bsp[g * 128]) * hs[HC_ZB + ch];
            WSB(WS_OABS)[(size_t)s * DM + 1024 + ch] = (bf16)f2bf(ob); }
    }
    __syncthreads();
}

__global__ void __launch_bounds__(512, 2) mk_fwd(Args args) {
    extern __shared__ __attribute__((aligned(16))) unsigned char lds_raw[];
    Ctx F;
    F.lds = (LAS unsigned char*)lds_raw;
    F.tid = threadIdx.x; F.lane = F.tid & 63; F.wave = __builtin_amdgcn_readfirstlane(F.tid >> 6); F.G = gridDim.x; F.bid = blockIdx.x;
    F.out = args.out; F.ws = args.ws;
    volatile LAS unsigned* MISC = (volatile LAS unsigned*)(F.lds + MISC_OFF);
    for (int u = F.tid; u < (LDS_BYTES - LDSCTL_OFF) / 4; u += 512) ((LAS unsigned*)(F.lds + LDSCTL_OFF))[u] = 0u;
    __syncthreads();
    XcdBarrier bar; bar.bar = (unsigned*)(((gu32*)(F.ws + WS_CTL)) + CW_BAR); bar.x = 0; bar.st = nullptr;
    if (MK_N_LAUNCHES == 1) bar = xcd_barrier_post((unsigned*)(((gu32*)(F.ws + WS_CTL)) + CW_BAR), MISC + 8);
    const int lo = args.ph_lo, hi = args.ph_hi;
#ifndef PH_MASK
#define PH_MASK 0x7f
#endif
#define IN(k) (((PH_MASK >> (k)) & 1) && lo <= (k) && (k) < hi)
#define SEAM(k) do { if (IN(k) && IN((k) + 1)) xcd_barrier(bar); } while (0)

    if (IN(0)) { In I{}; I.win = (const float*)args.in[7]; I.wpa = (const float*)args.in[8]; I.wpb = (const float*)args.in[9]; I.wo = (const float*)args.in[10]; I.xp = (const float*)args.in[0]; I.xs = (const float*)args.in[1]; I.gin = (const float*)args.in[6]; p0_prologue(F, I); }
    SEAM(0);
    if (IN(1)) {
        p1_sample_inproj(F);
        pg8::Gemm g{WSB(WS_XN), WSB(WS_XN), WSB(WS_WTIN), WSB(WS_WTIN), DM, DM, DM}; pg8::StaticOrder S; S.init(MP, LDH, F.G, F.bid);
        pg8::EpiInProj E{WSB(WS_H), F.out, WSF(WS_WI)};
        pg8::gemm_phase<pg8::EpiInProj, pg8::StaticOrder, true, true>(F.lds + RING_OFF, g, S, E);
    }
    SEAM(1);
    if (IN(2)) {
        In I{}; I.cki = (const float*)args.in[4]; I.pt = (const int*)args.in[5]; I.lng = (const float*)args.in[11]; I.lnb = (const float*)args.in[12]; I.wsp = (const float*)args.in[13]; I.bsp = (const float*)args.in[14];
        LAS int* slot = (LAS int*)(F.lds + LDSCTL_OFF);
        for (;;) {
            __syncthreads();
            if (F.tid == 0) *slot = (int)__hip_atomic_fetch_add((unsigned*)(((gu32*)(F.ws + WS_CTL)) + CW_Q2), 1u, __ATOMIC_RELAXED, __HIP_MEMORY_SCOPE_AGENT);
            __syncthreads();
            const int item = __builtin_amdgcn_readfirstlane(*slot);
            if (item >= 512 + 64 + 128) break;
#ifndef P2SEL
#define P2SEL 7
#endif
            if (item < 512) { if (P2SEL & 1) p2_prompt_item(F, item); }
            else if (item < 576) { if (P2SEL & 2) p2_gmlp_item(F, I, item - 512); }
            else { if (P2SEL & 4) p2_sscore_item(F, I, item - 576); }
        }
    }
    SEAM(2);
    if (IN(3)) {
        if (F.bid < NS) { In I{}; I.ck = (const float*)args.in[2]; I.cv = (const float*)args.in[3]; I.pt = (const int*)args.in[5]; I.lng = (const float*)args.in[11]; I.lnb = (const float*)args.in[12]; I.wsp = (const float*)args.in[13]; I.bsp = (const float*)args.in[14]; p3_sample_item(F, I, F.bid); }
        pg8::Gemm g{WSB(WS_OAB), WSB(WS_OAB) + 1024, WSB(WS_WTA), WSB(WS_WTB), DM, 1024, 1024}; pg8::PairOrder S; S.init(MP, DM, F.G, F.bid);
        pg8::EpiMix E{WSB(WS_H), WSB(WS_MIX)};
        pg8::gemm_phase<pg8::EpiMix, pg8::PairOrder, true, true>(F.lds + RING_OFF, g, S, E);
    }
    SEAM(3);
    if (IN(4)) {
        if (F.bid < 128) {
            LAS float* red = (LAS float*)(F.lds + RING_OFF);
            const int n0 = 16 * F.bid;
            f32x4 ya = sgemv_part(WSB(WS_OABS), DM, WSB(WS_WTA), 1024, n0, F.wave * 128, 4, F.lane);
            f32x4 yb = sgemv_part(WSB(WS_OABS) + 1024, DM, WSB(WS_WTB), 1024, n0, F.wave * 128, 4, F.lane);
            ya = block_reduce8(ya, red, F.wave, F.lane); yb = block_reduce8(yb, red, F.wave, F.lane);
            if (F.wave == 0 && F.lane < 32) {
#pragma unroll
                for (int j = 0; j < 4; ++j) { const int s = 4 * (F.lane >> 4) + j, n = n0 + (F.lane & 15);
                    const float v = WSF(WS_HS)[(size_t)s * LDH + HC_GA + n] * ya[j] + WSF(WS_HS)[(size_t)s * LDH + HC_GB + n] * yb[j];
                    WSB(WS_MIXS)[(size_t)s * DM + n] = (bf16)f2bf(v); }
            }
            __syncthreads();
        }
        pg8::Gemm g{WSB(WS_MIX), WSB(WS_MIX), WSB(WS_WTO), WSB(WS_WTO), DM, DM, DM}; pg8::StaticOrder S; S.init(MP, DM, F.G, F.bid);
        pg8::EpiOut E{(const float*)args.in[0], F.out, WSF(WS_PS)};
        pg8::gemm_phase<pg8::EpiOut, pg8::StaticOrder, false, true>(F.lds + RING_OFF, g, S, E);
    }
    SEAM(4);
    if (IN(5)) {
        if (F.bid < 128) {
            LAS float* red = (LAS float*)(F.lds + RING_OFF);
            const int n0 = 16 * F.bid;
            f32x4 y = sgemv_part(WSB(WS_MIXS), DM, WSB(WS_WTO), DM, n0, F.wave * 256, 8, F.lane);
            y = block_reduce8(y, red, F.wave, F.lane);
            if (F.wave == 0 && F.lane < 32) {
#pragma unroll
                for (int j = 0; j < 4; ++j) { const int s = 4 * (F.lane >> 4) + j, n = n0 + (F.lane & 15); WSF(WS_XSO)[(size_t)s * DM + n] = ((const float*)args.in[1])[(size_t)s * DM + n] + y[j]; }
            }
        }
        const int gw = F.bid * 8 + F.wave, NGW = F.G * 8;
        for (int m = gw; m < MP; m += NGW) {
            const f32x4 p0 = *(const f32x4*)(WSF(WS_PS) + (size_t)m * 8), p1 = *(const f32x4*)(WSF(WS_PS) + (size_t)m * 8 + 4);
            const float ss = ((p0[0] + p0[1]) + (p0[2] + p0[3])) + ((p1[0] + p1[1]) + (p1[2] + p1[3]));
            const float rstd = 1.0f / sqrtf(ss * (1.f / DM) + RMS_EPS);
            f32x4* row = (f32x4*)(F.out + O_YP + (size_t)m * DM) + F.lane; const f32x4* gr = (const f32x4*)args.in[15] + F.lane;
#pragma unroll
            for (int j = 0; j < 8; ++j) { const f32x4 v = row[64 * j], gg = gr[64 * j]; row[64 * j] = v * rstd * gg; }
        }
    }
    SEAM(5);
    if (IN(6)) {
        const int gw = F.bid * 8 + F.wave;
        if (gw < NS) {
            const f32x4* xr = (const f32x4*)(WSF(WS_XSO) + (size_t)gw * DM) + F.lane; const f32x4* gr = (const f32x4*)args.in[15] + F.lane;
            f32x4 v[8]; float s = 0.f;
#pragma unroll
            for (int j = 0; j < 8; ++j) { v[j] = xr[64 * j]; s += (v[j].x * v[j].x + v[j].y * v[j].y) + (v[j].z * v[j].z + v[j].w * v[j].w); }
            const float rstd = 1.0f / sqrtf(wave_sum(s) * (1.f / DM) + RMS_EPS);
            f32x4* o = (f32x4*)(F.out + O_YS + (size_t)gw * DM) + F.lane;
#pragma unroll
            for (int j = 0; j < 8; ++j) o[64 * j] = v[j] * rstd * gr[64 * j];
        }
    }
#undef IN
#undef SEAM
}

extern "C" void kernel_launch(void* const* d_in, const int* in_sizes, int n_in, void* d_out, int out_size, void* d_ws, size_t ws_size, hipStream_t stream) {
    static int grid = 0;
    if (grid == 0) {
        if (n_in != 16 || out_size != (int)O_END || ws_size < WS_END) { fprintf(stderr, "kernel_launch: unexpected shapes: n_in %d out %d ws %zu\n", n_in, out_size, ws_size); grid = -1; return; }
        int dev = 0, cus = 0;
        if (hipGetDevice(&dev) != hipSuccess || hipDeviceGetAttribute(&cus, hipDeviceAttributeMultiprocessorCount, dev) != hipSuccess) { grid = -1; return; }
        if (hipFuncSetAttribute((const void*)mk_fwd, hipFuncAttributeMaxDynamicSharedMemorySize, LDS_BYTES) != hipSuccess) { fprintf(stderr, "kernel_launch: hipFuncSetAttribute failed\n"); grid = -1; return; }
        int per_cu = 0;
        if (hipOccupancyMaxActiveBlocksPerMultiprocessor(&per_cu, (const void*)mk_fwd, 512, LDS_BYTES) != hipSuccess || per_cu < 1) fprintf(stderr, "kernel_launch: occupancy query reports %d\n", per_cu);
        (void)hipGetLastError();
        grid = cus;
        if (grid != 256) fprintf(stderr, "kernel_launch: %d CUs; this kernel is laid out for 256\n", grid);
    }
    if (grid < 0) return;
    (void)hipMemsetAsync((char*)d_ws + WS_CTL, 0, CTL_ZERO_BYTES, stream);
    Args a{};
    for (int i = 0; i < 16; ++i) a.in[i] = d_in[i];
    a.out = (float*)d_out; a.ws = (unsigned char*)d_ws;
    constexpr int NPH = 7;
    if (MK_N_LAUNCHES == 1) { a.ph_lo = 0; a.ph_hi = NPH; a.li = 0; hipLaunchKernelGGL(mk_fwd, dim3(grid), dim3(512), LDS_BYTES, stream, a); }
    else for (int p = 0; p < NPH; ++p) { a.ph_lo = p; a.ph_hi = p + 1; a.li = p; hipLaunchKernelGGL(mk_fwd, dim3(grid), dim3(512), LDS_BYTES, stream, a); }
}
```

```cpp
#include <hip/hip_runtime.h>
#include <cstdio>
#include <cstdint>
#include <cmath>

#ifndef MK_N_LAUNCHES
#define MK_N_LAUNCHES 1
#endif

constexpr int DM = 2048, SEQ = 4096, NBATCH = 2, MP = NBATCH * SEQ, NS = 8, PAST = 16384, NPAGES = 128, PAGE = 128;
constexpr int LDH = 12032;
constexpr int HC_Q = 0, HC_K = 1024, HC_V = 1280, HC_QI = 1536, HC_WI = 3584, HC_KI = 3600, HC_ZA = 3840, HC_U = 4864, HC_VB = 5888, HC_ZB = 6912, HC_GA = 7936, HC_GB = 9984;
constexpr int IN_WIDTH = 11920;
constexpr float QSCALE = 0.08838834764831845f * 1.4426950408889634f;
constexpr float WSCALE = 0.25f * 0.08838834764831845f;
constexpr float RMS_EPS = 1e-6f, LN_EPS = 1e-5f;
constexpr size_t O_YP = 0, O_YS = 16777216, O_KP = 16793600, O_VP = 18890752, O_KIP = 20987904, O_KS = 22036480, O_VS = 22038528, O_KIS = 22040576, O_GV = 22041600, O_END = 22049792;
constexpr size_t MiB = 1u << 20;
constexpr size_t WS_CTL = 0, CTL_ZERO_BYTES = 32768;
constexpr size_t WS_WTIN = 2 * MiB, WS_WTA = 50 * MiB, WS_WTB = 54 * MiB, WS_WTO = 58 * MiB, WS_XN = 66 * MiB, WS_XNS = 98 * MiB, WS_HS = 99 * MiB, WS_SSC = 100 * MiB;
constexpr size_t WS_OABS = 101 * MiB, WS_MIXS = 101 * MiB + 256 * 1024, WS_XSO = 101 * MiB + 512 * 1024, WS_PS = 102 * MiB, WS_WI = 103 * MiB;
constexpr size_t WS_H = 104 * MiB, WS_OAB = 292 * MiB, WS_MIX = 324 * MiB, WS_SC = 356 * MiB, WS_KV8 = 420 * MiB, WS_PSV = 424 * MiB, WS_KI8 = 425 * MiB, WS_END = 426 * MiB;
#ifndef IDX_FP8
#define IDX_FP8 0
#endif
#ifndef ATT_FP8
#define ATT_FP8 1
#endif
constexpr int SSC_LD = 16448;
static_assert(WS_WTIN + (size_t)LDH * DM * 2 <= WS_WTA && WS_H + (size_t)MP * LDH * 2 <= WS_OAB && WS_WI + (size_t)MP * 16 * 4 <= WS_H, "ws map");
constexpr int CW_Q2 = 64;
constexpr int CW_SDONE = 1152;
constexpr int CW_BAR = 4096;

#define GAS __attribute__((address_space(1)))
#define LAS __attribute__((address_space(3)))
typedef unsigned short bf16;
typedef unsigned v4u __attribute__((ext_vector_type(4)));
typedef unsigned v2u __attribute__((ext_vector_type(2)));
typedef float f32x4 __attribute__((ext_vector_type(4)));
typedef float f32x2 __attribute__((ext_vector_type(2)));
typedef float f32x16 __attribute__((ext_vector_type(16)));
typedef short bf16x8 __attribute__((ext_vector_type(8)));
typedef short s16x4 __attribute__((ext_vector_type(4)));
typedef __bf16 bf16x2_t __attribute__((ext_vector_type(2)));
typedef int v2i_t __attribute__((ext_vector_type(2)));
typedef GAS unsigned gu32;
#define LDS_WAIT() asm volatile("s_waitcnt lgkmcnt(0)" ::: "memory")
#define VM_WAIT() asm volatile("s_waitcnt vmcnt(0)" ::: "memory")

__device__ __forceinline__ unsigned cvtpk(float lo, float hi) { f32x2 v = {lo, hi}; bf16x2_t b = __builtin_convertvector(v, bf16x2_t); return __builtin_bit_cast(unsigned, b); }
__device__ __forceinline__ float bf2f(unsigned short h) { return __uint_as_float((unsigned)h << 16); }
__device__ __forceinline__ float bflo(unsigned w) { return __uint_as_float(w << 16); }
__device__ __forceinline__ float bfhi(unsigned w) { return __uint_as_float(w & 0xffff0000u); }
__device__ __forceinline__ bf16x8 cvt8(f32x4 a, f32x4 b) { v4u w; w.x = cvtpk(a[0], a[1]); w.y = cvtpk(a[2], a[3]); w.z = cvtpk(b[0], b[1]); w.w = cvtpk(b[2], b[3]); return __builtin_bit_cast(bf16x8, w); }
__device__ __forceinline__ void store16_wt(void* p, v4u v) { asm volatile("global_store_dwordx4 %0, %1, off sc1\n\ts_nop 1" :: "v"(p), "v"(v) : "memory"); }
__device__ __forceinline__ float sigmoid_(float x) { return __builtin_amdgcn_rcpf(1.f + __builtin_amdgcn_exp2f(-1.4426950408889634f * x)); }
__device__ __forceinline__ float silu_(float x) { return x * sigmoid_(x); }
template <int CTRL> __device__ __forceinline__ float dppf(float v) { return __int_as_float(__builtin_amdgcn_mov_dpp(__float_as_int(v), CTRL, 0xF, 0xF, true)); }
template <int CTRL> __device__ __forceinline__ int dppi(int v) { return __builtin_amdgcn_mov_dpp(v, CTRL, 0xF, 0xF, true); }
__device__ __forceinline__ float x16_add(float v) { const auto x = __builtin_amdgcn_permlane16_swap(__float_as_uint(v), __float_as_uint(v), false, false); return __uint_as_float(x[0]) + __uint_as_float(x[1]); }
__device__ __forceinline__ float x32_add(float v) { const auto x = __builtin_amdgcn_permlane32_swap(__float_as_uint(v), __float_as_uint(v), false, false); return __uint_as_float(x[0]) + __uint_as_float(x[1]); }
__device__ __forceinline__ float x16_max(float v) { const auto x = __builtin_amdgcn_permlane16_swap(__float_as_uint(v), __float_as_uint(v), false, false); return fmaxf(__uint_as_float(x[0]), __uint_as_float(x[1])); }
__device__ __forceinline__ float x32_max(float v) { const auto x = __builtin_amdgcn_permlane32_swap(__float_as_uint(v), __float_as_uint(v), false, false); return fmaxf(__uint_as_float(x[0]), __uint_as_float(x[1])); }
__device__ __forceinline__ float x16_min(float v) { const auto x = __builtin_amdgcn_permlane16_swap(__float_as_uint(v), __float_as_uint(v), false, false); return fminf(__uint_as_float(x[0]), __uint_as_float(x[1])); }
__device__ __forceinline__ float x32_min(float v) { const auto x = __builtin_amdgcn_permlane32_swap(__float_as_uint(v), __float_as_uint(v), false, false); return fminf(__uint_as_float(x[0]), __uint_as_float(x[1])); }
__device__ __forceinline__ float xrows_add(float v) { return x32_add(x16_add(v)); }
__device__ __forceinline__ float xrows_max(float v) { return x32_max(x16_max(v)); }
__device__ __forceinline__ float wave_sum(float v) { v += dppf<0xB1>(v); v += dppf<0x4E>(v); v += dppf<0x141>(v); v += dppf<0x140>(v); return xrows_add(v); }
__device__ __forceinline__ int wave_sum_i(int v) { v += dppi<0xB1>(v); v += dppi<0x4E>(v); v += dppi<0x141>(v); v += dppi<0x140>(v);
    { const auto x = __builtin_amdgcn_permlane16_swap((unsigned)v, (unsigned)v, false, false); v = (int)(x[0] + x[1]); }
    { const auto x = __builtin_amdgcn_permlane32_swap((unsigned)v, (unsigned)v, false, false); v = (int)(x[0] + x[1]); } return v; }
__device__ __forceinline__ float wave_max(float v) { v = fmaxf(v, dppf<0xB1>(v)); v = fmaxf(v, dppf<0x4E>(v)); v = fmaxf(v, dppf<0x141>(v)); v = fmaxf(v, dppf<0x140>(v)); return xrows_max(v); }
__device__ __forceinline__ float wave_min(float v) { v = fminf(v, dppf<0xB1>(v)); v = fminf(v, dppf<0x4E>(v)); v = fminf(v, dppf<0x141>(v)); v = fminf(v, dppf<0x140>(v)); return x32_min(x16_min(v)); }

namespace pg8 {
#define PG8_LAS __attribute__((address_space(3)))
typedef unsigned short bf16_t;
typedef unsigned u32x4 __attribute__((ext_vector_type(4)));
constexpr int BM = 256, BK = 64, HALF = 128, HTB = HALF * BK * 2, STAGE_BYTES = 8 * HTB, NXCD = 8, WGM = 8;
__host__ __device__ __forceinline__ int lds_byte(int r, int c) { const int st = (r >> 4) * 2 + (c >> 5), rr = r & 15, cc = c & 31, ob = rr * 64 + cc * 2; return st * 1024 + (ob ^ (((ob >> 9) & 1) << 5)); }
__host__ __device__ __forceinline__ void stage_rc(int b, int& R, int& C) { const int st = b / 1024, sb = b % 1024, swz = sb ^ (((sb >> 9) & 1) << 5); R = (st >> 1) * 16 + swz / 64; C = (st & 1) * 32 + (swz % 64) / 2; }
__host__ __device__ __forceinline__ int perm32(int rho) { const int n = rho >> 4, i = rho & 15; return 8 * (i >> 2) + 4 * n + (i & 3); }
struct Unit { int pm, pn, kind; };
struct Gemm { const bf16_t* A0; const bf16_t* A1; const bf16_t* B0; const bf16_t* B1; int lda, ldb, K; };
struct StaticOrder {
    int nM, nN, nwg, G, c;
    __host__ __device__ void init(int M, int N, int G_, int c_) { nM = M / BM; nN = N / BM; nwg = nM * nN; G = G_; c = c_; }
    __host__ __device__ bool tile(long L, Unit& u) const {
        if (L >= nwg) return false;
        int wgid = (int)L; { const int q = nwg / NXCD, r = nwg % NXCD, xcd = wgid % NXCD, off = wgid / NXCD; wgid = (xcd < r ? xcd * (q + 1) : r * (q + 1) + (xcd - r) * q) + off; }
        const int nig = WGM * nN, gid = wgid / nig, fm = gid * WGM, gsz = (nM - fm) < WGM ? (nM - fm) : WGM;
        u.pm = fm + ((wgid % nig) % gsz); u.pn = (wgid % nig) / gsz; u.kind = 0; return true;
    }
    __host__ __device__ bool next(int i, Unit& u) const { return tile((long)i * G + c, u); }
};
struct PairOrder : StaticOrder {
    __host__ __device__ bool next(int i, Unit& u) const { if (i >= 2) return false; const bool ok = tile((long)c, u); u.kind = i; return ok; }
};

template <class Epi, class Sched, bool ALIGN_EPI = false, bool SP2 = false>
__device__ __forceinline__ void gemm_phase(PG8_LAS unsigned char* lds, const Gemm g, const Sched& S, const Epi& E) {
    const int tid = threadIdx.x, wid = __builtin_amdgcn_readfirstlane(tid >> 6), lane = tid & 63, wr = wid >> 2, wc = wid & 3, fr = lane & 15, fq = lane >> 4;
    const int K = g.K, nt = K / BK;
    unsigned voffA[2], voffB[2];
#pragma unroll
    for (int i = 0; i < 2; ++i) { int R, C; stage_rc(tid * 16 + i * 8192, R, C); const int Rb = Epi::PERM ? ((R & ~31) + perm32(R & 31)) : R;
        voffA[i] = (unsigned)(R * g.lda + C) * 2u; voffB[i] = (unsigned)(Rb * g.ldb + C) * 2u; }
    const size_t kstep = (size_t)(BK * 2);
    const size_t hstepA = (size_t)HALF * g.lda * 2, hstepB = (size_t)HALF * g.ldb * 2;
    const size_t tstepA = 2 * hstepA, tstepB = 2 * hstepB;
    const unsigned ldsw = (unsigned)wid * 1024u;
    const int aoff = lds_byte(wr * 64 + fr, fq * 8), boff = lds_byte(wc * 32 + fr, fq * 8);
#define PG8_SA(b, h) (((b) * 2 + (h)) * HTB)
#define PG8_SB(b, h) ((4 + (b) * 2 + (h)) * HTB)
#define PG8_STAGE(bufoff, gbase, voff) do { _Pragma("unroll") for (int _i = 0; _i < 2; ++_i) \
        __builtin_amdgcn_global_load_lds((const unsigned*)((const char*)(gbase) + (voff)[_i]), (PG8_LAS unsigned*)(lds + (bufoff) + ldsw + _i * 8192), 16, 0, 0); } while (0)
#define PG8_LDA(dst, b, h) do { _Pragma("unroll") for (int m = 0; m < 4; ++m) _Pragma("unroll") for (int k = 0; k < 2; ++k) dst[m][k] = *(const PG8_LAS bf16x8*)(lds + PG8_SA(b, h) + aoff + m * 2048 + k * 1024); } while (0)
#define PG8_LDB(dst, b, h) do { _Pragma("unroll") for (int n = 0; n < 2; ++n) _Pragma("unroll") for (int k = 0; k < 2; ++k) dst[n][k] = *(const PG8_LAS bf16x8*)(lds + PG8_SB(b, h) + boff + n * 2048 + k * 1024); } while (0)
#define PG8_MMA(ai, bj, At, Bt) do { __builtin_amdgcn_s_setprio(1); _Pragma("unroll") for (int m = 0; m < 4; ++m) _Pragma("unroll") for (int n = 0; n < 2; ++n) _Pragma("unroll") for (int k = 0; k < 2; ++k) \
        acc[ai][bj][m][n] = __builtin_amdgcn_mfma_f32_16x16x32_bf16(Bt[n][k], At[m][k], acc[ai][bj][m][n], 0, 0, 0); __builtin_amdgcn_s_setprio(0); } while (0)
#define PG8_WAIT_V(n) asm volatile("s_waitcnt vmcnt(" #n ")" ::: "memory")
#define PG8_WAIT_L(n) asm volatile("s_waitcnt lgkmcnt(" #n ")" ::: "memory")
#define PG8_BAR __builtin_amdgcn_s_barrier()
#define PG8_SCHED __builtin_amdgcn_sched_barrier(0)
#define PG8_OPA(u) ((const char*)((u).kind ? g.A1 : g.A0) + (size_t)(u).pm * tstepA)
#define PG8_OPB(u) ((const char*)((u).kind ? g.B1 : g.B0) + (size_t)(u).pn * tstepB)
    Unit cur, nxt; int ui = 0;
    if (!S.next(0, cur)) return;
    f32x4 acc[2][2][4][2];
#pragma unroll
    for (int a = 0; a < 2; ++a)
#pragma unroll
        for (int b = 0; b < 2; ++b)
#pragma unroll
            for (int m = 0; m < 4; ++m)
#pragma unroll
                for (int n = 0; n < 2; ++n) acc[a][b][m][n] = (f32x4){0.f, 0.f, 0.f, 0.f};
    bf16x8 At[4][2], B0[2][2], B1[2][2];
    const char* cA = PG8_OPA(cur); const char* cB = PG8_OPB(cur);
    if constexpr (SP2) {
        PG8_STAGE(PG8_SB(0, 0), cB, voffB); PG8_STAGE(PG8_SB(0, 1), cB + hstepB, voffB); PG8_STAGE(PG8_SA(0, 0), cA, voffA); PG8_STAGE(PG8_SA(0, 1), cA + hstepA, voffA);
        if (wr == 1) PG8_BAR;
        PG8_WAIT_V(2); PG8_BAR;
        PG8_STAGE(PG8_SB(1, 0), cB + kstep, voffB); PG8_STAGE(PG8_SA(1, 0), cA + kstep, voffA); PG8_STAGE(PG8_SB(1, 1), cB + hstepB + kstep, voffB);
        PG8_WAIT_V(6); PG8_BAR;
    } else {
        PG8_STAGE(PG8_SB(0, 0), cB, voffB); PG8_STAGE(PG8_SA(0, 0), cA, voffA); PG8_STAGE(PG8_SB(0, 1), cB + hstepB, voffB); PG8_STAGE(PG8_SA(0, 1), cA + hstepA, voffA);
        if (wr == 1) PG8_BAR;
        PG8_WAIT_V(4); PG8_BAR;
        PG8_STAGE(PG8_SB(1, 0), cB + kstep, voffB); PG8_STAGE(PG8_SA(1, 0), cA + kstep, voffA); PG8_STAGE(PG8_SB(1, 1), cB + hstepB + kstep, voffB);
        PG8_WAIT_V(6); PG8_BAR;
    }
    for (;;) {
        const bool has_next = S.next(ui + 1, nxt);
        const char* nA = has_next ? PG8_OPA(nxt) : cA; const char* nB = has_next ? PG8_OPB(nxt) : cB;
        for (int t = 0; t < nt; t += 2) {
            const bool last = (t == nt - 2);
            const char* a1 = cA + (size_t)(t + 1) * kstep;
            const char* a2 = last ? nA : cA + (size_t)(t + 2) * kstep; const char* b2 = last ? nB : cB + (size_t)(t + 2) * kstep;
            const char* a3 = a2 + kstep; const char* b3 = b2 + kstep;
            if constexpr (SP2) {
            PG8_LDB(B0, 0, 0); PG8_LDB(B1, 0, 1); PG8_SCHED; PG8_LDA(At, 0, 0); PG8_STAGE(PG8_SA(1, 1), a1 + hstepA, voffA);
            PG8_WAIT_V(8); PG8_WAIT_L(0); PG8_BAR; PG8_MMA(0, 0, At, B0); PG8_MMA(0, 1, At, B1); PG8_BAR; PG8_SCHED;
            PG8_LDA(At, 0, 1); PG8_STAGE(PG8_SB(0, 0), b2, voffB); PG8_STAGE(PG8_SB(0, 1), b2 + hstepB, voffB); PG8_STAGE(PG8_SA(0, 0), a2, voffA);
            PG8_WAIT_V(8); PG8_WAIT_L(0); PG8_BAR; PG8_MMA(1, 0, At, B0); PG8_MMA(1, 1, At, B1); PG8_BAR; PG8_SCHED;
            PG8_LDB(B0, 1, 0); PG8_LDB(B1, 1, 1); PG8_SCHED; PG8_LDA(At, 1, 0); PG8_STAGE(PG8_SA(0, 1), a2 + hstepA, voffA);
            PG8_WAIT_V(8); PG8_WAIT_L(0); PG8_BAR; PG8_MMA(0, 0, At, B0); PG8_MMA(0, 1, At, B1); PG8_BAR; PG8_SCHED;
            PG8_LDA(At, 1, 1); PG8_STAGE(PG8_SB(1, 0), b3, voffB); PG8_STAGE(PG8_SB(1, 1), b3 + hstepB, voffB); PG8_STAGE(PG8_SA(1, 0), a3, voffA);
            PG8_WAIT_V(8); PG8_WAIT_L(0); PG8_BAR; PG8_MMA(1, 0, At, B0); PG8_MMA(1, 1, At, B1); PG8_BAR; PG8_SCHED;
            } else {
            PG8_LDB(B0, 0, 0); PG8_SCHED; PG8_LDA(At, 0, 0); PG8_STAGE(PG8_SA(1, 1), a1 + hstepA, voffA);
            PG8_WAIT_L(8); PG8_BAR; PG8_WAIT_L(0); PG8_MMA(0, 0, At, B0); PG8_BAR; PG8_SCHED;
            PG8_LDB(B1, 0, 1); PG8_STAGE(PG8_SB(0, 0), b2, voffB);
            PG8_BAR; PG8_WAIT_L(0); PG8_MMA(0, 1, At, B1); PG8_BAR;
            PG8_LDA(At, 0, 1); PG8_STAGE(PG8_SA(0, 0), a2, voffA);
            PG8_BAR; PG8_WAIT_L(0); PG8_MMA(1, 0, At, B0); PG8_BAR; PG8_SCHED;
            PG8_STAGE(PG8_SB(0, 1), b2 + hstepB, voffB);
            PG8_WAIT_V(6); PG8_BAR; PG8_MMA(1, 1, At, B1); PG8_BAR;
            PG8_LDB(B0, 1, 0); PG8_SCHED; PG8_LDA(At, 1, 0); PG8_STAGE(PG8_SA(0, 1), a2 + hstepA, voffA);
            PG8_WAIT_L(8); PG8_BAR; PG8_WAIT_L(0); PG8_MMA(0, 0, At, B0); PG8_BAR; PG8_SCHED;
            PG8_LDB(B1, 1, 1); PG8_STAGE(PG8_SB(1, 0), b3, voffB);
            PG8_BAR; PG8_WAIT_L(0); PG8_MMA(0, 1, At, B1); PG8_BAR;
            PG8_LDA(At, 1, 1); PG8_STAGE(PG8_SA(1, 0), a3, voffA);
            PG8_BAR; PG8_WAIT_L(0); PG8_MMA(1, 0, At, B0); PG8_BAR; PG8_SCHED;
            PG8_STAGE(PG8_SB(1, 1), b3 + hstepB, voffB);
            PG8_WAIT_V(6); PG8_BAR; PG8_MMA(1, 1, At, B1); PG8_BAR;
            }
        }
        if constexpr (ALIGN_EPI) { if (wr == 0) PG8_BAR; }
        if constexpr (!Epi::AFTER_DRAIN) { E(acc, cur, wr, wc, fr, fq); }
        if (!has_next) break;
        if (!(Epi::KEEP && cur.kind == 0)) {
#pragma unroll
        for (int a = 0; a < 2; ++a)
#pragma unroll
            for (int b = 0; b < 2; ++b)
#pragma unroll
                for (int m = 0; m < 4; ++m)
#pragma unroll
                    for (int n = 0; n < 2; ++n) acc[a][b][m][n] = (f32x4){0.f, 0.f, 0.f, 0.f};
        }
        cur = nxt; cA = nA; cB = nB; ++ui;
        if constexpr (ALIGN_EPI) { if (wr == 1) PG8_BAR; }
    }
    PG8_WAIT_V(0);
    if constexpr (!ALIGN_EPI) { if (wr == 0) PG8_BAR; }
    PG8_BAR;
    if constexpr (Epi::AFTER_DRAIN) { E.fused(acc, cur, wr, wc, fr, fq, lds, wid, lane); }
#undef PG8_SA
#undef PG8_SB
#undef PG8_STAGE
#undef PG8_LDA
#undef PG8_LDB
#undef PG8_MMA
#undef PG8_WAIT_V
#undef PG8_WAIT_L
#undef PG8_BAR
#undef PG8_SCHED
#undef PG8_OPA
#undef PG8_OPB
}

__device__ __forceinline__ f32x2 gelu_pk(f32x2 v) {
    const f32x2 av = __builtin_elementwise_abs(v), d = av * 0.2316418882f + 1.0f;
    f32x2 t; t.x = __builtin_amdgcn_rcpf(d.x); t.y = __builtin_amdgcn_rcpf(d.y);
    f32x2 q = t * 0.5307027145f + (-0.7265760135f); q = q * t + 0.7107068705f; q = q * t + (-0.142248368f); q = q * t + 0.127414796f; q = q * t;
    const f32x2 s = (v * v) * (-0.72134752044f);
    f32x2 e; e.x = __builtin_amdgcn_exp2f(s.x); e.y = __builtin_amdgcn_exp2f(s.y);
    const f32x2 m = v * (q * e), r = v - m;
    f32x2 o; o.x = v.x < 0.f ? m.x : r.x; o.y = v.y < 0.f ? m.y : r.y; return o;
}

struct EpiInProj {
    static constexpr bool PERM = true, AFTER_DRAIN = false, KEEP = false;
    bf16_t* H; float* out; float* WI; unsigned char* KV8; unsigned char* KI8; float* PSV;
    __device__ __forceinline__ void operator()(f32x4 (&acc)[2][2][4][2], const Unit& u, int wr, int wc, int fr, int fq) const {
        const int pn = u.pn;
        int act;
        if (pn < 4) act = 1; else if (pn == 4) act = 5; else if (pn == 5) act = 6; else if (pn < 14) act = 0; else if (pn == 14) act = 7;
        else if (pn < 19) act = 2; else if (pn < 27) act = 3; else if (pn < 31) act = 2; else act = 4;
        const int row0 = u.pm * BM + wr * 64 + fr, col0 = pn * BM + wc * 32 + 8 * fq;
#pragma unroll
        for (int ai = 0; ai < 2; ++ai)
#pragma unroll
            for (int m = 0; m < 4; ++m) { const int row = row0 + ai * HALF + m * 16; bf16_t* hrow = H + (size_t)row * LDH; float s1 = 0.f, s2 = 0.f;
#pragma unroll
                for (int bj = 0; bj < 2; ++bj) { f32x4 v0 = acc[ai][bj][m][0], v1 = acc[ai][bj][m][1]; const int c = col0 + bj * HALF;
                    bool st = true;
                    if (act == 1) { v0 = v0 * QSCALE; v1 = v1 * QSCALE; }
                    else if (act == 2) {
#pragma unroll
                        for (int j = 0; j < 4; ++j) { v0[j] = silu_(v0[j]); v1[j] = silu_(v1[j]); } }
                    else if (act == 3) { f32x2 a = gelu_pk((f32x2){v0[0], v0[1]}), b = gelu_pk((f32x2){v0[2], v0[3]}), cc = gelu_pk((f32x2){v1[0], v1[1]}), d = gelu_pk((f32x2){v1[2], v1[3]});
                        v0 = (f32x4){a.x, a.y, b.x, b.y}; v1 = (f32x4){cc.x, cc.y, d.x, d.y};
                        s1 += ((v0[0] + v0[1]) + (v0[2] + v0[3])) + ((v1[0] + v1[1]) + (v1[2] + v1[3]));
                        s2 += ((v0[0] * v0[0] + v0[1] * v0[1]) + (v0[2] * v0[2] + v0[3] * v0[3])) + ((v1[0] * v1[0] + v1[1] * v1[1]) + (v1[2] * v1[2] + v1[3] * v1[3])); }
                    else if (act == 4) {
#pragma unroll
                        for (int j = 0; j < 4; ++j) { v0[j] = sigmoid_(v0[j]); v1[j] = sigmoid_(v1[j]); } }
                    else if (act == 5 || act == 6) { float* o = out + (act == 5 ? O_KP : O_VP) + (size_t)row * 256 + (c - (act == 5 ? HC_K : HC_V)); *(f32x4*)o = v0; *(f32x4*)(o + 4) = v1;
                        if (ATT_FP8) { int w0 = __builtin_amdgcn_cvt_pk_fp8_f32(v0[0], v0[1], 0, false); w0 = __builtin_amdgcn_cvt_pk_fp8_f32(v0[2], v0[3], w0, true);
                            int w1 = __builtin_amdgcn_cvt_pk_fp8_f32(v1[0], v1[1], 0, false); w1 = __builtin_amdgcn_cvt_pk_fp8_f32(v1[2], v1[3], w1, true);
                            *(v2u*)(KV8 + (size_t)row * 512 + (act == 5 ? 0 : 256) + (c - (act == 5 ? HC_K : HC_V))) = (v2u){(unsigned)w0, (unsigned)w1}; st = false; } }
                    else if (act == 7) { const int cl = c - HC_WI;
                        if (cl < 16) { float* o = WI + (size_t)row * 16 + cl; *(f32x4*)o = v0 * WSCALE; *(f32x4*)(o + 4) = v1 * WSCALE; st = false; }
                        else if (cl < 144) { float* o = out + O_KIP + (size_t)row * 128 + (cl - 16); *(f32x4*)o = v0; *(f32x4*)(o + 4) = v1;
                            if (IDX_FP8) { int w0 = __builtin_amdgcn_cvt_pk_fp8_f32(v0[0], v0[1], 0, false); w0 = __builtin_amdgcn_cvt_pk_fp8_f32(v0[2], v0[3], w0, true);
                                int w1 = __builtin_amdgcn_cvt_pk_fp8_f32(v1[0], v1[1], 0, false); w1 = __builtin_amdgcn_cvt_pk_fp8_f32(v1[2], v1[3], w1, true);
                                *(v2u*)(KI8 + (size_t)row * 128 + (cl - 16)) = (v2u){(unsigned)w0, (unsigned)w1}; } }
                        else st = false; }
                    if (st) { u32x4 w; w.x = cvtpk(v0[0], v0[1]); w.y = cvtpk(v0[2], v0[3]); w.z = cvtpk(v1[0], v1[1]); w.w = cvtpk(v1[2], v1[3]); store16_wt(hrow + c, w); } }
                if (pn >= 23 && pn < 27) {
                    s1 = xrows_add(s1); s2 = xrows_add(s2);
                    if (fq == 0) *(f32x2*)(PSV + ((size_t)row * 16 + (pn - 23) * 4 + wc) * 2) = (f32x2){s1, s2}; } }
    }
};
struct EpiMix {
    static constexpr bool PERM = true, AFTER_DRAIN = false, KEEP = true;
    const bf16_t* H; bf16_t* MIX;
    __device__ __forceinline__ void operator()(f32x4 (&acc)[2][2][4][2], const Unit& u, int wr, int wc, int fr, int fq) const {
        const int row0 = u.pm * BM + wr * 64 + fr, col0 = u.pn * BM + wc * 32 + 8 * fq;
#pragma unroll
        for (int ai = 0; ai < 2; ++ai) {
            u32x4 gb[4][2], ga[4][2];
#pragma unroll
            for (int m = 0; m < 4; ++m)
#pragma unroll
                for (int bj = 0; bj < 2; ++bj) { const bf16_t* hp = H + (size_t)(row0 + ai * HALF + m * 16) * LDH + col0 + bj * HALF;
                    gb[m][bj] = *(const u32x4*)(hp + HC_GB); if (u.kind == 0) ga[m][bj] = *(const u32x4*)(hp + HC_GA); }
            __builtin_amdgcn_sched_barrier(0);
#pragma unroll
            for (int m = 0; m < 4; ++m) { const int row = row0 + ai * HALF + m * 16;
#pragma unroll
                for (int bj = 0; bj < 2; ++bj) { const int c = col0 + bj * HALF; const u32x4 gbv = gb[m][bj];
                    float b[8] = {bflo(gbv.x), bfhi(gbv.x), bflo(gbv.y), bfhi(gbv.y), bflo(gbv.z), bfhi(gbv.z), bflo(gbv.w), bfhi(gbv.w)};
                    if (u.kind == 0) {
                        const u32x4 gav = ga[m][bj];
                        float a[8] = {bflo(gav.x), bfhi(gav.x), bflo(gav.y), bfhi(gav.y), bflo(gav.z), bfhi(gav.z), bflo(gav.w), bfhi(gav.w)};
#pragma unroll
                        for (int j = 0; j < 4; ++j) { acc[ai][bj][m][0][j] *= a[j] * __builtin_amdgcn_rcpf(fmaxf(b[j], 1e-30f)); acc[ai][bj][m][1][j] *= a[4 + j] * __builtin_amdgcn_rcpf(fmaxf(b[4 + j], 1e-30f)); }
                    } else {
                        f32x4 v0 = acc[ai][bj][m][0], v1 = acc[ai][bj][m][1];
#pragma unroll
                        for (int j = 0; j < 4; ++j) { v0[j] *= b[j]; v1[j] *= b[4 + j]; }
                        u32x4 w; w.x = cvtpk(v0[0], v0[1]); w.y = cvtpk(v0[2], v0[3]); w.z = cvtpk(v1[0], v1[1]); w.w = cvtpk(v1[2], v1[3]); *(u32x4*)(MIX + (size_t)row * DM + c) = w; } } }
            __builtin_amdgcn_sched_barrier(0);
        }
    }
};
template <class Bar>
struct EpiOut {
    static constexpr bool PERM = false, AFTER_DRAIN = true, KEEP = false;
    const float* X; float* out; float* PS; const float* gf; Bar bar; unsigned* prb; unsigned long long t0;
    __device__ __forceinline__ void fused(f32x4 (&acc)[2][2][4][2], const Unit& u, int wr, int wc, int fr, int fq, PG8_LAS unsigned char* lds, int wid, int lane) const {
        PG8_LAS float* P = (PG8_LAS float*)lds;
        PG8_LAS float* R = (PG8_LAS float*)(lds + 4096);
        const int col0 = u.pn * BM + wc * 32 + 4 * fq;
#pragma unroll
        for (int ai = 0; ai < 2; ++ai) {
            f32x4 xv[4][2][2];
#pragma unroll
            for (int m = 0; m < 4; ++m) { const size_t off = (size_t)(u.pm * BM + ai * HALF + wr * 64 + m * 16 + fr) * DM + col0;
#pragma unroll
                for (int bj = 0; bj < 2; ++bj)
#pragma unroll
                    for (int n = 0; n < 2; ++n) xv[m][bj][n] = *(const f32x4*)(X + off + bj * HALF + n * 16); }
            __builtin_amdgcn_sched_barrier(0);
#pragma unroll
            for (int m = 0; m < 4; ++m) { const int rl = ai * HALF + wr * 64 + m * 16 + fr; float s = 0.f;
#pragma unroll
                for (int bj = 0; bj < 2; ++bj)
#pragma unroll
                    for (int n = 0; n < 2; ++n) { const f32x4 v = acc[ai][bj][m][n] + xv[m][bj][n];
                        acc[ai][bj][m][n] = v; s += (v[0] * v[0] + v[1] * v[1]) + (v[2] * v[2] + v[3] * v[3]); }
                s = xrows_add(s);
                if (fq == 0) P[rl * 4 + wc] = s; }
            __builtin_amdgcn_sched_barrier(0);
        }
        asm volatile("s_waitcnt lgkmcnt(0)" ::: "memory"); __builtin_amdgcn_s_barrier(); asm volatile("" ::: "memory");
        const int tid = wid * 64 + lane;
        if (tid < 256) { const float t = (P[tid * 4 + 0] + P[tid * 4 + 1]) + (P[tid * 4 + 2] + P[tid * 4 + 3]); PS[(size_t)(u.pm * BM + tid) * 8 + u.pn] = t; }
        if (prb && threadIdx.x == 0) atomicAdd(prb, (unsigned)(__builtin_amdgcn_s_memrealtime() - t0));
        bar();
        if (tid < 256) { const float* ps = PS + (size_t)(u.pm * BM + tid) * 8; const f32x4 p0 = *(const f32x4*)ps, p1 = *(const f32x4*)(ps + 4);
            const float ss = ((p0[0] + p0[1]) + (p0[2] + p0[3])) + ((p1[0] + p1[1]) + (p1[2] + p1[3]));
            R[tid] = 1.0f / sqrtf(ss * (1.f / DM) + RMS_EPS); }
        asm volatile("s_waitcnt lgkmcnt(0)" ::: "memory"); __builtin_amdgcn_s_barrier(); asm volatile("" ::: "memory");
        f32x4 gv[2][2];
#pragma unroll
        for (int bj = 0; bj < 2; ++bj)
#pragma unroll
            for (int n = 0; n < 2; ++n) gv[bj][n] = *(const f32x4*)(gf + col0 + bj * HALF + n * 16);
#pragma unroll
        for (int ai = 0; ai < 2; ++ai)
#pragma unroll
            for (int m = 0; m < 4; ++m) { const int rl = ai * HALF + wr * 64 + m * 16 + fr; const size_t off = (size_t)(u.pm * BM + rl) * DM + col0; const float rs = R[rl];
#pragma unroll
                for (int bj = 0; bj < 2; ++bj)
#pragma unroll
                    for (int n = 0; n < 2; ++n) *(f32x4*)(out + off + bj * HALF + n * 16) = acc[ai][bj][m][n] * rs * gv[bj][n]; }
    }
};
}

constexpr int RING_OFF = 0, RING_BYTES = 131072;
constexpr int LDSCTL_OFF = RING_BYTES, MISC_OFF = LDSCTL_OFF + 320;
constexpr int LDS_BYTES = 147456;

#define XB_TMO      128
#define XB_XCNT(j)  (256  + 64 * (j))
#define XB_XSUB(j)  (1280 + 64 * (j))
#define XB_XGEN(j)  (2304 + 64 * (j))
#define XB_TOP      3328
#define XB_TOPGEN   3392
#define XCD_BAR_WORDS 3456
#define XB_SPIN_CAP (1u << 18)
__device__ __forceinline__ unsigned xb_ld(unsigned* p)              { return __hip_atomic_load(p, __ATOMIC_RELAXED, __HIP_MEMORY_SCOPE_AGENT); }
__device__ __forceinline__ unsigned xb_add(unsigned* p, unsigned v) { return __hip_atomic_fetch_add(p, v, __ATOMIC_RELAXED, __HIP_MEMORY_SCOPE_AGENT); }
__device__ __forceinline__ unsigned xb_xcc_id() { return (unsigned)__builtin_amdgcn_s_getreg((3 << 11) | 20) & 0xFu; }
#define XB_SPIN(cond, bar) do { unsigned _sp = 0; while (cond) { __builtin_amdgcn_s_sleep(1); \
    if ((++_sp & 255u) == 0u) { if (xb_ld(&(bar)[XB_TMO])) break; if (_sp > XB_SPIN_CAP) { atomicAdd(&(bar)[XB_TMO], 1u); break; } } } } while (0)
struct XcdBarrier { unsigned* bar; unsigned x; volatile LAS unsigned* st; };
__device__ __forceinline__ XcdBarrier xcd_barrier_post(unsigned* bar, volatile LAS unsigned* st) {
    XcdBarrier b; b.bar = bar; b.x = xb_xcc_id(); b.st = st;
    if (threadIdx.x == 0) (void)xb_add(&bar[XB_XCNT(b.x)], 1u);
    return b;
}
__device__ __forceinline__ void xcd_barrier_complete(unsigned* bar, unsigned x, unsigned& nloc, unsigned& nx) {
    const unsigned G = gridDim.x * gridDim.y * gridDim.z;
    unsigned sum, cnt, mine, sp = 0u;
    for (;;) {
        sum = 0u; cnt = 0u; mine = 0u;
#pragma unroll
        for (unsigned j = 0; j < 16; ++j) { const unsigned c = xb_ld(&bar[XB_XCNT(j)]); sum += c; cnt += (c > 0u) ? 1u : 0u; mine = (j == x) ? c : mine; }
        if (sum == G) break;
        __builtin_amdgcn_s_sleep(1);
        if ((++sp & 255u) == 0u) { if (xb_ld(&bar[XB_TMO])) break; if (sp > XB_SPIN_CAP) { atomicAdd(&bar[XB_TMO], 1u); break; } }
    }
    nloc = mine > 0u ? mine : 1u; nx = cnt > 0u ? cnt : 1u;
}
__device__ __forceinline__ void xcd_barrier(const XcdBarrier& b) {
    asm volatile("s_waitcnt vmcnt(0)" ::: "memory");
    __syncthreads();
    if (threadIdx.x == 0) {
        unsigned* bar = b.bar;
        __builtin_amdgcn_s_waitcnt(0);
        unsigned nloc = b.st[0], nx = b.st[1];
        if (nloc == 0u) { xcd_barrier_complete(bar, b.x, nloc, nx); b.st[0] = nloc; b.st[1] = nx; }
        const unsigned old = xb_add(&bar[XB_XSUB(b.x)], 1u);
        const unsigned gen = old / nloc;
        if (old + 1u == (gen + 1u) * nloc) {
            __builtin_amdgcn_fence(__ATOMIC_RELEASE, "agent");
            asm volatile("s_waitcnt vmcnt(0)" ::: "memory");
            const unsigned og = xb_add(&bar[XB_TOP], 1u);
            const unsigned tg = og / nx;
            if (og + 1u == (tg + 1u) * nx) xb_add(&bar[XB_TOPGEN], 1u);
            else XB_SPIN(xb_ld(&bar[XB_TOPGEN]) == tg, bar);
            __builtin_amdgcn_fence(__ATOMIC_ACQUIRE, "agent");
            xb_add(&bar[XB_XGEN(b.x)], 1u);
            asm volatile("s_waitcnt vmcnt(0)" ::: "memory");
        } else {
            XB_SPIN(xb_ld(&bar[XB_XGEN(b.x)]) == gen, bar);
            __builtin_amdgcn_fence(__ATOMIC_ACQUIRE, "agent");
            asm volatile("s_waitcnt vmcnt(0)" ::: "memory");
        }
    }
    __syncthreads();
}

#ifndef PROBE_ID
#define PROBE_ID -1
#endif
constexpr int CW_PROBE = 2048;
#ifndef PROBE_QUANT
#define PROBE_QUANT 1u
#endif
#define PRB_Q(x) (((x) / PROBE_QUANT) * PROBE_QUANT)
#define PRB_T() (PROBE_ID >= 0 ? __builtin_amdgcn_s_memrealtime() : 0ull)
#define PRB_ADD(k, t0) do { if (PROBE_ID >= 0 && threadIdx.x == 0) atomicAdd((unsigned*)(((gu32*)(F.ws + WS_CTL)) + CW_PROBE + (k)), (unsigned)(__builtin_amdgcn_s_memrealtime() - (t0))); } while (0)
struct Args { const void* in[16]; float* out; unsigned char* ws; int ph_lo, ph_hi, li, pad; };
#define WSB(off) ((bf16*)(F.ws + (off)))
#define WSF(off) ((float*)(F.ws + (off)))
struct In { const float *xp, *xs, *ck, *cv, *cki, *gin, *win, *wpa, *wpb, *wo, *lng, *lnb, *wsp, *bsp, *gf; const int* pt; };
struct Ctx {
    LAS unsigned char* lds; int tid, lane, wave, G, bid;
    float* out; unsigned char* ws;
};

__device__ __forceinline__ unsigned f2bf(float f) { unsigned u = __builtin_bit_cast(unsigned, f); return (u + 0x7fffu + ((u >> 16) & 1u)) >> 16; }
__device__ __forceinline__ unsigned pk2(float lo, float hi) { return f2bf(lo) | (f2bf(hi) << 16); }
__device__ __forceinline__ void p0_transpose_item(const float* W, int K, int Nsrc, bf16* WT, bool remap, int kb, int nb, int lane) {
    const int k0 = 64 * kb, nd = 64 * nb + lane; int ns = nd; bool ok = true;
    if (remap) { if (nd >= 3840) ns = nd - 112; else if (nd >= 3728) { ok = false; ns = 0; } }
    const float* src = W + (size_t)k0 * Nsrc + ns;
    float v[64];
#pragma unroll
    for (int i = 0; i < 64; ++i) v[i] = __builtin_nontemporal_load(&src[(size_t)i * Nsrc]);
    v4u* dst = (v4u*)(WT + (size_t)nd * K + k0);
#pragma unroll
    for (int j = 0; j < 8; ++j) { v4u o; o.x = cvtpk(v[8 * j], v[8 * j + 1]); o.y = cvtpk(v[8 * j + 2], v[8 * j + 3]); o.z = cvtpk(v[8 * j + 4], v[8 * j + 5]); o.w = cvtpk(v[8 * j + 6], v[8 * j + 7]);
        if (!ok) o = (v4u){0u, 0u, 0u, 0u};
        dst[j] = o; }
}
__device__ __forceinline__ void rms_row_to_bf16(const float* xrow, const float* g, bf16* orow, int lane) {
    const f32x4* xr = (const f32x4*)xrow + lane; const f32x4* gr = (const f32x4*)g + lane;
    f32x4 v[8]; float s = 0.f;
#pragma unroll
    for (int j = 0; j < 8; ++j) { v[j] = __builtin_nontemporal_load(&xr[64 * j]); s += (v[j].x * v[j].x + v[j].y * v[j].y) + (v[j].z * v[j].z + v[j].w * v[j].w); }
    const float rstd = 1.0f / sqrtf(wave_sum(s) * (1.f / DM) + RMS_EPS);
    v2u* o8 = (v2u*)orow + lane;
#pragma unroll
    for (int j = 0; j < 8; ++j) { const f32x4 gg = gr[64 * j]; v2u w; w.x = cvtpk(v[j].x * rstd * gg.x, v[j].y * rstd * gg.y); w.y = cvtpk(v[j].z * rstd * gg.z, v[j].w * rstd * gg.w); o8[64 * j] = w; }
}
__device__ __forceinline__ void p0_prologue(Ctx& F, const In& I) {
    int lane = F.lane; asm volatile("" : "+v"(lane));
    const int gw = F.bid * 8 + F.wave, NGW = F.G * 8;
    constexpr int NB_IN = LDH / 64, I_IN = (DM / 64) * NB_IN;
    constexpr int I_A = (1024 / 64) * (DM / 64), I_O = (DM / 64) * (DM / 64);
    constexpr int NITEMS = I_IN + 2 * I_A + I_O;
#pragma unroll 1
    for (int it = gw; it < NITEMS; it += NGW) {
        int r = it;
        if (r < I_IN) { p0_transpose_item(I.win, DM, IN_WIDTH, WSB(WS_WTIN), true, r / NB_IN, r % NB_IN, lane); continue; } r -= I_IN;
        if (r < I_A) { p0_transpose_item(I.wpa, 1024, DM, WSB(WS_WTA), false, r / (DM / 64), r % (DM / 64), lane); continue; } r -= I_A;
        if (r < I_A) { p0_transpose_item(I.wpb, 1024, DM, WSB(WS_WTB), false, r / (DM / 64), r % (DM / 64), lane); continue; } r -= I_A;
        p0_transpose_item(I.wo, DM, DM, WSB(WS_WTO), false, r / (DM / 64), r % (DM / 64), lane);
    }
    for (int m = gw; m < MP + NS; m += NGW) {
        if (m < MP) rms_row_to_bf16(I.xp + (size_t)m * DM, I.gin, WSB(WS_XN) + (size_t)m * DM, lane);
        else rms_row_to_bf16(I.xs + (size_t)(m - MP) * DM, I.gin, WSB(WS_XNS) + (size_t)(m - MP) * DM, lane);
    }
}

template <int NSTEPS>
__device__ __forceinline__ f32x4 sgemv_part_t(const bf16* X, int ldx, const bf16* Wt, int ldw, int n0, int kbeg, int lane) {
    const int r = lane & 15, q = lane >> 4;
    const bf16* xp = X + (size_t)(r & 7) * ldx + kbeg + 8 * q; const bf16* wp = Wt + (size_t)(n0 + r) * ldw + kbeg + 8 * q;
    const bf16x8 z = {0, 0, 0, 0, 0, 0, 0, 0};
    bf16x8 a[NSTEPS], b[NSTEPS];
#pragma unroll
    for (int st = 0; st < NSTEPS; ++st) { a[st] = *(const bf16x8*)(xp + 32 * st); b[st] = *(const bf16x8*)(wp + 32 * st); }
    __builtin_amdgcn_sched_barrier(0);
    f32x4 acc = {0.f, 0.f, 0.f, 0.f};
#pragma unroll
    for (int st = 0; st < NSTEPS; ++st) acc = __builtin_amdgcn_mfma_f32_16x16x32_bf16(r >= 8 ? z : a[st], b[st], acc, 0, 0, 0);
    return acc;
}
__device__ __forceinline__ f32x4 sgemv_part(const bf16* X, int ldx, const bf16* Wt, int ldw, int n0, int kbeg, int nsteps, int lane) {
    return nsteps == 8 ? sgemv_part_t<8>(X, ldx, Wt, ldw, n0, kbeg, lane) : sgemv_part_t<4>(X, ldx, Wt, ldw, n0, kbeg, lane);
}
__device__ __forceinline__ f32x4 block_reduce8(f32x4 v, LAS float* red, int wave, int lane) {
    *(LAS f32x4*)(red + (wave * 64 + lane) * 4) = v;
    __syncthreads();
    f32x4 s = {0.f, 0.f, 0.f, 0.f};
    if (wave == 0) {
#pragma unroll
        for (int w = 0; w < 8; ++w) s += *(LAS f32x4*)(red + (w * 64 + lane) * 4);
    }
    __syncthreads();
    return s;
}
__device__ __forceinline__ void finish_sample_col(Ctx& F, int s, int n, float v) {
    float h = v;
    if (n < HC_K) h = v * QSCALE;
    else if (n < HC_V) F.out[O_KS + s * 256 + (n - HC_K)] = v;
    else if (n < HC_QI) F.out[O_VS + s * 256 + (n - HC_V)] = v;
    else if (n < HC_WI) {}
    else if (n < HC_KI) h = v * WSCALE;
    else if (n < 3728) F.out[O_KIS + s * 128 + (n - HC_KI)] = v;
    else if (n < HC_ZA) h = 0.f;
    else if (n < HC_U) h = silu_(v);
    else if (n < HC_ZB) h = 0.5f * v * (1.0f + erff(v * 0.70710678118654752f));
    else if (n < HC_GA) h = silu_(v);
    else h = sigmoid_(v);
    WSF(WS_HS)[(size_t)s * LDH + n] = h;
}
__device__ __forceinline__ void p1_sample_inproj(Ctx& F) {
    LAS float* red = (LAS float*)(F.lds + RING_OFF);
    int lane = F.lane; asm volatile("" : "+v"(lane));
    const int r = lane & 15, q = lane >> 4, kbeg = F.wave * 256;
    const bf16x8 z = {0, 0, 0, 0, 0, 0, 0, 0};
    for (int it0 = F.bid; it0 < LDH / 16; it0 += 3 * F.G) {
        const bf16* xp = WSB(WS_XNS) + (size_t)(r & 7) * DM + kbeg + 8 * q;
        bf16x8 a[8], b[3][8];
#pragma unroll
        for (int st = 0; st < 8; ++st) a[st] = *(const bf16x8*)(xp + 32 * st);
#pragma unroll
        for (int i = 0; i < 3; ++i) { const int it = min(it0 + i * F.G, LDH / 16 - 1); const bf16* wp = WSB(WS_WTIN) + (size_t)(16 * it + r) * DM + kbeg + 8 * q;
#pragma unroll
            for (int st = 0; st < 8; ++st) b[i][st] = *(const bf16x8*)(wp + 32 * st); }
        __builtin_amdgcn_sched_barrier(0);
#pragma unroll
        for (int i = 0; i < 3; ++i) { f32x4 acc = {0.f, 0.f, 0.f, 0.f};
#pragma unroll
            for (int st = 0; st < 8; ++st) acc = __builtin_amdgcn_mfma_f32_16x16x32_bf16(r >= 8 ? z : a[st], b[i][st], acc, 0, 0, 0);
            *(LAS f32x4*)(red + ((i * 8 + F.wave) * 64 + lane) * 4) = acc; }
        __syncthreads();
        if (F.wave < 3 && it0 + F.wave * F.G < LDH / 16) {
            f32x4 sacc = {0.f, 0.f, 0.f, 0.f};
#pragma unroll
            for (int w = 0; w < 8; ++w) sacc += *(LAS f32x4*)(red + ((F.wave * 8 + w) * 64 + lane) * 4);
            const int n0 = 16 * (it0 + F.wave * F.G);
            if (lane < 32) {
#pragma unroll
                for (int j = 0; j < 4; ++j) finish_sample_col(F, 4 * (lane >> 4) + j, n0 + (lane & 15), sacc[j]);
            }
        }
        __syncthreads();
    }
}

__device__ __forceinline__ int wave_excl_scan(int v, int lane) {
    int x = v;
    x += dppi<0x111>(x); x += dppi<0x112>(x); x += dppi<0x114>(x); x += dppi<0x118>(x);
    const int t0 = __builtin_amdgcn_readlane(x, 15), t1 = __builtin_amdgcn_readlane(x, 31), t2 = __builtin_amdgcn_readlane(x, 47);
    x += (lane >= 16 ? t0 : 0) + (lane >= 32 ? t1 : 0) + (lane >= 48 ? t2 : 0);
    return x - v;
}
__device__ __forceinline__ void hist_find(const LAS unsigned* hist, int lane, int need, int& bin, int& above, int& cnt) {
    const v4u h0 = *(const LAS v4u*)(hist + 504 - 8 * lane), h1 = *(const LAS v4u*)(hist + 508 - 8 * lane);
    const int a[8] = {(int)h1.w, (int)h1.z, (int)h1.y, (int)h1.x, (int)h0.w, (int)h0.z, (int)h0.y, (int)h0.x};
    const int tot = ((a[0] + a[1]) + (a[2] + a[3])) + ((a[4] + a[5]) + (a[6] + a[7]));
    const int ex = wave_excl_scan(tot, lane);
    const unsigned long long m = __ballot(ex + tot >= need);
    const int L = m ? (int)__builtin_ctzll(m) : 63;
    int acc = ex, fb = 0, fa = 0, fc = 0; bool done = false;
#pragma unroll
    for (int j = 0; j < 8; ++j) { const bool hit = !done && (acc + a[j] >= need); if (hit) { fb = 511 - 8 * lane - j; fa = acc; fc = a[j]; done = true; } acc += a[j]; }
    bin = __builtin_amdgcn_readlane(fb, L); above = __builtin_amdgcn_readlane(fa, L); cnt = __builtin_amdgcn_readlane(fc, L);
}
template <int NREG>
__device__ __forceinline__ void wave_select256(const float (&s)[NREG], int n_valid, int lane, LAS unsigned short* list, LAS unsigned* hist) {
    float mx = -INFINITY, mn = INFINITY;
#pragma unroll
    for (int i = 0; i < NREG; ++i) { mx = fmaxf(mx, s[i]); mn = fminf(mn, s[i] == -INFINITY ? INFINITY : s[i]); }
    mx = wave_max(mx); mn = wave_min(mn);
    const float scale = (mx > mn) ? 262143.0f / (mx - mn) : 0.f;
    int k[NREG];
#pragma unroll
    for (int i = 0; i < NREG; ++i) { const int q = (int)((s[i] - mn) * scale); k[i] = (s[i] == -INFINITY) ? -1 : (q < 0 ? 0 : (q > 262143 ? 262143 : q)); }
    *(LAS v4u*)(hist + 8 * lane) = (v4u){0u, 0u, 0u, 0u}; *(LAS v4u*)(hist + 8 * lane + 4) = (v4u){0u, 0u, 0u, 0u};
    LDS_WAIT();
#pragma unroll
    for (int i = 0; i < NREG; ++i) __hip_atomic_fetch_add(hist + (k[i] >= 0 ? (k[i] >> 9) : 512 + lane), 1u, __ATOMIC_RELAXED, __HIP_MEMORY_SCOPE_WAVEFRONT);
    LDS_WAIT();
    int b1, ab1, c1; hist_find(hist, lane, 256, b1, ab1, c1);
    LDS_WAIT();
    *(LAS v4u*)(hist + 8 * lane) = (v4u){0u, 0u, 0u, 0u}; *(LAS v4u*)(hist + 8 * lane + 4) = (v4u){0u, 0u, 0u, 0u};
    LDS_WAIT();
#pragma unroll
    for (int i = 0; i < NREG; ++i) __hip_atomic_fetch_add(hist + ((k[i] >> 9) == b1 ? (k[i] & 511) : 512 + lane), 1u, __ATOMIC_RELAXED, __HIP_MEMORY_SCOPE_WAVEFRONT);
    LDS_WAIT();
    int b2, ab2, c2; hist_find(hist, lane, 256 - ab1, b2, ab2, c2);
    const int T = (b1 << 9) | b2; const int need_eq = 256 - ab1 - ab2;
    int cg = 0, ce = 0;
#pragma unroll
    for (int i = 0; i < NREG; ++i) { cg += (k[i] > T) ? 1 : 0; ce += (k[i] == T) ? 1 : 0; }
    const int ex = wave_excl_scan(cg | (ce << 16), lane);
    int pg = ex & 0xffff, re = ex >> 16;
    const int ngt = 256 - need_eq;
    int T2 = T; asm volatile("" : "+s"(T2));
    int sl = lane;
#pragma unroll
    for (int i = 0; i < NREG; ++i) {
        const bool g_ = k[i] > T2, e_ = k[i] == T2;
        const int pos = g_ ? pg : ((e_ && re < need_eq) ? ngt + re : 256 + lane);
        list[pos] = (unsigned short)sl; pg += g_ ? 1 : 0; re += e_ ? 1 : 0;
        sl += 64; asm volatile("" : "+v"(sl));
    }
    LDS_WAIT();
}

struct RowSrc { const unsigned short* Hb; const float* ck; const float* cv; const int* pt; const float* knew; const float* vnew; };
template <bool SAMPLE>
__device__ __forceinline__ void attn_part(const RowSrc& R, int g, const LAS unsigned short* list, int k0, int nstep, int nsel, LAS unsigned char* vst, const bf16x8 (&qf)[4], float& m_out, float& l_out, f32x4 (&o)[8], int lane) {
    const int r16 = lane & 15, q4 = lane >> 4;
    float m = -1e30f, l = 0.f;
#pragma unroll
    for (int db = 0; db < 8; ++db) o[db] = (f32x4){0.f, 0.f, 0.f, 0.f};
    const LAS unsigned char* vb = vst + (4 * q4 + (r16 >> 2)) * 288 + (r16 & 3) * 8;
#pragma unroll 1
    for (int ks = 0; ks < nstep; ++ks) {
        const int sb = k0 + ks * 32;
        bf16x8 ka[2][4]; v4u vw[8];
#pragma unroll
        for (int grp = 0; grp < 2; ++grp) {
            const int slot = sb + grp * 16 + r16; const int key = list[slot < nsel ? slot : 0];
            if constexpr (!SAMPLE) {
                const unsigned short* kp = R.Hb + (size_t)key * LDH + HC_K + g * 128 + 8 * q4;
#pragma unroll
                for (int st = 0; st < 4; ++st) ka[grp][st] = *(const bf16x8*)(kp + 32 * st);
            } else {
                const float* kp = (key < PAST) ? R.ck + ((size_t)(R.pt[key >> 7] * PAGE + (key & 127)) * 2 + g) * 128 : R.knew + g * 128;
                kp += 8 * q4;
#pragma unroll
                for (int st = 0; st < 4; ++st) ka[grp][st] = cvt8(*(const f32x4*)(kp + 32 * st), *(const f32x4*)(kp + 32 * st + 4));
            }
        }
#pragma unroll
        for (int i = 0; i < 8; ++i) {
            const int slot = sb + 4 * i + q4; const int key = list[slot < nsel ? slot : 0];
            if constexpr (!SAMPLE) vw[i] = *(const v4u*)(R.Hb + (size_t)key * LDH + HC_V + g * 128 + r16 * 8);
            else { const float* vp = (key < PAST) ? R.cv + ((size_t)(R.pt[key >> 7] * PAGE + (key & 127)) * 2 + g) * 128 : R.vnew + g * 128;
                   vw[i] = __builtin_bit_cast(v4u, cvt8(*(const f32x4*)(vp + r16 * 8), *(const f32x4*)(vp + r16 * 8 + 4))); }
        }
        f32x4 c[2];
#pragma unroll
        for (int grp = 0; grp < 2; ++grp) {
            c[grp] = (f32x4){0.f, 0.f, 0.f, 0.f};
#pragma unroll
            for (int st = 0; st < 4; ++st) c[grp] = __builtin_amdgcn_mfma_f32_16x16x32_bf16(ka[grp][st], qf[st], c[grp], 0, 0, 0);
#pragma unroll
            for (int r = 0; r < 4; ++r) { const int sl = sb + grp * 16 + 4 * q4 + r; c[grp][r] = sl < nsel ? c[grp][r] : -1e30f; }
        }
        float ml = fmaxf(fmaxf(fmaxf(c[0][0], c[0][1]), fmaxf(c[0][2], c[0][3])), fmaxf(fmaxf(c[1][0], c[1][1]), fmaxf(c[1][2], c[1][3])));
        ml = xrows_max(ml);
        const float mn = fmaxf(m, ml), f = __builtin_amdgcn_exp2f(m - mn);
        m = mn; l *= f;
#pragma unroll
        for (int db = 0; db < 8; ++db) o[db] = o[db] * f;
#pragma unroll
        for (int grp = 0; grp < 2; ++grp)
#pragma unroll
            for (int r = 0; r < 4; ++r) { const float p = __builtin_amdgcn_exp2f(c[grp][r] - m); c[grp][r] = p; l += p; }
        v4u pw; pw.x = cvtpk(c[0][0], c[0][1]); pw.y = cvtpk(c[0][2], c[0][3]); pw.z = cvtpk(c[1][0], c[1][1]); pw.w = cvtpk(c[1][2], c[1][3]);
        const bf16x8 pf = __builtin_bit_cast(bf16x8, pw);
#pragma unroll
        for (int i = 0; i < 8; ++i) *(LAS v4u*)(vst + (4 * i + q4) * 288 + r16 * 16) = vw[i];
        LDS_WAIT();
#pragma unroll
        for (int db = 0; db < 8; ++db) {
            const s16x4 lo = __builtin_bit_cast(s16x4, __builtin_amdgcn_ds_read_tr16_b64_v4i16((LAS s16x4*)(vb + db * 32)));
            const s16x4 hi = __builtin_bit_cast(s16x4, __builtin_amdgcn_ds_read_tr16_b64_v4i16((LAS s16x4*)(vb + 16 * 288 + db * 32)));
            const bf16x8 vf = {lo[0], lo[1], lo[2], lo[3], hi[0], hi[1], hi[2], hi[3]};
            o[db] = __builtin_amdgcn_mfma_f32_16x16x32_bf16(vf, pf, o[db], 0, 0, 0);
        }
        LDS_WAIT();
    }
    l = xrows_add(l);
    m_out = m; l_out = l;
}

#if ATT_FP8
typedef v4u kfrag_t[2][2];
typedef v4u vfrag_t[4];
#define AT_NV 4
__device__ __forceinline__ void cvt16_fp8(const v4u w, bf16x8& lo, bf16x8& hi) {
    unsigned r[8];
#pragma unroll
    for (int j = 0; j < 4; ++j) { const f32x2 a = __builtin_amdgcn_cvt_pk_f32_fp8((int)w[j], false), b = __builtin_amdgcn_cvt_pk_f32_fp8((int)w[j], true); r[2 * j] = cvtpk(a.x, a.y); r[2 * j + 1] = cvtpk(b.x, b.y); }
    lo = __builtin_bit_cast(bf16x8, (v4u){r[0], r[1], r[2], r[3]}); hi = __builtin_bit_cast(bf16x8, (v4u){r[4], r[5], r[6], r[7]});
}
typedef long qfrag_t;
#else
typedef bf16x8 kfrag_t[2][4];
typedef v4u vfrag_t[8];
typedef bf16x8 qfrag_t;
#define AT_NV 8
#endif
__device__ __forceinline__ void at_qfrags(const unsigned short* qrow, int r16, int q4, qfrag_t (&qf)[4]) {
    v4u w[4];
#pragma unroll
    for (int st = 0; st < 4; ++st) w[st] = *(const v4u*)(qrow + (ATT_FP8 ? 64 * (st >> 1) + 16 * q4 + 8 * (st & 1) : 32 * st + 8 * q4));
    __builtin_amdgcn_sched_barrier(0);
#pragma unroll
    for (int st = 0; st < 4; ++st) {
#if ATT_FP8
        const float is = 1.0f / QSCALE; int lo = 0, hi = 0;
        lo = __builtin_amdgcn_cvt_pk_fp8_f32(bflo(w[st].x) * is, bfhi(w[st].x) * is, lo, false); lo = __builtin_amdgcn_cvt_pk_fp8_f32(bflo(w[st].y) * is, bfhi(w[st].y) * is, lo, true);
        hi = __builtin_amdgcn_cvt_pk_fp8_f32(bflo(w[st].z) * is, bfhi(w[st].z) * is, hi, false); hi = __builtin_amdgcn_cvt_pk_fp8_f32(bflo(w[st].w) * is, bfhi(w[st].w) * is, hi, true);
        const long v = (long)(((unsigned long long)(unsigned)hi << 32) | (unsigned long long)(unsigned)lo);
        qf[st] = r16 < 4 ? v : 0l;
#else
        const bf16x8 z = {0, 0, 0, 0, 0, 0, 0, 0};
        qf[st] = r16 < 4 ? __builtin_bit_cast(bf16x8, w[st]) : z;
#endif
    }
}
template <bool FULL>
__device__ __forceinline__ void at_load(const unsigned short* Hb, const unsigned char* KVb, const LAS unsigned short* list, int nsel, int step, int lane, kfrag_t& ka, vfrag_t& vw) {
    const int g = step >> 3, sb = (step & 7) * 32, r16 = lane & 15, q4 = lane >> 4;
#pragma unroll
    for (int grp = 0; grp < 2; ++grp) {
        const int slot = sb + grp * 16 + r16; const int key = list[(FULL || slot < nsel) ? slot : 0];
#if ATT_FP8
        const unsigned char* kp = KVb + (size_t)key * 512 + g * 128 + 16 * q4;
        ka[grp][0] = *(const v4u*)kp; ka[grp][1] = *(const v4u*)(kp + 64);
#else
        const unsigned short* kp = Hb + (size_t)key * LDH + HC_K + g * 128 + 8 * q4;
#pragma unroll
        for (int st = 0; st < 4; ++st) ka[grp][st] = *(const bf16x8*)(kp + 32 * st);
#endif
    }
#if ATT_FP8
#pragma unroll
    for (int i = 0; i < 4; ++i) { const int slot = sb + 8 * i + (lane >> 3); const int key = list[(FULL || slot < nsel) ? slot : 0];
        vw[i] = *(const v4u*)(KVb + (size_t)key * 512 + 256 + g * 128 + (lane & 7) * 16); }
#else
#pragma unroll
    for (int i = 0; i < 8; ++i) { const int slot = sb + 4 * i + q4; const int key = list[(FULL || slot < nsel) ? slot : 0];
        vw[i] = *(const v4u*)(Hb + (size_t)key * LDH + HC_V + g * 128 + r16 * 8); }
#endif
}
template <bool FULL>
__device__ __forceinline__ void at_comp(const kfrag_t& ka, const vfrag_t& vw, const qfrag_t (&qf)[4], int step, int nsel, int lane, LAS unsigned char* vst, const LAS unsigned char* vb, float& m, float& l, f32x4 (&o)[8]) {
    const int sb = (step & 7) * 32, r16 = lane & 15, q4 = lane >> 4;
    f32x4 c[2];
#pragma unroll
    for (int grp = 0; grp < 2; ++grp) {
        c[grp] = (f32x4){0.f, 0.f, 0.f, 0.f};
#if ATT_FP8
#pragma unroll
        for (int j = 0; j < 2; ++j) { const v4u w = ka[grp][j];
            const long a0 = (long)(((unsigned long long)w.y << 32) | w.x), a1 = (long)(((unsigned long long)w.w << 32) | w.z);
            c[grp] = __builtin_amdgcn_mfma_f32_16x16x32_fp8_fp8(a0, qf[2 * j], c[grp], 0, 0, 0); c[grp] = __builtin_amdgcn_mfma_f32_16x16x32_fp8_fp8(a1, qf[2 * j + 1], c[grp], 0, 0, 0); }
        c[grp] = c[grp] * QSCALE;
#else
#pragma unroll
        for (int st = 0; st < 4; ++st) c[grp] = __builtin_amdgcn_mfma_f32_16x16x32_bf16(ka[grp][st], qf[st], c[grp], 0, 0, 0);
#endif
        if (!FULL)
#pragma unroll
        for (int r = 0; r < 4; ++r) { const int sl = sb + grp * 16 + 4 * q4 + r; c[grp][r] = sl < nsel ? c[grp][r] : -1e30f; }
    }
    float ml = fmaxf(fmaxf(fmaxf(c[0][0], c[0][1]), fmaxf(c[0][2], c[0][3])), fmaxf(fmaxf(c[1][0], c[1][1]), fmaxf(c[1][2], c[1][3])));
    ml = xrows_max(ml);
    if (__ballot(ml > m)) {
        const float mn = fmaxf(m, ml), f = __builtin_amdgcn_exp2f(m - mn);
        m = mn; l *= f;
#pragma unroll
        for (int db = 0; db < 8; ++db) o[db] = o[db] * f;
    }
#pragma unroll
    for (int grp = 0; grp < 2; ++grp)
#pragma unroll
        for (int r = 0; r < 4; ++r) { const float p = __builtin_amdgcn_exp2f(c[grp][r] - m); c[grp][r] = p; l += p; }
    v4u pw; pw.x = cvtpk(c[0][0], c[0][1]); pw.y = cvtpk(c[0][2], c[0][3]); pw.z = cvtpk(c[1][0], c[1][1]); pw.w = cvtpk(c[1][2], c[1][3]);
    const bf16x8 pf = __builtin_bit_cast(bf16x8, pw);
#if ATT_FP8
#pragma unroll
    for (int i = 0; i < 4; ++i) { const int srow = 8 * i + (lane >> 3); const int lrow = 8 * ((srow >> 2) & 3) + 4 * (srow >> 4) + (srow & 3);
        *(LAS v4u*)(vst + lrow * 144 + (lane & 7) * 16) = vw[i]; }
#else
#pragma unroll
    for (int i = 0; i < 8; ++i) *(LAS v4u*)(vst + (4 * i + q4) * 288 + r16 * 16) = vw[i];
#endif
    LDS_WAIT();
#if ATT_FP8
    {
        int p0 = 0, p1 = 0;
        p0 = __builtin_amdgcn_cvt_pk_fp8_f32(c[0][0], c[0][1], p0, false); p0 = __builtin_amdgcn_cvt_pk_fp8_f32(c[0][2], c[0][3], p0, true);
        p1 = __builtin_amdgcn_cvt_pk_fp8_f32(c[1][0], c[1][1], p1, false); p1 = __builtin_amdgcn_cvt_pk_fp8_f32(c[1][2], c[1][3], p1, true);
        const long pf8 = (long)(((unsigned long long)(unsigned)p1 << 32) | (unsigned long long)(unsigned)p0);
        const LAS unsigned char* vb8 = vst + (8 * q4 + (r16 >> 1)) * 144 + (r16 & 1) * 8;
#pragma unroll
        for (int db = 0; db < 8; ++db) {
            const v2i_t t = __builtin_amdgcn_ds_read_tr8_b64_v2i32((LAS v2i_t*)(vb8 + db * 16));
            const long vf8 = (long)(((unsigned long long)(unsigned)t[1] << 32) | (unsigned long long)(unsigned)t[0]);
            o[db] = __builtin_amdgcn_mfma_f32_16x16x32_fp8_fp8(vf8, pf8, o[db], 0, 0, 0);
        }
    }
#else
#pragma unroll
    for (int db = 0; db < 8; ++db) {
        const s16x4 lo = __builtin_bit_cast(s16x4, __builtin_amdgcn_ds_read_tr16_b64_v4i16((LAS s16x4*)(vb + db * 32)));
        const s16x4 hi = __builtin_bit_cast(s16x4, __builtin_amdgcn_ds_read_tr16_b64_v4i16((LAS s16x4*)(vb + 16 * 288 + db * 32)));
        const bf16x8 vf = {lo[0], lo[1], lo[2], lo[3], hi[0], hi[1], hi[2], hi[3]};
        o[db] = __builtin_amdgcn_mfma_f32_16x16x32_bf16(vf, pf, o[db], 0, 0, 0);
    }
#endif
    LDS_WAIT();
}
template <bool FULL>
__device__ __forceinline__ void attn_prompt_query(const unsigned short* Hb, const unsigned char* KVb, int t, bf16* orow, const LAS unsigned short* list, int nsel, LAS unsigned char* vst, int lane) {
    const int r16 = lane & 15, q4 = lane >> 4;
    const LAS unsigned char* vb = vst + (4 * q4 + (r16 >> 2)) * 288 + (r16 & 3) * 8;
    kfrag_t kaA, kaB; vfrag_t vwA, vwB; qfrag_t qf[4];
    float m = -1e30f, l = 0.f; f32x4 o[8];
#pragma unroll
    for (int db = 0; db < 8; ++db) o[db] = (f32x4){0.f, 0.f, 0.f, 0.f};
    { const unsigned short* qp = Hb + (size_t)t * LDH + HC_Q + (r16 & 3) * 128;
      at_qfrags(qp, r16, q4, qf); }
    kfrag_t kaC; vfrag_t vwC;
#define AT_FINAL(g) do { v2u zz_[8]; const unsigned short* zp_ = Hb + (size_t)t * LDH + HC_ZA + ((g) * 4 + (r16 & 3)) * 128 + 4 * q4; \
        _Pragma("unroll") for (int db = 0; db < 8; ++db) zz_[db] = *(const v2u*)(zp_ + db * 16);     \
        l = xrows_add(l); \
        __builtin_amdgcn_sched_barrier(0); \
        if (r16 < 4) { const float rl = 1.0f / l; bf16* op = orow + ((g) * 4 + r16) * 128 + 4 * q4; \
            _Pragma("unroll") for (int db = 0; db < 8; ++db) { const v2u zz = zz_[db]; \
                v2u ww; ww.x = cvtpk(o[db][0] * rl * bflo(zz.x), o[db][1] * rl * bfhi(zz.x)); ww.y = cvtpk(o[db][2] * rl * bflo(zz.y), o[db][3] * rl * bfhi(zz.y)); \
                *(v2u*)(op + db * 16) = ww; } } } while (0)
    at_load<FULL>(Hb, KVb, list, nsel, 0, lane, kaA, vwA); at_load<FULL>(Hb, KVb, list, nsel, 1, lane, kaB, vwB);
#pragma unroll 1
    for (int it = 0; it < 5; ++it) {
        at_load<FULL>(Hb, KVb, list, nsel, 3 * it + 2, lane, kaC, vwC);
        at_comp<FULL>(kaA, vwA, qf, 3 * it, nsel, lane, vst, vb, m, l, o);
        at_load<FULL>(Hb, KVb, list, nsel, 3 * it + 3, lane, kaA, vwA);
        at_comp<FULL>(kaB, vwB, qf, 3 * it + 1, nsel, lane, vst, vb, m, l, o);
        if (it == 2) {
            AT_FINAL(0);
            m = -1e30f; l = 0.f;
#pragma unroll
            for (int db = 0; db < 8; ++db) o[db] = (f32x4){0.f, 0.f, 0.f, 0.f};
            const unsigned short* qp = Hb + (size_t)t * LDH + HC_Q + (4 + (r16 & 3)) * 128;
            at_qfrags(qp, r16, q4, qf);
        }
        if (it < 4) at_load<FULL>(Hb, KVb, list, nsel, 3 * it + 4, lane, kaB, vwB);
        at_comp<FULL>(kaC, vwC, qf, 3 * it + 2, nsel, lane, vst, vb, m, l, o);
    }
    at_comp<FULL>(kaA, vwA, qf, 15, nsel, lane, vst, vb, m, l, o);
    AT_FINAL(1);
#undef AT_FINAL
}

__device__ __forceinline__ float relu_i(float x) { const int v = __float_as_int(x); return __int_as_float(v > 0 ? v : 0); }
__device__ __forceinline__ void p2_prompt_item(Ctx& F, int j, int b) {
    const int qb = 255 - j, q0 = qb * 16, rowbase = b * SEQ;
    const int nkeys = q0 + 16, ntile = (nkeys + 63) >> 6;
    int lane = F.lane, w = F.wave, tid = F.tid;
    asm volatile("" : "+v"(lane), "+v"(tid)); asm volatile("" : "+s"(w));
    LAS unsigned char* kbuf = F.lds + RING_OFF;
    LAS unsigned short* list = (LAS unsigned short*)(F.lds + RING_OFF + 32768 + w * 10240);
    LAS unsigned char* vst = F.lds + RING_OFF + 32768 + w * 10240 + 1024;
    float* SCb = WSF(WS_SC) + (size_t)F.bid * (16 * 4096);
    const bf16* Hb = WSB(WS_H) + (size_t)rowbase * LDH;
#ifndef REP_P2
#define REP_P2 0
#endif
    unsigned long long ts_ = PRB_T();
    for (int rp_ = 0; rp_ < 1 + (REP_P2 & 1); ++rp_) {
        const int r = lane & 31, hi = lane >> 5;
#if !IDX_FP8
        const int qg = w & 3, kh = w >> 2;
        float wv[2][16];
#pragma unroll
        for (int s2 = 0; s2 < 2; ++s2) { const f32x4* wp = (const f32x4*)(WSF(WS_WI) + (size_t)(rowbase + q0 + 4 * qg + 2 * s2 + hi) * 16);
#pragma unroll
          for (int j = 0; j < 4; ++j) { const f32x4 t = wp[j]; wv[s2][4 * j] = t[0]; wv[s2][4 * j + 1] = t[1]; wv[s2][4 * j + 2] = t[2]; wv[s2][4 * j + 3] = t[3]; } }
        const int headr = (r & 3) + 4 * (r >> 3);
#else
        float wv[16];
        const int tqr = q0 + 2 * w + ((r >> 2) & 1), headr = (r & 3) + 4 * (r >> 3);
        { const f32x4* wp = (const f32x4*)(WSF(WS_WI) + (size_t)(rowbase + q0 + 2 * w + hi) * 16);
#pragma unroll
          for (int j = 0; j < 4; ++j) { const f32x4 t = wp[j]; wv[4 * j] = t[0]; wv[4 * j + 1] = t[1]; wv[4 * j + 2] = t[2]; wv[4 * j + 3] = t[3]; } }
        const int tql = q0 + 2 * w + hi;
#endif
#if IDX_FP8
        typedef int v8i_t __attribute__((ext_vector_type(8)));
        v8i_t qa[2];
        { const bf16* qsrc = Hb + (size_t)tqr * LDH + HC_QI + headr * 128 + 32 * hi;
#pragma unroll
          for (int sI = 0; sI < 2; ++sI)
#pragma unroll
            for (int c4 = 0; c4 < 4; ++c4) { const v4u wq = *(const v4u*)(qsrc + 64 * sI + 8 * c4);
                int lo = __builtin_amdgcn_cvt_pk_fp8_f32(bflo(wq.x), bfhi(wq.x), 0, false); lo = __builtin_amdgcn_cvt_pk_fp8_f32(bflo(wq.y), bfhi(wq.y), lo, true);
                int hh = __builtin_amdgcn_cvt_pk_fp8_f32(bflo(wq.z), bfhi(wq.z), 0, false); hh = __builtin_amdgcn_cvt_pk_fp8_f32(bflo(wq.w), bfhi(wq.w), hh, true);
                qa[sI][2 * c4] = lo; qa[sI][2 * c4 + 1] = hh; } }
        const unsigned char* K8 = F.ws + WS_KI8 + (size_t)rowbase * 128;
        const int skey = tid >> 3, sch = tid & 7;
        v4u pre = *(const v4u*)(K8 + (size_t)skey * 128 + sch * 16);
        *(LAS v4u*)(kbuf + skey * 128 + ((sch ^ ((skey >> 1) & 7)) * 16)) = pre;
        __syncthreads();
        for (int kt = 0; kt < ntile; ++kt) {
            const bool more = kt + 1 < ntile;
            if (more) pre = *(const v4u*)(K8 + (size_t)(64 * (kt + 1) + skey) * 128 + sch * 16);
            const LAS unsigned char* buf = kbuf + (kt & 1) * 8192;
#pragma unroll
            for (int sub = 0; sub < 2; ++sub) {
                f32x16 c = {};
                const int krow = sub * 32 + r; const LAS unsigned char* kr = buf + krow * 128; const int sw = (krow >> 1) & 7;
#pragma unroll
                for (int sI = 0; sI < 2; ++sI) {
                    const v4u b0 = *(const LAS v4u*)(kr + (((4 * sI + 2 * hi) ^ sw) * 16)), b1 = *(const LAS v4u*)(kr + (((4 * sI + 2 * hi + 1) ^ sw) * 16));
                    const v8i_t kb = {(int)b0.x, (int)b0.y, (int)b0.z, (int)b0.w, (int)b1.x, (int)b1.y, (int)b1.z, (int)b1.w};
                    c = __builtin_amdgcn_mfma_scale_f32_32x32x64_f8f6f4(qa[sI], kb, c, 0, 0, 0, 0x7f7f7f7f, 0, 0x7f7f7f7f);
                }
                float sc = 0.f;
#pragma unroll
                for (int j = 0; j < 16; ++j) sc += wv[j] * fmaxf(c[j], 0.f);
                const int key = 64 * kt + 32 * sub + r;
                __builtin_nontemporal_store(key <= tql ? sc : -INFINITY, &SCb[(2 * w + hi) * 4096 + key]);
            }
            if (more) *(LAS v4u*)(kbuf + ((kt + 1) & 1) * 8192 + skey * 128 + ((sch ^ ((skey >> 1) & 7)) * 16)) = pre;
            __syncthreads();
        }
#else
        bf16x8 qf[2][8];
#pragma unroll
        for (int s2 = 0; s2 < 2; ++s2) { const bf16* qsrc = Hb + (size_t)(q0 + 4 * qg + 2 * s2 + ((r >> 2) & 1)) * LDH + HC_QI + headr * 128 + 8 * hi;
#pragma unroll
          for (int st = 0; st < 8; ++st) qf[s2][st] = *(const bf16x8*)(qsrc + 16 * st); }
        const int ntile2 = (nkeys + 127) >> 7;
        v4u pre[4];
        const int sc_ = tid & 15;
        const bf16* kp[4];
#pragma unroll
        for (int i = 0; i < 4; ++i) kp[i] = Hb + (size_t)((tid + 512 * i) >> 4) * LDH + HC_KI + sc_ * 8;
        unsigned lo_[4];
#pragma unroll
        for (int i = 0; i < 4; ++i) { const int sk = (tid + 512 * i) >> 4; lo_[i] = sk * 256 + ((sc_ ^ (sk & 15)) * 16); }
#pragma unroll
        for (int i = 0; i < 4; ++i) pre[i] = *(const v4u*)(kp[i]);
#pragma unroll
        for (int i = 0; i < 4; ++i) *(LAS v4u*)(kbuf + lo_[i]) = pre[i];
        __syncthreads();
        f32x16 cp = {};
        float* const row0 = SCb + (4 * qg + hi) * 4096 + 64 * kh + r; float* const row1 = row0 + 2 * 4096;
        const int kq0 = q0 + 4 * qg + hi - 64 * kh - r, kq1 = kq0 + 2;
        for (int kt = 0; kt < ntile2; ++kt) {
            const int ktn = min(kt + 1, ntile2 - 1), ktp = max(kt - 1, 0);
#pragma unroll
            for (int i = 0; i < 4; ++i) pre[i] = *(const v4u*)(kp[i] + (size_t)ktn * (128 * LDH));
            const LAS unsigned char* buf = kbuf + (kt & 1) * 32768 + (kh * 64 + r) * 256;
            bf16x8 fr[8];
#pragma unroll
            for (int st = 0; st < 8; ++st) fr[st] = *(const LAS bf16x8*)(buf + (((2 * st + hi) ^ (r & 15)) * 16));
            { float s1 = 0.f;
#pragma unroll
              for (int j = 0; j < 16; ++j) s1 += wv[1][j] * relu_i(cp[j]);
              __builtin_nontemporal_store(128 * ktp + 32 <= kq1 ? s1 : -INFINITY, row1 + 128 * ktp + 32); }
            __builtin_amdgcn_sched_barrier(0);
            f32x16 c0 = {}, c1 = {};
#pragma unroll
            for (int st = 0; st < 8; ++st) c0 = __builtin_amdgcn_mfma_f32_32x32x16_bf16(qf[0][st], fr[st], c0, 0, 0, 0);
            __builtin_amdgcn_sched_barrier(0);
#pragma unroll
            for (int st = 0; st < 8; ++st) c1 = __builtin_amdgcn_mfma_f32_32x32x16_bf16(qf[1][st], fr[st], c1, 0, 0, 0);
            { float s0 = 0.f;
#pragma unroll
              for (int j = 0; j < 16; ++j) s0 += wv[0][j] * relu_i(c0[j]);
#pragma unroll
              for (int g = 0; g < 8; ++g) { __builtin_amdgcn_sched_group_barrier(0x008, 1, 0); __builtin_amdgcn_sched_group_barrier(0x002, 4, 0); }
              __builtin_nontemporal_store(128 * kt <= kq0 ? s0 : -INFINITY, row0 + 128 * kt); }
            __builtin_amdgcn_sched_barrier(0);
#pragma unroll
            for (int st = 0; st < 8; ++st) fr[st] = *(const LAS bf16x8*)(buf + 32 * 256 + (((2 * st + hi) ^ (r & 15)) * 16));
            { float s1 = 0.f;
#pragma unroll
              for (int j = 0; j < 16; ++j) s1 += wv[1][j] * relu_i(c1[j]);
              __builtin_nontemporal_store(128 * kt <= kq1 ? s1 : -INFINITY, row1 + 128 * kt); }
            __builtin_amdgcn_sched_barrier(0);
#pragma unroll
            for (int j = 0; j < 16; ++j) { c0[j] = 0.f; c1[j] = 0.f; }
#pragma unroll
            for (int st = 0; st < 8; ++st) c0 = __builtin_amdgcn_mfma_f32_32x32x16_bf16(qf[0][st], fr[st], c0, 0, 0, 0);
            __builtin_amdgcn_sched_barrier(0);
#pragma unroll
            for (int st = 0; st < 8; ++st) c1 = __builtin_amdgcn_mfma_f32_32x32x16_bf16(qf[1][st], fr[st], c1, 0, 0, 0);
            { float s0 = 0.f;
#pragma unroll
              for (int j = 0; j < 16; ++j) s0 += wv[0][j] * relu_i(c0[j]);
#pragma unroll
              for (int g = 0; g < 8; ++g) { __builtin_amdgcn_sched_group_barrier(0x008, 1, 0); __builtin_amdgcn_sched_group_barrier(0x002, 4, 0); }
              __builtin_nontemporal_store(128 * kt + 32 <= kq0 ? s0 : -INFINITY, row0 + 128 * kt + 32); }
            cp = c1;
            __builtin_amdgcn_sched_barrier(0);
            { LAS unsigned char* nb = kbuf + ((kt + 1) & 1) * 32768;
#pragma unroll
              for (int i = 0; i < 4; ++i) *(LAS v4u*)(nb + lo_[i]) = pre[i]; }
            __syncthreads();
        }
        { float s1 = 0.f;
#pragma unroll
          for (int j = 0; j < 16; ++j) s1 += wv[1][j] * relu_i(cp[j]);
          __builtin_nontemporal_store(128 * (ntile2 - 1) + 32 <= kq1 ? s1 : -INFINITY, row1 + 128 * (ntile2 - 1) + 32); }
#endif
    }
    __syncthreads();
    PRB_ADD(9, ts_);
    static_assert(ATT_FP8 == 1, "the second selection list sits behind the fp8 V staging tile");
    LAS unsigned short* listB = (LAS unsigned short*)(F.lds + RING_OFF + 32768 + w * 10240 + 5632);
    int nsA = 0, nsB = 0;
#pragma unroll 1
    for (int stp = 0; stp < 4; ++stp) {
        ts_ = PRB_T();
        const int isatt = (w & 1) ? (stp >> 1) : (stp & 1), qq = (w & 1) ? (stp & 1) : (stp >> 1);
        LAS unsigned short* lst = qq ? listB : list;
        const int ql = 2 * w + qq, t = q0 + ql, n = t + 1;
        if (!isatt) {
            int nsel;
            if (n <= 256) {
#pragma unroll
                for (int j = 0; j < 4; ++j) lst[lane + 64 * j] = (unsigned short)(lane + 64 * j);
                LDS_WAIT(); nsel = n;
            } else {
#define SEL_W(NR) do { float s[NR]; int ln = lane; asm volatile("" : "+v"(ln));     \
                _Pragma("unroll") for (int i = 0; i < NR; ++i) { const float v = __builtin_nontemporal_load(&SCb[ql * 4096 + i * 64 + lane]); s[i] = (ln <= t - i * 64) ? v : -INFINITY; } \
                asm volatile("s_waitcnt vmcnt(0)" ::: "memory"); \
                if (PROBE_ID >= 0) { PRB_ADD(14, ts_); ts_ = PRB_T(); } \
                wave_select256<NR>(s, n, lane, lst, (LAS unsigned*)vst); } while (0)
                if (n <= 1024) SEL_W(16); else if (n <= 2048) SEL_W(32); else if (n <= 3072) SEL_W(48); else SEL_W(64);
#undef SEL_W
                nsel = 256;
            }
            if (qq) nsB = nsel; else nsA = nsel;
            PRB_ADD(10, ts_);
        } else {
            const int nsel = qq ? nsB : nsA;
            asm volatile("" : "+v"(lane) :: "memory"); __builtin_amdgcn_sched_barrier(0);
            if (nsel == 256) attn_prompt_query<true>(Hb, F.ws + WS_KV8 + (size_t)rowbase * 512, t, WSB(WS_OAB) + (size_t)(rowbase + t) * DM, lst, nsel, vst, lane);
            else attn_prompt_query<false>(Hb, F.ws + WS_KV8 + (size_t)rowbase * 512, t, WSB(WS_OAB) + (size_t)(rowbase + t) * DM, lst, nsel, vst, lane);
            PRB_ADD(11, ts_);
        }
    }
}
__device__ __forceinline__ void p2_gmlp_item(Ctx& F, const In& I, int item) {
    int lane = F.lane, w = F.wave, tid = F.tid; const int c = item >> 3, g = item & 7, r0 = c * 128;
    asm volatile("" : "+v"(lane), "+v"(tid)); asm volatile("" : "+s"(w));
    LAS unsigned char* tile = F.lds + RING_OFF;
    LAS float* smu = (LAS float*)(F.lds + RING_OFF + 36864); LAS float* srs = smu + 128;
    v4u pre[4];
#pragma unroll
    for (int i = 0; i < 4; ++i) { const int p = tid + 512 * i, row = p >> 4, ch = p & 15; pre[i] = *(const v4u*)(WSB(WS_H) + (size_t)(r0 + row) * LDH + HC_VB + g * 128 + ch * 8); }
    if (tid < 128) { const f32x4* ps = (const f32x4*)(WSF(WS_PSV) + (size_t)(r0 + tid) * 32); float s1 = 0.f, s2 = 0.f;
#pragma unroll
        for (int j = 0; j < 8; ++j) { const f32x4 v = ps[j]; s1 += v[0] + v[2]; s2 += v[1] + v[3]; }
        const float mu = s1 * (1.f / 1024.f), var = fmaxf(s2 * (1.f / 1024.f) - mu * mu, 0.f);
        smu[tid] = mu; srs[tid] = 1.0f / sqrtf(var + LN_EPS); }
#pragma unroll
    for (int i = 0; i < 4; ++i) { const int p = tid + 512 * i, row = p >> 4, ch = p & 15; *(LAS v4u*)(tile + row * 288 + ch * 16) = pre[i]; }
    __syncthreads();
    const int i16 = lane & 15, q4 = lane >> 4, t = 16 * w + i16, nks = (w >> 1) + 1;
    const bf16* hrow = WSB(WS_H) + (size_t)(r0 + t) * LDH;
    f32x4 lgv[8], lbv[8]; v2u uuv[8], zzv[8];
#pragma unroll
    for (int db = 0; db < 8; ++db) { const int ch0 = g * 128 + db * 16 + 4 * q4;
        lgv[db] = *(const f32x4*)(I.lng + ch0); lbv[db] = *(const f32x4*)(I.lnb + ch0); uuv[db] = *(const v2u*)(hrow + HC_U + ch0); zzv[db] = *(const v2u*)(hrow + HC_ZB + ch0); }
    const float bt = I.bsp[g * 128 + t];
    f32x4 w0v[4], w1v[4];
#pragma unroll
    for (int ks = 0; ks < 4; ++ks) { const float* wrow = I.wsp + ((size_t)(g * 128 + t) * 128 + 32 * ks + 8 * q4); w0v[ks] = *(const f32x4*)wrow; w1v[ks] = *(const f32x4*)(wrow + 4); }
    __builtin_amdgcn_sched_barrier(0);
    f32x4 acc[8];
#pragma unroll
    for (int db = 0; db < 8; ++db) acc[db] = (f32x4){0.f, 0.f, 0.f, 0.f};
    float c1 = 0.f, c2 = 0.f;
#pragma unroll
    for (int ks = 0; ks < 4; ++ks) if (ks < nks) {
        const int s0 = 32 * ks + 8 * q4;
        const f32x4 w0 = w0v[ks], w1 = w1v[ks];
        float wv[8] = {w0[0], w0[1], w0[2], w0[3], w1[0], w1[1], w1[2], w1[3]};
#pragma unroll
        for (int j = 0; j < 8; ++j) { const int s = s0 + j; const float x = (s <= t) ? wv[j] : 0.f; c2 += x; const float xp = x * srs[s]; c1 += xp * smu[s]; wv[j] = xp; }
        const bf16x8 wf = cvt8((f32x4){wv[0], wv[1], wv[2], wv[3]}, (f32x4){wv[4], wv[5], wv[6], wv[7]});
        const LAS unsigned char* vb = tile + (32 * ks + 8 * q4 + (i16 >> 2)) * 288 + (i16 & 3) * 8;
#pragma unroll
        for (int db = 0; db < 8; ++db) {
            const s16x4 lo = __builtin_bit_cast(s16x4, __builtin_amdgcn_ds_read_tr16_b64_v4i16((LAS s16x4*)(vb + db * 32)));
            const s16x4 hi = __builtin_bit_cast(s16x4, __builtin_amdgcn_ds_read_tr16_b64_v4i16((LAS s16x4*)(vb + 4 * 288 + db * 32)));
            const bf16x8 vf = {lo[0], lo[1], lo[2], lo[3], hi[0], hi[1], hi[2], hi[3]};
            acc[db] = __builtin_amdgcn_mfma_f32_16x16x32_bf16(vf, wf, acc[db], 0, 0, 0);
        }
    }
    c1 = xrows_add(c1); c2 = xrows_add(c2);
    bf16* orow = WSB(WS_OAB) + (size_t)(r0 + t) * DM + 1024;
#pragma unroll
    for (int db = 0; db < 8; ++db) { const int ch0 = g * 128 + db * 16 + 4 * q4;
        const f32x4 lg = lgv[db], lb = lbv[db];
        const v2u uu = uuv[db], zz = zzv[db];
        float mx[4];
#pragma unroll
        for (int r = 0; r < 4; ++r) mx[r] = lg[r] * (acc[db][r] - c1) + lb[r] * c2 + bt;
        v2u ww; ww.x = cvtpk(bflo(uu.x) * mx[0] * bflo(zz.x), bfhi(uu.x) * mx[1] * bfhi(zz.x)); ww.y = cvtpk(bflo(uu.y) * mx[2] * bflo(zz.y), bfhi(uu.y) * mx[3] * bfhi(zz.y));
        *(v2u*)(orow + ch0) = ww; }
}
__device__ __forceinline__ void p2_sscore_item(Ctx& F, const In& I, int item) {
    int lane = F.lane, w = F.wave; asm volatile("" : "+v"(lane)); asm volatile("" : "+s"(w));
    const int s = item >> 4, page = (item & 15) * 8 + w, r16 = lane & 15, q4 = lane >> 4;
    const float* hs = WSF(WS_HS) + (size_t)s * LDH;
    bf16x8 qf[4];
#pragma unroll
    for (int st = 0; st < 4; ++st) { const float* p = hs + HC_QI + r16 * 128 + st * 32 + 8 * q4; qf[st] = cvt8(*(const f32x4*)p, *(const f32x4*)(p + 4)); }
    const f32x4 wv = *(const f32x4*)(hs + HC_WI + 4 * q4);
    const int phys = I.pt[s * NPAGES + page];
    const float* kb = I.cki + (size_t)phys * PAGE * 128;
#pragma unroll 1
    for (int g2 = 0; g2 < 8; g2 += 4) {
        f32x4 x[4][4][2];
#pragma unroll
        for (int u = 0; u < 4; ++u) { const float* kp = kb + (size_t)((g2 + u) * 16 + r16) * 128 + 8 * q4;
#pragma unroll
            for (int st = 0; st < 4; ++st) { x[u][st][0] = __builtin_nontemporal_load((const f32x4*)(kp + 32 * st)); x[u][st][1] = __builtin_nontemporal_load((const f32x4*)(kp + 32 * st + 4)); } }
        __builtin_amdgcn_sched_barrier(0);
#pragma unroll
        for (int u = 0; u < 4; ++u) {
            f32x4 c = {0.f, 0.f, 0.f, 0.f};
#pragma unroll
            for (int st = 0; st < 4; ++st) c = __builtin_amdgcn_mfma_f32_16x16x32_bf16(qf[st], cvt8(x[u][st][0], x[u][st][1]), c, 0, 0, 0);
            float v = wv[0] * fmaxf(c[0], 0.f) + wv[1] * fmaxf(c[1], 0.f) + wv[2] * fmaxf(c[2], 0.f) + wv[3] * fmaxf(c[3], 0.f);
            v = xrows_add(v);
            if (lane < 16) __hip_atomic_store(WSF(WS_SSC) + (size_t)s * SSC_LD + page * 128 + (g2 + u) * 16 + lane, v, __ATOMIC_RELAXED, __HIP_MEMORY_SCOPE_AGENT);
        }
    }
}

__device__ __forceinline__ void p3_sample_item(Ctx& F, const In& I, int s) {
    int lane = F.lane, w = F.wave, tid = F.tid; asm volatile("" : "+v"(lane), "+v"(tid)); asm volatile("" : "+s"(w));
    const int r16 = lane & 15, q4 = lane >> 4;
    LAS unsigned short* cand = (LAS unsigned short*)(F.lds + RING_OFF);
    LAS unsigned short* fin = (LAS unsigned short*)(F.lds + RING_OFF + 5120);
    LAS unsigned short* tmp = (LAS unsigned short*)(F.lds + RING_OFF + 5760);
    LAS float* snew = (LAS float*)(F.lds + RING_OFF + 6400);
    LAS float* comb = (LAS float*)(F.lds + RING_OFF + 8192);
    LAS unsigned char* vst = F.lds + RING_OFF + 32768 + w * 9216;
    const float* hs = WSF(WS_HS) + (size_t)s * LDH;
    float* ssc = WSF(WS_SSC) + (size_t)s * SSC_LD;
    if (w == 0) {
        const int h = lane >> 2, part = lane & 3; float d = 0.f;
        const float* qp = hs + HC_QI + h * 128 + part * 32; const float* kp = hs + HC_KI + part * 32;
#pragma unroll
        for (int j = 0; j < 32; ++j) d += bf2f((unsigned short)f2bf(qp[j])) * bf2f((unsigned short)f2bf(kp[j]));
        d += dppf<0xB1>(d); d += dppf<0x4E>(d);
        float cn = (part == 0) ? hs[HC_WI + h] * fmaxf(d, 0.f) : 0.f;
        cn = wave_sum(cn);
        if (lane == 0) { snew[0] = cn; ssc[PAST] = cn; }
    }
    {
        float sv[32];
#pragma unroll
        for (int i = 0; i < 32; ++i) sv[i] = ssc[w * 2048 + i * 64 + lane];
        wave_select256<32>(sv, 2048, lane, cand + w * 320, (LAS unsigned*)vst);
    }
    __syncthreads();
    if (w == 0) {
        float sv[33];
#pragma unroll
        for (int i = 0; i < 32; ++i) { const int cidx = i * 64 + lane; const int key = (cidx >> 8) * 2048 + cand[(cidx >> 8) * 320 + (cidx & 255)]; sv[i] = ssc[key]; }
        sv[32] = lane == 0 ? snew[0] : -INFINITY;
        wave_select256<33>(sv, 2049, lane, tmp, (LAS unsigned*)vst);
#pragma unroll
        for (int j = 0; j < 4; ++j) { const int slot = tmp[lane + 64 * j]; fin[lane + 64 * j] = (unsigned short)(slot >= 2048 ? PAST : (slot >> 8) * 2048 + cand[(slot >> 8) * 320 + (slot & 255)]); }
        LDS_WAIT();
    }
    __syncthreads();
    {
        const int g = w & 1, part = w >> 1;
        RowSrc R; R.Hb = nullptr; R.ck = I.ck; R.cv = I.cv; R.pt = I.pt + s * NPAGES; R.knew = F.out + O_KS + s * 256; R.vnew = F.out + O_VS + s * 256;
        bf16x8 qf[4]; const bf16x8 z = {0, 0, 0, 0, 0, 0, 0, 0};
        const float* qp = hs + HC_Q + (g * 4 + (r16 & 3)) * 128 + 8 * q4;
#pragma unroll
        for (int st = 0; st < 4; ++st) { qf[st] = cvt8(*(const f32x4*)(qp + 32 * st), *(const f32x4*)(qp + 32 * st + 4)); if (r16 >= 4) qf[st] = z; }
        float m, l; f32x4 o[8];
        attn_part<true>(R, g, fin, part * 64, 2, 256, vst, qf, m, l, o, lane);
        LAS float* cw = comb + w * 520;
        if (r16 < 4) {
            if (q4 == 0) { cw[r16] = m; cw[4 + r16] = l; }
#pragma unroll
            for (int db = 0; db < 8; ++db)
#pragma unroll
                for (int r = 0; r < 4; ++r) cw[8 + (db * 16 + 4 * q4 + r) * 4 + r16] = o[db][r];
        }
    }
    __syncthreads();
    for (int e = tid; e < 1024; e += 512) {
        const int hh = e >> 7, d = e & 127, g = hh >> 2, h = hh & 3;
        float M = -1e30f;
#pragma unroll
        for (int p = 0; p < 4; ++p) M = fmaxf(M, comb[(g + 2 * p) * 520 + h]);
        float num = 0.f, den = 0.f;
#pragma unroll
        for (int p = 0; p < 4; ++p) { const LAS float* cw = comb + (g + 2 * p) * 520; const float f = __builtin_amdgcn_exp2f(cw[h] - M); num += cw[8 + d * 4 + h] * f; den += cw[4 + h] * f; }
        const float v = num / den * hs[HC_ZA + hh * 128 + d];
        WSB(WS_OABS)[(size_t)s * DM + hh * 128 + d] = (bf16)f2bf(v);
    }
    if (w == 1) {
        float x[16]; float sum = 0.f;
#pragma unroll
        for (int j = 0; j < 16; ++j) { x[j] = hs[HC_VB + lane + 64 * j]; sum += x[j]; }
        const float mu = wave_sum(sum) * (1.f / 1024.f); float qv = 0.f;
#pragma unroll
        for (int j = 0; j < 16; ++j) { const float d = x[j] - mu; qv += d * d; }
        const float rs = 1.0f / sqrtf(wave_sum(qv) * (1.f / 1024.f) + LN_EPS);
#pragma unroll
        for (int j = 0; j < 16; ++j) { const int ch = lane + 64 * j, g = ch >> 7;
            const float vn = (x[j] - mu) * rs * I.lng[ch] + I.lnb[ch];
            F.out[O_GV + s * 1024 + ch] = vn;
            const float ob = hs[HC_U + ch] * (I.wsp[(size_t)g * 128 * 128] * vn + I.bsp[g * 128]) * hs[HC_ZB + ch];
            WSB(WS_OABS)[(size_t)s * DM + 1024 + ch] = (bf16)f2bf(ob); }
    }
    __syncthreads();
}

__global__ void __launch_bounds__(512, 2) mk_fwd(Args args) {
    extern __shared__ __attribute__((aligned(16))) unsigned char lds_raw[];
    Ctx F;
    F.lds = (LAS unsigned char*)lds_raw;
    F.tid = threadIdx.x; F.lane = F.tid & 63; F.wave = __builtin_amdgcn_readfirstlane(F.tid >> 6); F.G = gridDim.x; F.bid = blockIdx.x;
    F.out = args.out; F.ws = args.ws;
    volatile LAS unsigned* MISC = (volatile LAS unsigned*)(F.lds + MISC_OFF);
    for (int u = F.tid; u < (LDS_BYTES - LDSCTL_OFF) / 4; u += 512) ((LAS unsigned*)(F.lds + LDSCTL_OFF))[u] = 0u;
    __syncthreads();
    XcdBarrier bar; bar.bar = (unsigned*)(((gu32*)(F.ws + WS_CTL)) + CW_BAR); bar.x = 0; bar.st = nullptr;
    if (MK_N_LAUNCHES == 1) bar = xcd_barrier_post((unsigned*)(((gu32*)(F.ws + WS_CTL)) + CW_BAR), MISC + 8);
    const int lo = args.ph_lo, hi = args.ph_hi;
#ifndef PH_MASK
#define PH_MASK 0x7f
#endif
#define IN(k) (((PH_MASK >> (k)) & 1) && lo <= (k) && (k) < hi)
#define SEAM(k) do { if (IN(k) && IN((k) + 1)) xcd_barrier(bar); } while (0)
#ifndef REP_MASK
#define REP_MASK 0
#endif
#define REPS(k) for (int rep_ = 0; rep_ < 1 + ((REP_MASK >> (k)) & 1); ++rep_, ((REP_MASK >> (k)) & 1) && rep_ == 1 ? (xcd_barrier(bar), 0) : 0)

    unsigned long long tp_ = PRB_T(); const unsigned long long tk0_ = tp_;
    if (IN(0)) REPS(0) { In I{}; I.win = (const float*)args.in[7]; I.wpa = (const float*)args.in[8]; I.wpb = (const float*)args.in[9]; I.wo = (const float*)args.in[10]; I.xp = (const float*)args.in[0]; I.xs = (const float*)args.in[1]; I.gin = (const float*)args.in[6]; p0_prologue(F, I); }
    PRB_ADD(0, tp_);
    SEAM(0); PRB_ADD(16, tp_); tp_ = PRB_T();
    if (IN(1)) REPS(1) {
        p1_sample_inproj(F);
        pg8::Gemm g{WSB(WS_XN), WSB(WS_XN), WSB(WS_WTIN), WSB(WS_WTIN), DM, DM, DM}; pg8::StaticOrder S; S.init(MP, LDH, F.G, F.bid);
        pg8::EpiInProj E{WSB(WS_H), F.out, WSF(WS_WI), F.ws + WS_KV8, F.ws + WS_KI8, WSF(WS_PSV)};
        pg8::gemm_phase<pg8::EpiInProj, pg8::StaticOrder, true, true>(F.lds + RING_OFF, g, S, E);
    }
    PRB_ADD(1, tp_);
    SEAM(1); PRB_ADD(17, tp_); tp_ = PRB_T();
    if (IN(2)) REPS(2) {
        In I{}; I.cki = (const float*)args.in[4]; I.pt = (const int*)args.in[5]; I.lng = (const float*)args.in[11]; I.lnb = (const float*)args.in[12]; I.wsp = (const float*)args.in[13]; I.bsp = (const float*)args.in[14];
        LAS int* slot = (LAS int*)(F.lds + LDSCTL_OFF);
        unsigned* qh = (unsigned*)(((gu32*)(F.ws + WS_CTL)) + CW_Q2 + 64 * 8 * rep_);
        unsigned* sdone = (unsigned*)(((gu32*)(F.ws + WS_CTL)) + CW_SDONE + 64 * 8 * rep_);
        const int pb = (int)(xb_xcc_id() & 1u);
        const bool stat_ = (F.G >= 128);
        int stage = stat_ ? 2 : 0, pre_ = (stat_ && F.bid < 128) ? 0 : 2;
        for (int par_ = 0;; par_ ^= 1) {
            int item, st_;
            if (pre_ >= 2 && F.tid == 0) {
                int st = stage, it = -1;
                for (; st < 5; ++st) {
                    const int q = (st == 0) ? 3 : (st == 1 ? 4 : (st == 4 ? 2 : (st == 2 ? pb : (pb ^ 1))));
                    const int lim = (st == 0) ? 128 : (st == 1 ? NS : (st == 4 ? 512 : 256));
                    const int v = (int)__hip_atomic_fetch_add(qh + 64 * q, 1u, __ATOMIC_RELAXED, __HIP_MEMORY_SCOPE_AGENT);
                    if (v < lim) { it = v; break; }
                }
                slot[2 * par_] = it; slot[2 * par_ + 1] = st;
            }
            __syncthreads();
            if (pre_ < 2) {
                item = F.bid; st_ = pre_;
                pre_ = (pre_ == 0 && F.bid < NS) ? 1 : 2;
            } else {
                item = __builtin_amdgcn_readfirstlane(slot[2 * par_]); stage = __builtin_amdgcn_readfirstlane(slot[2 * par_ + 1]); st_ = stage;
                if (item < 0) break;
            }
            if (st_ == 0) {
                const unsigned long long tq_ = PRB_T(); p2_sscore_item(F, I, item);
                asm volatile("s_waitcnt vmcnt(0)" ::: "memory"); __syncthreads();
                if (F.tid == 0) __hip_atomic_fetch_add(sdone + 64 * (item >> 4), 1u, __ATOMIC_RELAXED, __HIP_MEMORY_SCOPE_AGENT);
                PRB_ADD(13, tq_);
            } else if (st_ == 1) {
                const unsigned long long tq_ = PRB_T();
                if (F.tid == 0) { unsigned sp = 0; while (__hip_atomic_load(sdone + 64 * item, __ATOMIC_RELAXED, __HIP_MEMORY_SCOPE_AGENT) < 16u) { __builtin_amdgcn_s_sleep(8); if (++sp > (1u << 22)) break; }
                    __builtin_amdgcn_fence(__ATOMIC_ACQUIRE, "agent"); asm volatile("s_waitcnt vmcnt(0)" ::: "memory"); }
                __syncthreads();
                In J = I; J.ck = (const float*)args.in[2]; J.cv = (const float*)args.in[3];
                p3_sample_item(F, J, item);
                PRB_ADD(15, tq_);
            } else if (st_ == 4) { const unsigned long long tq_ = PRB_T(); for (int rp_ = 0; rp_ < 1 + ((REP_P2 >> 3) & 1); ++rp_) p2_gmlp_item(F, I, item); PRB_ADD(12, tq_); }
            else p2_prompt_item(F, item, st_ == 2 ? pb : (pb ^ 1));
        }
    }
    PRB_ADD(2, tp_);
    SEAM(2); PRB_ADD(8, tp_); tp_ = PRB_T();
    if (IN(3)) REPS(3) {
        if (F.bid < 128) {
            LAS float* red = (LAS float*)(F.lds + RING_OFF);
            const int n0 = 16 * F.bid;
            f32x4 ya, yb; float gav[4], gbv[4];
            {
                const int r = F.lane & 15, q = F.lane >> 4, kbeg = F.wave * 128;
                const bf16* xa = WSB(WS_OABS) + (size_t)(r & 7) * DM + kbeg + 8 * q; const bf16* wa = WSB(WS_WTA) + (size_t)(n0 + r) * 1024 + kbeg + 8 * q; const bf16* wb = WSB(WS_WTB) + (size_t)(n0 + r) * 1024 + kbeg + 8 * q;
                const bf16x8 z = {0, 0, 0, 0, 0, 0, 0, 0};
                bf16x8 a0[4], a1[4], b0[4], b1[4];
#pragma unroll
                for (int j = 0; j < 4; ++j) { const int s_ = (4 * (F.lane >> 4) + j) & 7; gav[j] = WSF(WS_HS)[(size_t)s_ * LDH + HC_GA + n0 + r]; gbv[j] = WSF(WS_HS)[(size_t)s_ * LDH + HC_GB + n0 + r]; }
#pragma unroll
                for (int st = 0; st < 4; ++st) { a0[st] = *(const bf16x8*)(xa + 32 * st); a1[st] = *(const bf16x8*)(xa + 1024 + 32 * st); b0[st] = *(const bf16x8*)(wa + 32 * st); b1[st] = *(const bf16x8*)(wb + 32 * st); }
                __builtin_amdgcn_sched_barrier(0);
                ya = (f32x4){0.f, 0.f, 0.f, 0.f}; yb = ya;
#pragma unroll
                for (int st = 0; st < 4; ++st) { ya = __builtin_amdgcn_mfma_f32_16x16x32_bf16(r >= 8 ? z : a0[st], b0[st], ya, 0, 0, 0); yb = __builtin_amdgcn_mfma_f32_16x16x32_bf16(r >= 8 ? z : a1[st], b1[st], yb, 0, 0, 0); }
                *(LAS f32x4*)(red + (F.wave * 64 + F.lane) * 4) = ya; *(LAS f32x4*)(red + ((8 + F.wave) * 64 + F.lane) * 4) = yb;
                __syncthreads();
                if (F.wave == 0) { ya = (f32x4){0.f, 0.f, 0.f, 0.f}; yb = ya;
#pragma unroll
                    for (int w = 0; w < 8; ++w) { ya += *(LAS f32x4*)(red + (w * 64 + F.lane) * 4); yb += *(LAS f32x4*)(red + ((8 + w) * 64 + F.lane) * 4); } }
            }
            if (F.wave == 0 && F.lane < 32) {
#pragma unroll
                for (int j = 0; j < 4; ++j) { const int s = 4 * (F.lane >> 4) + j, n = n0 + (F.lane & 15);
                    const float v = gav[j] * ya[j] + gbv[j] * yb[j];
                    WSB(WS_MIXS)[(size_t)s * DM + n] = (bf16)f2bf(v); }
            }
            __syncthreads();
        }
        pg8::Gemm g{WSB(WS_OAB), WSB(WS_OAB) + 1024, WSB(WS_WTA), WSB(WS_WTB), DM, 1024, 1024}; pg8::PairOrder S; S.init(MP, DM, F.G, F.bid);
        pg8::EpiMix E{WSB(WS_H), WSB(WS_MIX)};
        pg8::gemm_phase<pg8::EpiMix, pg8::PairOrder, true, true>(F.lds + RING_OFF, g, S, E);
    }
    PRB_ADD(3, tp_);
    SEAM(3); PRB_ADD(19, tp_); tp_ = PRB_T();
    if (IN(4)) REPS(4) {
        if (F.bid < 128) {
            LAS float* red = (LAS float*)(F.lds + RING_OFF);
            const int n0 = 16 * F.bid;
            float xres[4];
#pragma unroll
            for (int j = 0; j < 4; ++j) xres[j] = ((const float*)args.in[1])[(size_t)((4 * (F.lane >> 4) + j) & 7) * DM + n0 + (F.lane & 15)];
            f32x4 y = sgemv_part(WSB(WS_MIXS), DM, WSB(WS_WTO), DM, n0, F.wave * 256, 8, F.lane);
            y = block_reduce8(y, red, F.wave, F.lane);
            if (F.wave == 0 && F.lane < 32) {
#pragma unroll
                for (int j = 0; j < 4; ++j) { const int s = 4 * (F.lane >> 4) + j, n = n0 + (F.lane & 15); WSF(WS_XSO)[(size_t)s * DM + n] = xres[j] + y[j]; }
            }
        }
        __syncthreads();
        pg8::Gemm g{WSB(WS_MIX), WSB(WS_MIX), WSB(WS_WTO), WSB(WS_WTO), DM, DM, DM}; pg8::StaticOrder S; S.init(MP, DM, F.G, F.bid);
        struct BarFn { const XcdBarrier* b; __device__ __forceinline__ void operator()() const { xcd_barrier(*b); } };
        pg8::EpiOut<BarFn> E{(const float*)args.in[0], F.out, WSF(WS_PS), (const float*)args.in[15], BarFn{&bar}, PROBE_ID >= 0 ? (unsigned*)(((gu32*)(F.ws + WS_CTL)) + CW_PROBE + 21) : nullptr, tp_};
        pg8::gemm_phase<pg8::EpiOut<BarFn>, pg8::StaticOrder, false, true>(F.lds + RING_OFF, g, S, E);
        PRB_ADD(20, tk0_);
        const int gw = F.bid * 8 + F.wave, NGW = F.G * 8;
        if (gw >= NGW - NS) { const int sr = gw - (NGW - NS);
            const f32x4* xr = (const f32x4*)(WSF(WS_XSO) + (size_t)sr * DM) + F.lane; const f32x4* gr = (const f32x4*)args.in[15] + F.lane;
            f32x4 v[8]; float s = 0.f;
#pragma unroll
            for (int j = 0; j < 8; ++j) { v[j] = xr[64 * j]; s += (v[j].x * v[j].x + v[j].y * v[j].y) + (v[j].z * v[j].z + v[j].w * v[j].w); }
            const float rstd = 1.0f / sqrtf(wave_sum(s) * (1.f / DM) + RMS_EPS);
            f32x4* o = (f32x4*)(F.out + O_YS + (size_t)sr * DM) + F.lane;
            float prb_ = 1.0f; if (PROBE_ID >= 0) prb_ += (float)PRB_Q(__hip_atomic_load((unsigned*)(((gu32*)(F.ws + WS_CTL)) + CW_PROBE + (PROBE_ID >= 0 ? PROBE_ID : 0)), __ATOMIC_RELAXED, __HIP_MEMORY_SCOPE_AGENT)) * (0.01f / 256.f / 1000.f);
#pragma unroll
            for (int j = 0; j < 8; ++j) o[64 * j] = v[j] * rstd * gr[64 * j] * prb_;
        }

    }
    PRB_ADD(4, tp_);
#undef IN
#undef SEAM
}

extern "C" void kernel_launch(void* const* d_in, const int* in_sizes, int n_in, void* d_out, int out_size, void* d_ws, size_t ws_size, hipStream_t stream) {
    static int grid = 0;
    if (grid == 0) {
        if (n_in != 16 || out_size != (int)O_END || ws_size < WS_END) { fprintf(stderr, "kernel_launch: unexpected shapes: n_in %d out %d ws %zu\n", n_in, out_size, ws_size); grid = -1; return; }
        int dev = 0, cus = 0;
        if (hipGetDevice(&dev) != hipSuccess || hipDeviceGetAttribute(&cus, hipDeviceAttributeMultiprocessorCount, dev) != hipSuccess) { grid = -1; return; }
        if (hipFuncSetAttribute((const void*)mk_fwd, hipFuncAttributeMaxDynamicSharedMemorySize, LDS_BYTES) != hipSuccess) { fprintf(stderr, "kernel_launch: hipFuncSetAttribute failed\n"); grid = -1; return; }
        int per_cu = 0;
        if (hipOccupancyMaxActiveBlocksPerMultiprocessor(&per_cu, (const void*)mk_fwd, 512, LDS_BYTES) != hipSuccess || per_cu < 1) fprintf(stderr, "kernel_launch: occupancy query reports %d\n", per_cu);
        (void)hipGetLastError();
        grid = cus;
        if (grid != 256) fprintf(stderr, "kernel_launch: %d CUs; this kernel is laid out for 256\n", grid);
    }
    if (grid < 0) return;
    (void)hipMemsetAsync((char*)d_ws + WS_CTL, 0, CTL_ZERO_BYTES, stream);
    Args a{};
    for (int i = 0; i < 16; ++i) a.in[i] = d_in[i];
    a.out = (float*)d_out; a.ws = (unsigned char*)d_ws;
    constexpr int NPH = 5;
    if (MK_N_LAUNCHES == 1) { a.ph_lo = 0; a.ph_hi = NPH; a.li = 0; hipLaunchKernelGGL(mk_fwd, dim3(grid), dim3(512), LDS_BYTES, stream, a); }
    else for (int p = 0; p < NPH; ++p) { a.ph_lo = p; a.ph_hi = p + 1; a.li = p; hipLaunchKernelGGL(mk_fwd, dim3(grid), dim3(512), LDS_BYTES, stream, a); }
}
```

```cpp
#include <hip/hip_runtime.h>
#include <cstdio>
#include <cstdint>
#include <cmath>

#ifndef MK_N_LAUNCHES
#define MK_N_LAUNCHES 1
#endif

constexpr int DM = 2048, SEQ = 4096, NBATCH = 2, MP = NBATCH * SEQ, NS = 8, PAST = 16384, NPAGES = 128, PAGE = 128;
constexpr int LDH = 12032;
constexpr int HC_Q = 0, HC_K = 1024, HC_V = 1280, HC_QI = 1536, HC_WI = 3584, HC_KI = 3600, HC_ZA = 3840, HC_U = 4864, HC_VB = 5888, HC_ZB = 6912, HC_GA = 7936, HC_GB = 9984;
constexpr int IN_WIDTH = 11920;
constexpr float QSCALE = 0.08838834764831845f * 1.4426950408889634f;
constexpr float WSCALE = 0.25f * 0.08838834764831845f;
constexpr float RMS_EPS = 1e-6f, LN_EPS = 1e-5f;
constexpr size_t O_YP = 0, O_YS = 16777216, O_KP = 16793600, O_VP = 18890752, O_KIP = 20987904, O_KS = 22036480, O_VS = 22038528, O_KIS = 22040576, O_GV = 22041600, O_END = 22049792;
constexpr size_t MiB = 1u << 20;
constexpr size_t WS_CTL = 0, CTL_ZERO_BYTES = 32768;
constexpr size_t WS_WTIN = 2 * MiB, WS_WTA = 50 * MiB, WS_WTB = 54 * MiB, WS_WTO = 58 * MiB, WS_XN = 66 * MiB, WS_XNS = 98 * MiB, WS_HS = 99 * MiB, WS_SSC = 100 * MiB;
constexpr size_t WS_OABS = 101 * MiB, WS_MIXS = 101 * MiB + 256 * 1024, WS_XSO = 101 * MiB + 512 * 1024, WS_PS = 102 * MiB, WS_WI = 103 * MiB;
constexpr size_t WS_H = 104 * MiB, WS_OAB = 292 * MiB, WS_MIX = 324 * MiB, WS_SC = 356 * MiB, WS_KV8 = 420 * MiB, WS_PSV = 424 * MiB, WS_KI8 = 425 * MiB, WS_END = 426 * MiB;
#ifndef IDX_FP8
#define IDX_FP8 0
#endif
#ifndef ATT_FP8
#define ATT_FP8 1
#endif
constexpr int SSC_LD = 16448;
static_assert(WS_WTIN + (size_t)LDH * DM * 2 <= WS_WTA && WS_H + (size_t)MP * LDH * 2 <= WS_OAB && WS_WI + (size_t)MP * 16 * 4 <= WS_H, "ws map");
constexpr int CW_Q2 = 64;
constexpr int CW_SDONE = 1152;
constexpr int CW_BAR = 4096;

#define GAS __attribute__((address_space(1)))
#define LAS __attribute__((address_space(3)))
typedef unsigned short bf16;
typedef unsigned v4u __attribute__((ext_vector_type(4)));
typedef unsigned v2u __attribute__((ext_vector_type(2)));
typedef float f32x4 __attribute__((ext_vector_type(4)));
typedef float f32x2 __attribute__((ext_vector_type(2)));
typedef float f32x16 __attribute__((ext_vector_type(16)));
typedef short bf16x8 __attribute__((ext_vector_type(8)));
typedef short s16x4 __attribute__((ext_vector_type(4)));
typedef __bf16 bf16x2_t __attribute__((ext_vector_type(2)));
typedef int v2i_t __attribute__((ext_vector_type(2)));
typedef GAS unsigned gu32;
#define LDS_WAIT() asm volatile("s_waitcnt lgkmcnt(0)" ::: "memory")
#define VM_WAIT() asm volatile("s_waitcnt vmcnt(0)" ::: "memory")

__device__ __forceinline__ unsigned cvtpk(float lo, float hi) { f32x2 v = {lo, hi}; bf16x2_t b = __builtin_convertvector(v, bf16x2_t); return __builtin_bit_cast(unsigned, b); }
__device__ __forceinline__ float bf2f(unsigned short h) { return __uint_as_float((unsigned)h << 16); }
__device__ __forceinline__ float bflo(unsigned w) { return __uint_as_float(w << 16); }
__device__ __forceinline__ float bfhi(unsigned w) { return __uint_as_float(w & 0xffff0000u); }
__device__ __forceinline__ bf16x8 cvt8(f32x4 a, f32x4 b) { v4u w; w.x = cvtpk(a[0], a[1]); w.y = cvtpk(a[2], a[3]); w.z = cvtpk(b[0], b[1]); w.w = cvtpk(b[2], b[3]); return __builtin_bit_cast(bf16x8, w); }
__device__ __forceinline__ void store16_wt(void* p, v4u v) { asm volatile("global_store_dwordx4 %0, %1, off sc1\n\ts_nop 1" :: "v"(p), "v"(v) : "memory"); }
__device__ __forceinline__ float sigmoid_(float x) { return __builtin_amdgcn_rcpf(1.f + __builtin_amdgcn_exp2f(-1.4426950408889634f * x)); }
__device__ __forceinline__ float silu_(float x) { return x * sigmoid_(x); }
template <int CTRL> __device__ __forceinline__ float dppf(float v) { return __int_as_float(__builtin_amdgcn_mov_dpp(__float_as_int(v), CTRL, 0xF, 0xF, true)); }
template <int CTRL> __device__ __forceinline__ int dppi(int v) { return __builtin_amdgcn_mov_dpp(v, CTRL, 0xF, 0xF, true); }
__device__ __forceinline__ float x16_add(float v) { const auto x = __builtin_amdgcn_permlane16_swap(__float_as_uint(v), __float_as_uint(v), false, false); return __uint_as_float(x[0]) + __uint_as_float(x[1]); }
__device__ __forceinline__ float x32_add(float v) { const auto x = __builtin_amdgcn_permlane32_swap(__float_as_uint(v), __float_as_uint(v), false, false); return __uint_as_float(x[0]) + __uint_as_float(x[1]); }
__device__ __forceinline__ float x16_max(float v) { const auto x = __builtin_amdgcn_permlane16_swap(__float_as_uint(v), __float_as_uint(v), false, false); return fmaxf(__uint_as_float(x[0]), __uint_as_float(x[1])); }
__device__ __forceinline__ float x32_max(float v) { const auto x = __builtin_amdgcn_permlane32_swap(__float_as_uint(v), __float_as_uint(v), false, false); return fmaxf(__uint_as_float(x[0]), __uint_as_float(x[1])); }
__device__ __forceinline__ float x16_min(float v) { const auto x = __builtin_amdgcn_permlane16_swap(__float_as_uint(v), __float_as_uint(v), false, false); return fminf(__uint_as_float(x[0]), __uint_as_float(x[1])); }
__device__ __forceinline__ float x32_min(float v) { const auto x = __builtin_amdgcn_permlane32_swap(__float_as_uint(v), __float_as_uint(v), false, false); return fminf(__uint_as_float(x[0]), __uint_as_float(x[1])); }
__device__ __forceinline__ float xrows_add(float v) { return x32_add(x16_add(v)); }
__device__ __forceinline__ float xrows_max(float v) { return x32_max(x16_max(v)); }
__device__ __forceinline__ float wave_sum(float v) { v += dppf<0xB1>(v); v += dppf<0x4E>(v); v += dppf<0x141>(v); v += dppf<0x140>(v); return xrows_add(v); }
__device__ __forceinline__ int wave_sum_i(int v) { v += dppi<0xB1>(v); v += dppi<0x4E>(v); v += dppi<0x141>(v); v += dppi<0x140>(v);
    { const auto x = __builtin_amdgcn_permlane16_swap((unsigned)v, (unsigned)v, false, false); v = (int)(x[0] + x[1]); }
    { const auto x = __builtin_amdgcn_permlane32_swap((unsigned)v, (unsigned)v, false, false); v = (int)(x[0] + x[1]); } return v; }
__device__ __forceinline__ float wave_max(float v) { v = fmaxf(v, dppf<0xB1>(v)); v = fmaxf(v, dppf<0x4E>(v)); v = fmaxf(v, dppf<0x141>(v)); v = fmaxf(v, dppf<0x140>(v)); return xrows_max(v); }
__device__ __forceinline__ float wave_min(float v) { v = fminf(v, dppf<0xB1>(v)); v = fminf(v, dppf<0x4E>(v)); v = fminf(v, dppf<0x141>(v)); v = fminf(v, dppf<0x140>(v)); return x32_min(x16_min(v)); }

namespace pg8 {
#define PG8_LAS __attribute__((address_space(3)))
typedef unsigned short bf16_t;
typedef unsigned u32x4 __attribute__((ext_vector_type(4)));
constexpr int BM = 256, BK = 64, HALF = 128, HTB = HALF * BK * 2, STAGE_BYTES = 8 * HTB, NXCD = 8, WGM = 8;
__host__ __device__ __forceinline__ int lds_byte(int r, int c) { const int st = (r >> 4) * 2 + (c >> 5), rr = r & 15, cc = c & 31, ob = rr * 64 + cc * 2; return st * 1024 + (ob ^ (((ob >> 9) & 1) << 5)); }
__host__ __device__ __forceinline__ void stage_rc(int b, int& R, int& C) { const int st = b / 1024, sb = b % 1024, swz = sb ^ (((sb >> 9) & 1) << 5); R = (st >> 1) * 16 + swz / 64; C = (st & 1) * 32 + (swz % 64) / 2; }
__host__ __device__ __forceinline__ int perm32(int rho) { const int n = rho >> 4, i = rho & 15; return 8 * (i >> 2) + 4 * n + (i & 3); }
struct Unit { int pm, pn, kind; };
struct Gemm { const bf16_t* A0; const bf16_t* A1; const bf16_t* B0; const bf16_t* B1; int lda, ldb, K; };
struct StaticOrder {
    int nM, nN, nwg, G, c;
    __host__ __device__ void init(int M, int N, int G_, int c_) { nM = M / BM; nN = N / BM; nwg = nM * nN; G = G_; c = c_; }
    __host__ __device__ bool tile(long L, Unit& u) const {
        if (L >= nwg) return false;
        int wgid = (int)L; { const int q = nwg / NXCD, r = nwg % NXCD, xcd = wgid % NXCD, off = wgid / NXCD; wgid = (xcd < r ? xcd * (q + 1) : r * (q + 1) + (xcd - r) * q) + off; }
        const int nig = WGM * nN, gid = wgid / nig, fm = gid * WGM, gsz = (nM - fm) < WGM ? (nM - fm) : WGM;
        u.pm = fm + ((wgid % nig) % gsz); u.pn = (wgid % nig) / gsz; u.kind = 0; return true;
    }
    __host__ __device__ bool next(int i, Unit& u) const { return tile((long)i * G + c, u); }
};
struct PairOrder : StaticOrder {
    __host__ __device__ bool next(int i, Unit& u) const { if (i >= 2) return false; const bool ok = tile((long)c, u); u.kind = i; return ok; }
};

template <class Epi, class Sched, bool ALIGN_EPI = false, bool SP2 = false>
__device__ __forceinline__ void gemm_phase(PG8_LAS unsigned char* lds, const Gemm g, const Sched& S, const Epi& E) {
    const int tid = threadIdx.x, wid = __builtin_amdgcn_readfirstlane(tid >> 6), lane = tid & 63, wr = wid >> 2, wc = wid & 3, fr = lane & 15, fq = lane >> 4;
    const int K = g.K, nt = K / BK;
    unsigned voffA[2], voffB[2];
#pragma unroll
    for (int i = 0; i < 2; ++i) { int R, C; stage_rc(tid * 16 + i * 8192, R, C); const int Rb = Epi::PERM ? ((R & ~31) + perm32(R & 31)) : R;
        voffA[i] = (unsigned)(R * g.lda + C) * 2u; voffB[i] = (unsigned)(Rb * g.ldb + C) * 2u; }
    const size_t kstep = (size_t)(BK * 2);
    const size_t hstepA = (size_t)HALF * g.lda * 2, hstepB = (size_t)HALF * g.ldb * 2;
    const size_t tstepA = 2 * hstepA, tstepB = 2 * hstepB;
    const unsigned ldsw = (unsigned)wid * 1024u;
    const int aoff = lds_byte(wr * 64 + fr, fq * 8), boff = lds_byte(wc * 32 + fr, fq * 8);
#define PG8_SA(b, h) (((b) * 2 + (h)) * HTB)
#define PG8_SB(b, h) ((4 + (b) * 2 + (h)) * HTB)
#define PG8_STAGE(bufoff, gbase, voff) do { _Pragma("unroll") for (int _i = 0; _i < 2; ++_i) \
        __builtin_amdgcn_global_load_lds((const unsigned*)((const char*)(gbase) + (voff)[_i]), (PG8_LAS unsigned*)(lds + (bufoff) + ldsw + _i * 8192), 16, 0, 0); } while (0)
#define PG8_LDA(dst, b, h) do { _Pragma("unroll") for (int m = 0; m < 4; ++m) _Pragma("unroll") for (int k = 0; k < 2; ++k) dst[m][k] = *(const PG8_LAS bf16x8*)(lds + PG8_SA(b, h) + aoff + m * 2048 + k * 1024); } while (0)
#define PG8_LDB(dst, b, h) do { _Pragma("unroll") for (int n = 0; n < 2; ++n) _Pragma("unroll") for (int k = 0; k < 2; ++k) dst[n][k] = *(const PG8_LAS bf16x8*)(lds + PG8_SB(b, h) + boff + n * 2048 + k * 1024); } while (0)
#define PG8_MMA(ai, bj, At, Bt) do { __builtin_amdgcn_s_setprio(1); _Pragma("unroll") for (int m = 0; m < 4; ++m) _Pragma("unroll") for (int n = 0; n < 2; ++n) _Pragma("unroll") for (int k = 0; k < 2; ++k) \
        acc[ai][bj][m][n] = __builtin_amdgcn_mfma_f32_16x16x32_bf16(Bt[n][k], At[m][k], acc[ai][bj][m][n], 0, 0, 0); __builtin_amdgcn_s_setprio(0); } while (0)
#define PG8_WAIT_V(n) asm volatile("s_waitcnt vmcnt(" #n ")" ::: "memory")
#define PG8_WAIT_L(n) asm volatile("s_waitcnt lgkmcnt(" #n ")" ::: "memory")
#define PG8_BAR __builtin_amdgcn_s_barrier()
#define PG8_SCHED __builtin_amdgcn_sched_barrier(0)
#define PG8_OPA(u) ((const char*)((u).kind ? g.A1 : g.A0) + (size_t)(u).pm * tstepA)
#define PG8_OPB(u) ((const char*)((u).kind ? g.B1 : g.B0) + (size_t)(u).pn * tstepB)
    Unit cur, nxt; int ui = 0;
    if (!S.next(0, cur)) return;
    f32x4 acc[2][2][4][2];
#pragma unroll
    for (int a = 0; a < 2; ++a)
#pragma unroll
        for (int b = 0; b < 2; ++b)
#pragma unroll
            for (int m = 0; m < 4; ++m)
#pragma unroll
                for (int n = 0; n < 2; ++n) acc[a][b][m][n] = (f32x4){0.f, 0.f, 0.f, 0.f};
    bf16x8 At[4][2], B0[2][2], B1[2][2];
    const char* cA = PG8_OPA(cur); const char* cB = PG8_OPB(cur);
    if constexpr (SP2) {
        PG8_STAGE(PG8_SB(0, 0), cB, voffB); PG8_STAGE(PG8_SB(0, 1), cB + hstepB, voffB); PG8_STAGE(PG8_SA(0, 0), cA, voffA); PG8_STAGE(PG8_SA(0, 1), cA + hstepA, voffA);
        if (wr == 1) PG8_BAR;
        PG8_WAIT_V(2); PG8_BAR;
        PG8_STAGE(PG8_SB(1, 0), cB + kstep, voffB); PG8_STAGE(PG8_SA(1, 0), cA + kstep, voffA); PG8_STAGE(PG8_SB(1, 1), cB + hstepB + kstep, voffB);
        PG8_WAIT_V(6); PG8_BAR;
    } else {
        PG8_STAGE(PG8_SB(0, 0), cB, voffB); PG8_STAGE(PG8_SA(0, 0), cA, voffA); PG8_STAGE(PG8_SB(0, 1), cB + hstepB, voffB); PG8_STAGE(PG8_SA(0, 1), cA + hstepA, voffA);
        if (wr == 1) PG8_BAR;
        PG8_WAIT_V(4); PG8_BAR;
        PG8_STAGE(PG8_SB(1, 0), cB + kstep, voffB); PG8_STAGE(PG8_SA(1, 0), cA + kstep, voffA); PG8_STAGE(PG8_SB(1, 1), cB + hstepB + kstep, voffB);
        PG8_WAIT_V(6); PG8_BAR;
    }
    for (;;) {
        const bool has_next = S.next(ui + 1, nxt);
        const char* nA = has_next ? PG8_OPA(nxt) : cA; const char* nB = has_next ? PG8_OPB(nxt) : cB;
        for (int t = 0; t < nt; t += 2) {
            const bool last = (t == nt - 2);
            const char* a1 = cA + (size_t)(t + 1) * kstep;
            const char* a2 = last ? nA : cA + (size_t)(t + 2) * kstep; const char* b2 = last ? nB : cB + (size_t)(t + 2) * kstep;
            const char* a3 = a2 + kstep; const char* b3 = b2 + kstep;
            if constexpr (SP2) {
            PG8_LDB(B0, 0, 0); PG8_LDB(B1, 0, 1); PG8_SCHED; PG8_LDA(At, 0, 0); PG8_STAGE(PG8_SA(1, 1), a1 + hstepA, voffA);
            PG8_WAIT_V(8); PG8_WAIT_L(0); PG8_BAR; PG8_MMA(0, 0, At, B0); PG8_MMA(0, 1, At, B1); PG8_BAR; PG8_SCHED;
            PG8_LDA(At, 0, 1); PG8_STAGE(PG8_SB(0, 0), b2, voffB); PG8_STAGE(PG8_SB(0, 1), b2 + hstepB, voffB); PG8_STAGE(PG8_SA(0, 0), a2, voffA);
            PG8_WAIT_V(8); PG8_WAIT_L(0); PG8_BAR; PG8_MMA(1, 0, At, B0); PG8_MMA(1, 1, At, B1); PG8_BAR; PG8_SCHED;
            PG8_LDB(B0, 1, 0); PG8_LDB(B1, 1, 1); PG8_SCHED; PG8_LDA(At, 1, 0); PG8_STAGE(PG8_SA(0, 1), a2 + hstepA, voffA);
            PG8_WAIT_V(8); PG8_WAIT_L(0); PG8_BAR; PG8_MMA(0, 0, At, B0); PG8_MMA(0, 1, At, B1); PG8_BAR; PG8_SCHED;
            PG8_LDA(At, 1, 1); PG8_STAGE(PG8_SB(1, 0), b3, voffB); PG8_STAGE(PG8_SB(1, 1), b3 + hstepB, voffB); PG8_STAGE(PG8_SA(1, 0), a3, voffA);
            PG8_WAIT_V(8); PG8_WAIT_L(0); PG8_BAR; PG8_MMA(1, 0, At, B0); PG8_MMA(1, 1, At, B1); PG8_BAR; PG8_SCHED;
            } else {
            PG8_LDB(B0, 0, 0); PG8_SCHED; PG8_LDA(At, 0, 0); PG8_STAGE(PG8_SA(1, 1), a1 + hstepA, voffA);
            PG8_WAIT_L(8); PG8_BAR; PG8_WAIT_L(0); PG8_MMA(0, 0, At, B0); PG8_BAR; PG8_SCHED;
            PG8_LDB(B1, 0, 1); PG8_STAGE(PG8_SB(0, 0), b2, voffB);
            PG8_BAR; PG8_WAIT_L(0); PG8_MMA(0, 1, At, B1); PG8_BAR;
            PG8_LDA(At, 0, 1); PG8_STAGE(PG8_SA(0, 0), a2, voffA);
            PG8_BAR; PG8_WAIT_L(0); PG8_MMA(1, 0, At, B0); PG8_BAR; PG8_SCHED;
            PG8_STAGE(PG8_SB(0, 1), b2 + hstepB, voffB);
            PG8_WAIT_V(6); PG8_BAR; PG8_MMA(1, 1, At, B1); PG8_BAR;
            PG8_LDB(B0, 1, 0); PG8_SCHED; PG8_LDA(At, 1, 0); PG8_STAGE(PG8_SA(0, 1), a2 + hstepA, voffA);
            PG8_WAIT_L(8); PG8_BAR; PG8_WAIT_L(0); PG8_MMA(0, 0, At, B0); PG8_BAR; PG8_SCHED;
            PG8_LDB(B1, 1, 1); PG8_STAGE(PG8_SB(1, 0), b3, voffB);
            PG8_BAR; PG8_WAIT_L(0); PG8_MMA(0, 1, At, B1); PG8_BAR;
            PG8_LDA(At, 1, 1); PG8_STAGE(PG8_SA(1, 0), a3, voffA);
            PG8_BAR; PG8_WAIT_L(0); PG8_MMA(1, 0, At, B0); PG8_BAR; PG8_SCHED;
            PG8_STAGE(PG8_SB(1, 1), b3 + hstepB, voffB);
            PG8_WAIT_V(6); PG8_BAR; PG8_MMA(1, 1, At, B1); PG8_BAR;
            }
        }
        if constexpr (ALIGN_EPI) { if (wr == 0) PG8_BAR; }
        if constexpr (!Epi::AFTER_DRAIN) { E(acc, cur, wr, wc, fr, fq); }
        if (!has_next) break;
        if (!(Epi::KEEP && cur.kind == 0)) {
#pragma unroll
        for (int a = 0; a < 2; ++a)
#pragma unroll
            for (int b = 0; b < 2; ++b)
#pragma unroll
                for (int m = 0; m < 4; ++m)
#pragma unroll
                    for (int n = 0; n < 2; ++n) acc[a][b][m][n] = (f32x4){0.f, 0.f, 0.f, 0.f};
        }
        cur = nxt; cA = nA; cB = nB; ++ui;
        if constexpr (ALIGN_EPI) { if (wr == 1) PG8_BAR; }
    }
    PG8_WAIT_V(0);
    if constexpr (!ALIGN_EPI) { if (wr == 0) PG8_BAR; }
    PG8_BAR;
    if constexpr (Epi::AFTER_DRAIN) { E.fused(acc, cur, wr, wc, fr, fq, lds, wid, lane); }
#undef PG8_SA
#undef PG8_SB
#undef PG8_STAGE
#undef PG8_LDA
#undef PG8_LDB
#undef PG8_MMA
#undef PG8_WAIT_V
#undef PG8_WAIT_L
#undef PG8_BAR
#undef PG8_SCHED
#undef PG8_OPA
#undef PG8_OPB
}

__device__ __forceinline__ f32x2 gelu_pk(f32x2 v) {
    const f32x2 av = __builtin_elementwise_abs(v), d = av * 0.2316418882f + 1.0f;
    f32x2 t; t.x = __builtin_amdgcn_rcpf(d.x); t.y = __builtin_amdgcn_rcpf(d.y);
    f32x2 q = t * 0.5307027145f + (-0.7265760135f); q = q * t + 0.7107068705f; q = q * t + (-0.142248368f); q = q * t + 0.127414796f; q = q * t;
    const f32x2 s = (v * v) * (-0.72134752044f);
    f32x2 e; e.x = __builtin_amdgcn_exp2f(s.x); e.y = __builtin_amdgcn_exp2f(s.y);
    const f32x2 m = v * (q * e), r = v - m;
    f32x2 o; o.x = v.x < 0.f ? m.x : r.x; o.y = v.y < 0.f ? m.y : r.y; return o;
}

struct EpiInProj {
    static constexpr bool PERM = true, AFTER_DRAIN = false, KEEP = false;
    bf16_t* H; float* out; float* WI; unsigned char* KV8; unsigned char* KI8; float* PSV;
    __device__ __forceinline__ void operator()(f32x4 (&acc)[2][2][4][2], const Unit& u, int wr, int wc, int fr, int fq) const {
        const int pn = u.pn;
        int act;
        if (pn < 4) act = 1; else if (pn == 4) act = 5; else if (pn == 5) act = 6; else if (pn < 14) act = 0; else if (pn == 14) act = 7;
        else if (pn < 19) act = 2; else if (pn < 27) act = 3; else if (pn < 31) act = 2; else act = 4;
        const int row0 = u.pm * BM + wr * 64 + fr, col0 = pn * BM + wc * 32 + 8 * fq;
#pragma unroll
        for (int ai = 0; ai < 2; ++ai)
#pragma unroll
            for (int m = 0; m < 4; ++m) { const int row = row0 + ai * HALF + m * 16; bf16_t* hrow = H + (size_t)row * LDH; float s1 = 0.f, s2 = 0.f;
#pragma unroll
                for (int bj = 0; bj < 2; ++bj) { f32x4 v0 = acc[ai][bj][m][0], v1 = acc[ai][bj][m][1]; const int c = col0 + bj * HALF;
                    bool st = true;
                    if (act == 1) { v0 = v0 * QSCALE; v1 = v1 * QSCALE; }
                    else if (act == 2) {
#pragma unroll
                        for (int j = 0; j < 4; ++j) { v0[j] = silu_(v0[j]); v1[j] = silu_(v1[j]); } }
                    else if (act == 3) { f32x2 a = gelu_pk((f32x2){v0[0], v0[1]}), b = gelu_pk((f32x2){v0[2], v0[3]}), cc = gelu_pk((f32x2){v1[0], v1[1]}), d = gelu_pk((f32x2){v1[2], v1[3]});
                        v0 = (f32x4){a.x, a.y, b.x, b.y}; v1 = (f32x4){cc.x, cc.y, d.x, d.y};
                        s1 += ((v0[0] + v0[1]) + (v0[2] + v0[3])) + ((v1[0] + v1[1]) + (v1[2] + v1[3]));
                        s2 += ((v0[0] * v0[0] + v0[1] * v0[1]) + (v0[2] * v0[2] + v0[3] * v0[3])) + ((v1[0] * v1[0] + v1[1] * v1[1]) + (v1[2] * v1[2] + v1[3] * v1[3])); }
                    else if (act == 4) {
#pragma unroll
                        for (int j = 0; j < 4; ++j) { v0[j] = sigmoid_(v0[j]); v1[j] = sigmoid_(v1[j]); } }
                    else if (act == 5 || act == 6) { float* o = out + (act == 5 ? O_KP : O_VP) + (size_t)row * 256 + (c - (act == 5 ? HC_K : HC_V)); *(f32x4*)o = v0; *(f32x4*)(o + 4) = v1;
                        if (ATT_FP8) { int w0 = __builtin_amdgcn_cvt_pk_fp8_f32(v0[0], v0[1], 0, false); w0 = __builtin_amdgcn_cvt_pk_fp8_f32(v0[2], v0[3], w0, true);
                            int w1 = __builtin_amdgcn_cvt_pk_fp8_f32(v1[0], v1[1], 0, false); w1 = __builtin_amdgcn_cvt_pk_fp8_f32(v1[2], v1[3], w1, true);
                            *(v2u*)(KV8 + (size_t)row * 512 + (act == 5 ? 0 : 256) + (c - (act == 5 ? HC_K : HC_V))) = (v2u){(unsigned)w0, (unsigned)w1}; st = false; } }
                    else if (act == 7) { const int cl = c - HC_WI;
                        if (cl < 16) { float* o = WI + (size_t)row * 16 + cl; *(f32x4*)o = v0 * WSCALE; *(f32x4*)(o + 4) = v1 * WSCALE; st = false; }
                        else if (cl < 144) { float* o = out + O_KIP + (size_t)row * 128 + (cl - 16); *(f32x4*)o = v0; *(f32x4*)(o + 4) = v1;
                            if (IDX_FP8) { int w0 = __builtin_amdgcn_cvt_pk_fp8_f32(v0[0], v0[1], 0, false); w0 = __builtin_amdgcn_cvt_pk_fp8_f32(v0[2], v0[3], w0, true);
                                int w1 = __builtin_amdgcn_cvt_pk_fp8_f32(v1[0], v1[1], 0, false); w1 = __builtin_amdgcn_cvt_pk_fp8_f32(v1[2], v1[3], w1, true);
                                *(v2u*)(KI8 + (size_t)row * 128 + (cl - 16)) = (v2u){(unsigned)w0, (unsigned)w1}; } }
                        else st = false; }
                    if (st) { u32x4 w; w.x = cvtpk(v0[0], v0[1]); w.y = cvtpk(v0[2], v0[3]); w.z = cvtpk(v1[0], v1[1]); w.w = cvtpk(v1[2], v1[3]); store16_wt(hrow + c, w); } }
                if (pn >= 23 && pn < 27) {
                    s1 = xrows_add(s1); s2 = xrows_add(s2);
                    if (fq == 0) *(f32x2*)(PSV + ((size_t)row * 16 + (pn - 23) * 4 + wc) * 2) = (f32x2){s1, s2}; } }
    }
};
struct EpiMix {
    static constexpr bool PERM = true, AFTER_DRAIN = false, KEEP = true;
    const bf16_t* H; bf16_t* MIX;
    __device__ __forceinline__ void operator()(f32x4 (&acc)[2][2][4][2], const Unit& u, int wr, int wc, int fr, int fq) const {
        const int row0 = u.pm * BM + wr * 64 + fr, col0 = u.pn * BM + wc * 32 + 8 * fq;
#pragma unroll
        for (int ai = 0; ai < 2; ++ai) {
            u32x4 gb[4][2], ga[4][2];
#pragma unroll
            for (int m = 0; m < 4; ++m)
#pragma unroll
                for (int bj = 0; bj < 2; ++bj) { const bf16_t* hp = H + (size_t)(row0 + ai * HALF + m * 16) * LDH + col0 + bj * HALF;
                    gb[m][bj] = *(const u32x4*)(hp + HC_GB); if (u.kind == 0) ga[m][bj] = *(const u32x4*)(hp + HC_GA); }
            __builtin_amdgcn_sched_barrier(0);
#pragma unroll
            for (int m = 0; m < 4; ++m) { const int row = row0 + ai * HALF + m * 16;
#pragma unroll
                for (int bj = 0; bj < 2; ++bj) { const int c = col0 + bj * HALF; const u32x4 gbv = gb[m][bj];
                    float b[8] = {bflo(gbv.x), bfhi(gbv.x), bflo(gbv.y), bfhi(gbv.y), bflo(gbv.z), bfhi(gbv.z), bflo(gbv.w), bfhi(gbv.w)};
                    if (u.kind == 0) {
                        const u32x4 gav = ga[m][bj];
                        float a[8] = {bflo(gav.x), bfhi(gav.x), bflo(gav.y), bfhi(gav.y), bflo(gav.z), bfhi(gav.z), bflo(gav.w), bfhi(gav.w)};
#pragma unroll
                        for (int j = 0; j < 4; ++j) { acc[ai][bj][m][0][j] *= a[j] * __builtin_amdgcn_rcpf(fmaxf(b[j], 1e-30f)); acc[ai][bj][m][1][j] *= a[4 + j] * __builtin_amdgcn_rcpf(fmaxf(b[4 + j], 1e-30f)); }
                    } else {
                        f32x4 v0 = acc[ai][bj][m][0], v1 = acc[ai][bj][m][1];
#pragma unroll
                        for (int j = 0; j < 4; ++j) { v0[j] *= b[j]; v1[j] *= b[4 + j]; }
                        u32x4 w; w.x = cvtpk(v0[0], v0[1]); w.y = cvtpk(v0[2], v0[3]); w.z = cvtpk(v1[0], v1[1]); w.w = cvtpk(v1[2], v1[3]); *(u32x4*)(MIX + (size_t)row * DM + c) = w; } } }
            __builtin_amdgcn_sched_barrier(0);
        }
    }
};
template <class Bar>
struct EpiOut {
    static constexpr bool PERM = false, AFTER_DRAIN = true, KEEP = false;
    const float* X; float* out; float* PS; const float* gf; Bar bar; unsigned* prb; unsigned long long t0;
    __device__ __forceinline__ void fused(f32x4 (&acc)[2][2][4][2], const Unit& u, int wr, int wc, int fr, int fq, PG8_LAS unsigned char* lds, int wid, int lane) const {
        PG8_LAS float* P = (PG8_LAS float*)lds;
        PG8_LAS float* R = (PG8_LAS float*)(lds + 4096);
        const int col0 = u.pn * BM + wc * 32 + 4 * fq;
#pragma unroll
        for (int ai = 0; ai < 2; ++ai) {
            f32x4 xv[4][2][2];
#pragma unroll
            for (int m = 0; m < 4; ++m) { const size_t off = (size_t)(u.pm * BM + ai * HALF + wr * 64 + m * 16 + fr) * DM + col0;
#pragma unroll
                for (int bj = 0; bj < 2; ++bj)
#pragma unroll
                    for (int n = 0; n < 2; ++n) xv[m][bj][n] = *(const f32x4*)(X + off + bj * HALF + n * 16); }
            __builtin_amdgcn_sched_barrier(0);
#pragma unroll
            for (int m = 0; m < 4; ++m) { const int rl = ai * HALF + wr * 64 + m * 16 + fr; float s = 0.f;
#pragma unroll
                for (int bj = 0; bj < 2; ++bj)
#pragma unroll
                    for (int n = 0; n < 2; ++n) { const f32x4 v = acc[ai][bj][m][n] + xv[m][bj][n];
                        acc[ai][bj][m][n] = v; s += (v[0] * v[0] + v[1] * v[1]) + (v[2] * v[2] + v[3] * v[3]); }
                s = xrows_add(s);
                if (fq == 0) P[rl * 4 + wc] = s; }
            __builtin_amdgcn_sched_barrier(0);
        }
        asm volatile("s_waitcnt lgkmcnt(0)" ::: "memory"); __builtin_amdgcn_s_barrier(); asm volatile("" ::: "memory");
        const int tid = wid * 64 + lane;
        if (tid < 256) { const float t = (P[tid * 4 + 0] + P[tid * 4 + 1]) + (P[tid * 4 + 2] + P[tid * 4 + 3]); PS[(size_t)(u.pm * BM + tid) * 8 + u.pn] = t; }
        if (prb && threadIdx.x == 0) atomicAdd(prb, (unsigned)(__builtin_amdgcn_s_memrealtime() - t0));
        bar();
        if (tid < 256) { const float* ps = PS + (size_t)(u.pm * BM + tid) * 8; const f32x4 p0 = *(const f32x4*)ps, p1 = *(const f32x4*)(ps + 4);
            const float ss = ((p0[0] + p0[1]) + (p0[2] + p0[3])) + ((p1[0] + p1[1]) + (p1[2] + p1[3]));
            R[tid] = 1.0f / sqrtf(ss * (1.f / DM) + RMS_EPS); }
        asm volatile("s_waitcnt lgkmcnt(0)" ::: "memory"); __builtin_amdgcn_s_barrier(); asm volatile("" ::: "memory");
        f32x4 gv[2][2];
#pragma unroll
        for (int bj = 0; bj < 2; ++bj)
#pragma unroll
            for (int n = 0; n < 2; ++n) gv[bj][n] = *(const f32x4*)(gf + col0 + bj * HALF + n * 16);
#pragma unroll
        for (int ai = 0; ai < 2; ++ai)
#pragma unroll
            for (int m = 0; m < 4; ++m) { const int rl = ai * HALF + wr * 64 + m * 16 + fr; const size_t off = (size_t)(u.pm * BM + rl) * DM + col0; const float rs = R[rl];
#pragma unroll
                for (int bj = 0; bj < 2; ++bj)
#pragma unroll
                    for (int n = 0; n < 2; ++n) *(f32x4*)(out + off + bj * HALF + n * 16) = acc[ai][bj][m][n] * rs * gv[bj][n]; }
    }
};
}

constexpr int RING_OFF = 0, RING_BYTES = 131072;
constexpr int LDSCTL_OFF = RING_BYTES, MISC_OFF = LDSCTL_OFF + 320;
constexpr int LDS_BYTES = 147456;

#define XB_TMO      128
#define XB_XCNT(j)  (256  + 64 * (j))
#define XB_XSUB(j)  (1280 + 64 * (j))
#define XB_XGEN(j)  (2304 + 64 * (j))
#define XB_TOP      3328
#define XB_TOPGEN   3392
#define XCD_BAR_WORDS 3456
#define XB_SPIN_CAP (1u << 18)
__device__ __forceinline__ unsigned xb_ld(unsigned* p)              { return __hip_atomic_load(p, __ATOMIC_RELAXED, __HIP_MEMORY_SCOPE_AGENT); }
__device__ __forceinline__ unsigned xb_add(unsigned* p, unsigned v) { return __hip_atomic_fetch_add(p, v, __ATOMIC_RELAXED, __HIP_MEMORY_SCOPE_AGENT); }
__device__ __forceinline__ unsigned xb_xcc_id() { return (unsigned)__builtin_amdgcn_s_getreg((3 << 11) | 20) & 0xFu; }
#define XB_SPIN(cond, bar) do { unsigned _sp = 0; while (cond) { __builtin_amdgcn_s_sleep(1); \
    if ((++_sp & 255u) == 0u) { if (xb_ld(&(bar)[XB_TMO])) break; if (_sp > XB_SPIN_CAP) { atomicAdd(&(bar)[XB_TMO], 1u); break; } } } } while (0)
struct XcdBarrier { unsigned* bar; unsigned x; volatile LAS unsigned* st; };
__device__ __forceinline__ XcdBarrier xcd_barrier_post(unsigned* bar, volatile LAS unsigned* st) {
    XcdBarrier b; b.bar = bar; b.x = xb_xcc_id(); b.st = st;
    if (threadIdx.x == 0) (void)xb_add(&bar[XB_XCNT(b.x)], 1u);
    return b;
}
__device__ __forceinline__ void xcd_barrier_complete(unsigned* bar, unsigned x, unsigned& nloc, unsigned& nx) {
    const unsigned G = gridDim.x * gridDim.y * gridDim.z;
    unsigned sum, cnt, mine, sp = 0u;
    for (;;) {
        sum = 0u; cnt = 0u; mine = 0u;
#pragma unroll
        for (unsigned j = 0; j < 16; ++j) { const unsigned c = xb_ld(&bar[XB_XCNT(j)]); sum += c; cnt += (c > 0u) ? 1u : 0u; mine = (j == x) ? c : mine; }
        if (sum == G) break;
        __builtin_amdgcn_s_sleep(1);
        if ((++sp & 255u) == 0u) { if (xb_ld(&bar[XB_TMO])) break; if (sp > XB_SPIN_CAP) { atomicAdd(&bar[XB_TMO], 1u); break; } }
    }
    nloc = mine > 0u ? mine : 1u; nx = cnt > 0u ? cnt : 1u;
}
__device__ __forceinline__ void xcd_barrier(const XcdBarrier& b) {
    asm volatile("s_waitcnt vmcnt(0)" ::: "memory");
    __syncthreads();
    if (threadIdx.x == 0) {
        unsigned* bar = b.bar;
        __builtin_amdgcn_s_waitcnt(0);
        unsigned nloc = b.st[0], nx = b.st[1];
        if (nloc == 0u) { xcd_barrier_complete(bar, b.x, nloc, nx); b.st[0] = nloc; b.st[1] = nx; }
        const unsigned old = xb_add(&bar[XB_XSUB(b.x)], 1u);
        const unsigned gen = old / nloc;
        if (old + 1u == (gen + 1u) * nloc) {
            __builtin_amdgcn_fence(__ATOMIC_RELEASE, "agent");
            asm volatile("s_waitcnt vmcnt(0)" ::: "memory");
            const unsigned og = xb_add(&bar[XB_TOP], 1u);
            const unsigned tg = og / nx;
            if (og + 1u == (tg + 1u) * nx) xb_add(&bar[XB_TOPGEN], 1u);
            else XB_SPIN(xb_ld(&bar[XB_TOPGEN]) == tg, bar);
            __builtin_amdgcn_fence(__ATOMIC_ACQUIRE, "agent");
            xb_add(&bar[XB_XGEN(b.x)], 1u);
            asm volatile("s_waitcnt vmcnt(0)" ::: "memory");
        } else {
            XB_SPIN(xb_ld(&bar[XB_XGEN(b.x)]) == gen, bar);
            __builtin_amdgcn_fence(__ATOMIC_ACQUIRE, "agent");
            asm volatile("s_waitcnt vmcnt(0)" ::: "memory");
        }
    }
    __syncthreads();
}

#ifndef PROBE_ID
#define PROBE_ID -1
#endif
constexpr int CW_PROBE = 2048;
#ifndef PROBE_QUANT
#define PROBE_QUANT 1u
#endif
#define PRB_Q(x) (((x) / PROBE_QUANT) * PROBE_QUANT)
#define PRB_T() (PROBE_ID >= 0 ? __builtin_amdgcn_s_memrealtime() : 0ull)
#define PRB_ADD(k, t0) do { if (PROBE_ID >= 0 && threadIdx.x == 0) atomicAdd((unsigned*)(((gu32*)(F.ws + WS_CTL)) + CW_PROBE + (k)), (unsigned)(__builtin_amdgcn_s_memrealtime() - (t0))); } while (0)
struct Args { const void* in[16]; float* out; unsigned char* ws; int ph_lo, ph_hi, li, pad; };
#define WSB(off) ((bf16*)(F.ws + (off)))
#define WSF(off) ((float*)(F.ws + (off)))
struct In { const float *xp, *xs, *ck, *cv, *cki, *gin, *win, *wpa, *wpb, *wo, *lng, *lnb, *wsp, *bsp, *gf; const int* pt; };
struct Ctx {
    LAS unsigned char* lds; int tid, lane, wave, G, bid;
    float* out; unsigned char* ws;
};

__device__ __forceinline__ unsigned f2bf(float f) { unsigned u = __builtin_bit_cast(unsigned, f); return (u + 0x7fffu + ((u >> 16) & 1u)) >> 16; }
__device__ __forceinline__ unsigned pk2(float lo, float hi) { return f2bf(lo) | (f2bf(hi) << 16); }
__device__ __forceinline__ void p0_transpose_item(const float* W, int K, int Nsrc, bf16* WT, bool remap, int kb, int nb, int lane) {
    const int k0 = 64 * kb, nd = 64 * nb + lane; int ns = nd; bool ok = true;
    if (remap) { if (nd >= 3840) ns = nd - 112; else if (nd >= 3728) { ok = false; ns = 0; } }
    const float* src = W + (size_t)k0 * Nsrc + ns;
    float v[64];
#pragma unroll
    for (int i = 0; i < 64; ++i) v[i] = __builtin_nontemporal_load(&src[(size_t)i * Nsrc]);
    v4u* dst = (v4u*)(WT + (size_t)nd * K + k0);
#pragma unroll
    for (int j = 0; j < 8; ++j) { v4u o; o.x = cvtpk(v[8 * j], v[8 * j + 1]); o.y = cvtpk(v[8 * j + 2], v[8 * j + 3]); o.z = cvtpk(v[8 * j + 4], v[8 * j + 5]); o.w = cvtpk(v[8 * j + 6], v[8 * j + 7]);
        if (!ok) o = (v4u){0u, 0u, 0u, 0u};
        dst[j] = o; }
}
__device__ __forceinline__ void rms_row_to_bf16(const float* xrow, const float* g, bf16* orow, int lane) {
    const f32x4* xr = (const f32x4*)xrow + lane; const f32x4* gr = (const f32x4*)g + lane;
    f32x4 v[8]; float s = 0.f;
#pragma unroll
    for (int j = 0; j < 8; ++j) { v[j] = __builtin_nontemporal_load(&xr[64 * j]); s += (v[j].x * v[j].x + v[j].y * v[j].y) + (v[j].z * v[j].z + v[j].w * v[j].w); }
    const float rstd = 1.0f / sqrtf(wave_sum(s) * (1.f / DM) + RMS_EPS);
    v2u* o8 = (v2u*)orow + lane;
#pragma unroll
    for (int j = 0; j < 8; ++j) { const f32x4 gg = gr[64 * j]; v2u w; w.x = cvtpk(v[j].x * rstd * gg.x, v[j].y * rstd * gg.y); w.y = cvtpk(v[j].z * rstd * gg.z, v[j].w * rstd * gg.w); o8[64 * j] = w; }
}
__device__ __forceinline__ void p0_prologue(Ctx& F, const In& I) {
    int lane = F.lane; asm volatile("" : "+v"(lane));
    const int gw = F.bid * 8 + F.wave, NGW = F.G * 8;
    constexpr int NB_IN = LDH / 64, I_IN = (DM / 64) * NB_IN;
    constexpr int I_A = (1024 / 64) * (DM / 64), I_O = (DM / 64) * (DM / 64);
    constexpr int NITEMS = I_IN + 2 * I_A + I_O;
#pragma unroll 1
    for (int it = gw; it < I_IN; it += NGW) p0_transpose_item(I.win, DM, IN_WIDTH, WSB(WS_WTIN), true, it / NB_IN, it % NB_IN, lane);
    for (int m = gw; m < MP + NS; m += NGW) {
        if (m < MP) rms_row_to_bf16(I.xp + (size_t)m * DM, I.gin, WSB(WS_XN) + (size_t)m * DM, lane);
        else rms_row_to_bf16(I.xs + (size_t)(m - MP) * DM, I.gin, WSB(WS_XNS) + (size_t)(m - MP) * DM, lane);
    }
}

__device__ __forceinline__ void p2_wt_item(Ctx& F, const In& I, int item) {
    int lane = F.lane; asm volatile("" : "+v"(lane));
    constexpr int I_A = (1024 / 64) * (DM / 64);
    int r = item * 8 + F.wave;
    if (r < I_A) p0_transpose_item(I.wpa, 1024, DM, WSB(WS_WTA), false, r / (DM / 64), r % (DM / 64), lane);
    else if (r < 2 * I_A) { r -= I_A; p0_transpose_item(I.wpb, 1024, DM, WSB(WS_WTB), false, r / (DM / 64), r % (DM / 64), lane); }
    else { r -= 2 * I_A; p0_transpose_item(I.wo, DM, DM, WSB(WS_WTO), false, r / (DM / 64), r % (DM / 64), lane); }
}

template <int NSTEPS>
__device__ __forceinline__ f32x4 sgemv_part_t(const bf16* X, int ldx, const bf16* Wt, int ldw, int n0, int kbeg, int lane) {
    const int r = lane & 15, q = lane >> 4;
    const bf16* xp = X + (size_t)(r & 7) * ldx + kbeg + 8 * q; const bf16* wp = Wt + (size_t)(n0 + r) * ldw + kbeg + 8 * q;
    const bf16x8 z = {0, 0, 0, 0, 0, 0, 0, 0};
    bf16x8 a[NSTEPS], b[NSTEPS];
#pragma unroll
    for (int st = 0; st < NSTEPS; ++st) { a[st] = *(const bf16x8*)(xp + 32 * st); b[st] = *(const bf16x8*)(wp + 32 * st); }
    __builtin_amdgcn_sched_barrier(0);
    f32x4 acc = {0.f, 0.f, 0.f, 0.f};
#pragma unroll
    for (int st = 0; st < NSTEPS; ++st) acc = __builtin_amdgcn_mfma_f32_16x16x32_bf16(r >= 8 ? z : a[st], b[st], acc, 0, 0, 0);
    return acc;
}
__device__ __forceinline__ f32x4 sgemv_part(const bf16* X, int ldx, const bf16* Wt, int ldw, int n0, int kbeg, int nsteps, int lane) {
    return nsteps == 8 ? sgemv_part_t<8>(X, ldx, Wt, ldw, n0, kbeg, lane) : sgemv_part_t<4>(X, ldx, Wt, ldw, n0, kbeg, lane);
}
__device__ __forceinline__ f32x4 block_reduce8(f32x4 v, LAS float* red, int wave, int lane) {
    *(LAS f32x4*)(red + (wave * 64 + lane) * 4) = v;
    __syncthreads();
    f32x4 s = {0.f, 0.f, 0.f, 0.f};
    if (wave == 0) {
#pragma unroll
        for (int w = 0; w < 8; ++w) s += *(LAS f32x4*)(red + (w * 64 + lane) * 4);
    }
    __syncthreads();
    return s;
}
__device__ __forceinline__ void finish_sample_col(Ctx& F, int s, int n, float v) {
    float h = v;
    if (n < HC_K) h = v * QSCALE;
    else if (n < HC_V) F.out[O_KS + s * 256 + (n - HC_K)] = v;
    else if (n < HC_QI) F.out[O_VS + s * 256 + (n - HC_V)] = v;
    else if (n < HC_WI) {}
    else if (n < HC_KI) h = v * WSCALE;
    else if (n < 3728) F.out[O_KIS + s * 128 + (n - HC_KI)] = v;
    else if (n < HC_ZA) h = 0.f;
    else if (n < HC_U) h = silu_(v);
    else if (n < HC_ZB) h = 0.5f * v * (1.0f + erff(v * 0.70710678118654752f));
    else if (n < HC_GA) h = silu_(v);
    else h = sigmoid_(v);
    WSF(WS_HS)[(size_t)s * LDH + n] = h;
}
__device__ __forceinline__ void p1_sample_inproj(Ctx& F) {
    LAS float* red = (LAS float*)(F.lds + RING_OFF);
    int lane = F.lane; asm volatile("" : "+v"(lane));
    const int r = lane & 15, q = lane >> 4, kbeg = F.wave * 256;
    const bf16x8 z = {0, 0, 0, 0, 0, 0, 0, 0};
    for (int it0 = F.bid; it0 < LDH / 16; it0 += 3 * F.G) {
        const bf16* xp = WSB(WS_XNS) + (size_t)(r & 7) * DM + kbeg + 8 * q;
        bf16x8 a[8], b[3][8];
#pragma unroll
        for (int st = 0; st < 8; ++st) a[st] = *(const bf16x8*)(xp + 32 * st);
#pragma unroll
        for (int i = 0; i < 3; ++i) { const int it = min(it0 + i * F.G, LDH / 16 - 1); const bf16* wp = WSB(WS_WTIN) + (size_t)(16 * it + r) * DM + kbeg + 8 * q;
#pragma unroll
            for (int st = 0; st < 8; ++st) b[i][st] = *(const bf16x8*)(wp + 32 * st); }
        __builtin_amdgcn_sched_barrier(0);
#pragma unroll
        for (int i = 0; i < 3; ++i) { f32x4 acc = {0.f, 0.f, 0.f, 0.f};
#pragma unroll
            for (int st = 0; st < 8; ++st) acc = __builtin_amdgcn_mfma_f32_16x16x32_bf16(r >= 8 ? z : a[st], b[i][st], acc, 0, 0, 0);
            *(LAS f32x4*)(red + ((i * 8 + F.wave) * 64 + lane) * 4) = acc; }
        __syncthreads();
        if (F.wave < 3 && it0 + F.wave * F.G < LDH / 16) {
            f32x4 sacc = {0.f, 0.f, 0.f, 0.f};
#pragma unroll
            for (int w = 0; w < 8; ++w) sacc += *(LAS f32x4*)(red + ((F.wave * 8 + w) * 64 + lane) * 4);
            const int n0 = 16 * (it0 + F.wave * F.G);
            if (lane < 32) {
#pragma unroll
                for (int j = 0; j < 4; ++j) finish_sample_col(F, 4 * (lane >> 4) + j, n0 + (lane & 15), sacc[j]);
            }
        }
        __syncthreads();
    }
}

__device__ __forceinline__ int wave_excl_scan(int v, int lane) {
    int x = v;
    x += dppi<0x111>(x); x += dppi<0x112>(x); x += dppi<0x114>(x); x += dppi<0x118>(x);
    const int t0 = __builtin_amdgcn_readlane(x, 15), t1 = __builtin_amdgcn_readlane(x, 31), t2 = __builtin_amdgcn_readlane(x, 47);
    x += (lane >= 16 ? t0 : 0) + (lane >= 32 ? t1 : 0) + (lane >= 48 ? t2 : 0);
    return x - v;
}
__device__ __forceinline__ void hist_find(const LAS unsigned* hist, int lane, int need, int& bin, int& above, int& cnt) {
    const v4u h0 = *(const LAS v4u*)(hist + 504 - 8 * lane), h1 = *(const LAS v4u*)(hist + 508 - 8 * lane);
    const int a[8] = {(int)h1.w, (int)h1.z, (int)h1.y, (int)h1.x, (int)h0.w, (int)h0.z, (int)h0.y, (int)h0.x};
    const int tot = ((a[0] + a[1]) + (a[2] + a[3])) + ((a[4] + a[5]) + (a[6] + a[7]));
    const int ex = wave_excl_scan(tot, lane);
    const unsigned long long m = __ballot(ex + tot >= need);
    const int L = m ? (int)__builtin_ctzll(m) : 63;
    int acc = ex, fb = 0, fa = 0, fc = 0; bool done = false;
#pragma unroll
    for (int j = 0; j < 8; ++j) { const bool hit = !done && (acc + a[j] >= need); if (hit) { fb = 511 - 8 * lane - j; fa = acc; fc = a[j]; done = true; } acc += a[j]; }
    bin = __builtin_amdgcn_readlane(fb, L); above = __builtin_amdgcn_readlane(fa, L); cnt = __builtin_amdgcn_readlane(fc, L);
}
template <int NREG>
__device__ __forceinline__ void wave_select256(const float (&s)[NREG], int n_valid, int lane, LAS unsigned short* list, LAS unsigned* hist) {
    float mx = -INFINITY, mn = INFINITY;
#pragma unroll
    for (int i = 0; i < NREG; ++i) { mx = fmaxf(mx, s[i]); mn = fminf(mn, s[i] == -INFINITY ? INFINITY : s[i]); }
    mx = wave_max(mx); mn = wave_min(mn);
    const float scale = (mx > mn) ? 262143.0f / (mx - mn) : 0.f;
    int k[NREG];
#pragma unroll
    for (int i = 0; i < NREG; ++i) { const int q = (int)((s[i] - mn) * scale); k[i] = (s[i] == -INFINITY) ? -1 : (q < 0 ? 0 : (q > 262143 ? 262143 : q)); }
    *(LAS v4u*)(hist + 8 * lane) = (v4u){0u, 0u, 0u, 0u}; *(LAS v4u*)(hist + 8 * lane + 4) = (v4u){0u, 0u, 0u, 0u};
    LDS_WAIT();
#pragma unroll
    for (int i = 0; i < NREG; ++i) __hip_atomic_fetch_add(hist + (k[i] >= 0 ? (k[i] >> 9) : 512 + lane), 1u, __ATOMIC_RELAXED, __HIP_MEMORY_SCOPE_WAVEFRONT);
    LDS_WAIT();
    int b1, ab1, c1; hist_find(hist, lane, 256, b1, ab1, c1);
    LDS_WAIT();
    *(LAS v4u*)(hist + 8 * lane) = (v4u){0u, 0u, 0u, 0u}; *(LAS v4u*)(hist + 8 * lane + 4) = (v4u){0u, 0u, 0u, 0u};
    LDS_WAIT();
#pragma unroll
    for (int i = 0; i < NREG; ++i) __hip_atomic_fetch_add(hist + ((k[i] >> 9) == b1 ? (k[i] & 511) : 512 + lane), 1u, __ATOMIC_RELAXED, __HIP_MEMORY_SCOPE_WAVEFRONT);
    LDS_WAIT();
    int b2, ab2, c2; hist_find(hist, lane, 256 - ab1, b2, ab2, c2);
    const int T = (b1 << 9) | b2; const int need_eq = 256 - ab1 - ab2;
    int cg = 0, ce = 0;
#pragma unroll
    for (int i = 0; i < NREG; ++i) { cg += (k[i] > T) ? 1 : 0; ce += (k[i] == T) ? 1 : 0; }
    const int ex = wave_excl_scan(cg | (ce << 16), lane);
    int pg = ex & 0xffff, re = ex >> 16;
    const int ngt = 256 - need_eq;
    int T2 = T; asm volatile("" : "+s"(T2));
    int sl = lane;
#pragma unroll
    for (int i = 0; i < NREG; ++i) {
        const bool g_ = k[i] > T2, e_ = k[i] == T2;
        const int pos = g_ ? pg : ((e_ && re < need_eq) ? ngt + re : 256 + lane);
        list[pos] = (unsigned short)sl; pg += g_ ? 1 : 0; re += e_ ? 1 : 0;
        sl += 64; asm volatile("" : "+v"(sl));
    }
    LDS_WAIT();
}

struct RowSrc { const unsigned short* Hb; const float* ck; const float* cv; const int* pt; const float* knew; const float* vnew; };
template <bool SAMPLE>
__device__ __forceinline__ void attn_part(const RowSrc& R, int g, const LAS unsigned short* list, int k0, int nstep, int nsel, LAS unsigned char* vst, const bf16x8 (&qf)[4], float& m_out, float& l_out, f32x4 (&o)[8], int lane) {
    const int r16 = lane & 15, q4 = lane >> 4;
    float m = -1e30f, l = 0.f;
#pragma unroll
    for (int db = 0; db < 8; ++db) o[db] = (f32x4){0.f, 0.f, 0.f, 0.f};
    const LAS unsigned char* vb = vst + (4 * q4 + (r16 >> 2)) * 288 + (r16 & 3) * 8;
#pragma unroll 1
    for (int ks = 0; ks < nstep; ++ks) {
        const int sb = k0 + ks * 32;
        bf16x8 ka[2][4]; v4u vw[8];
#pragma unroll
        for (int grp = 0; grp < 2; ++grp) {
            const int slot = sb + grp * 16 + r16; const int key = list[slot < nsel ? slot : 0];
            if constexpr (!SAMPLE) {
                const unsigned short* kp = R.Hb + (size_t)key * LDH + HC_K + g * 128 + 8 * q4;
#pragma unroll
                for (int st = 0; st < 4; ++st) ka[grp][st] = *(const bf16x8*)(kp + 32 * st);
            } else {
                const float* kp = (key < PAST) ? R.ck + ((size_t)(R.pt[key >> 7] * PAGE + (key & 127)) * 2 + g) * 128 : R.knew + g * 128;
                kp += 8 * q4;
#pragma unroll
                for (int st = 0; st < 4; ++st) ka[grp][st] = cvt8(*(const f32x4*)(kp + 32 * st), *(const f32x4*)(kp + 32 * st + 4));
            }
        }
#pragma unroll
        for (int i = 0; i < 8; ++i) {
            const int slot = sb + 4 * i + q4; const int key = list[slot < nsel ? slot : 0];
            if constexpr (!SAMPLE) vw[i] = *(const v4u*)(R.Hb + (size_t)key * LDH + HC_V + g * 128 + r16 * 8);
            else { const float* vp = (key < PAST) ? R.cv + ((size_t)(R.pt[key >> 7] * PAGE + (key & 127)) * 2 + g) * 128 : R.vnew + g * 128;
                   vw[i] = __builtin_bit_cast(v4u, cvt8(*(const f32x4*)(vp + r16 * 8), *(const f32x4*)(vp + r16 * 8 + 4))); }
        }
        f32x4 c[2];
#pragma unroll
        for (int grp = 0; grp < 2; ++grp) {
            c[grp] = (f32x4){0.f, 0.f, 0.f, 0.f};
#pragma unroll
            for (int st = 0; st < 4; ++st) c[grp] = __builtin_amdgcn_mfma_f32_16x16x32_bf16(ka[grp][st], qf[st], c[grp], 0, 0, 0);
#pragma unroll
            for (int r = 0; r < 4; ++r) { const int sl = sb + grp * 16 + 4 * q4 + r; c[grp][r] = sl < nsel ? c[grp][r] : -1e30f; }
        }
        float ml = fmaxf(fmaxf(fmaxf(c[0][0], c[0][1]), fmaxf(c[0][2], c[0][3])), fmaxf(fmaxf(c[1][0], c[1][1]), fmaxf(c[1][2], c[1][3])));
        ml = xrows_max(ml);
        const float mn = fmaxf(m, ml), f = __builtin_amdgcn_exp2f(m - mn);
        m = mn; l *= f;
#pragma unroll
        for (int db = 0; db < 8; ++db) o[db] = o[db] * f;
#pragma unroll
        for (int grp = 0; grp < 2; ++grp)
#pragma unroll
            for (int r = 0; r < 4; ++r) { const float p = __builtin_amdgcn_exp2f(c[grp][r] - m); c[grp][r] = p; l += p; }
        v4u pw; pw.x = cvtpk(c[0][0], c[0][1]); pw.y = cvtpk(c[0][2], c[0][3]); pw.z = cvtpk(c[1][0], c[1][1]); pw.w = cvtpk(c[1][2], c[1][3]);
        const bf16x8 pf = __builtin_bit_cast(bf16x8, pw);
#pragma unroll
        for (int i = 0; i < 8; ++i) *(LAS v4u*)(vst + (4 * i + q4) * 288 + r16 * 16) = vw[i];
        LDS_WAIT();
#pragma unroll
        for (int db = 0; db < 8; ++db) {
            const s16x4 lo = __builtin_bit_cast(s16x4, __builtin_amdgcn_ds_read_tr16_b64_v4i16((LAS s16x4*)(vb + db * 32)));
            const s16x4 hi = __builtin_bit_cast(s16x4, __builtin_amdgcn_ds_read_tr16_b64_v4i16((LAS s16x4*)(vb + 16 * 288 + db * 32)));
            const bf16x8 vf = {lo[0], lo[1], lo[2], lo[3], hi[0], hi[1], hi[2], hi[3]};
            o[db] = __builtin_amdgcn_mfma_f32_16x16x32_bf16(vf, pf, o[db], 0, 0, 0);
        }
        LDS_WAIT();
    }
    l = xrows_add(l);
    m_out = m; l_out = l;
}

#if ATT_FP8
typedef v4u kfrag_t[2][2];
typedef v4u vfrag_t[4];
#define AT_NV 4
__device__ __forceinline__ void cvt16_fp8(const v4u w, bf16x8& lo, bf16x8& hi) {
    unsigned r[8];
#pragma unroll
    for (int j = 0; j < 4; ++j) { const f32x2 a = __builtin_amdgcn_cvt_pk_f32_fp8((int)w[j], false), b = __builtin_amdgcn_cvt_pk_f32_fp8((int)w[j], true); r[2 * j] = cvtpk(a.x, a.y); r[2 * j + 1] = cvtpk(b.x, b.y); }
    lo = __builtin_bit_cast(bf16x8, (v4u){r[0], r[1], r[2], r[3]}); hi = __builtin_bit_cast(bf16x8, (v4u){r[4], r[5], r[6], r[7]});
}
typedef long qfrag_t;
#else
typedef bf16x8 kfrag_t[2][4];
typedef v4u vfrag_t[8];
typedef bf16x8 qfrag_t;
#define AT_NV 8
#endif
__device__ __forceinline__ void at_qfrags(const unsigned short* qrow, int r16, int q4, qfrag_t (&qf)[4]) {
    v4u w[4];
#pragma unroll
    for (int st = 0; st < 4; ++st) w[st] = *(const v4u*)(qrow + (ATT_FP8 ? 64 * (st >> 1) + 16 * q4 + 8 * (st & 1) : 32 * st + 8 * q4));
    __builtin_amdgcn_sched_barrier(0);
#pragma unroll
    for (int st = 0; st < 4; ++st) {
#if ATT_FP8
        const float is = 1.0f / QSCALE; int lo = 0, hi = 0;
        lo = __builtin_amdgcn_cvt_pk_fp8_f32(bflo(w[st].x) * is, bfhi(w[st].x) * is, lo, false); lo = __builtin_amdgcn_cvt_pk_fp8_f32(bflo(w[st].y) * is, bfhi(w[st].y) * is, lo, true);
        hi = __builtin_amdgcn_cvt_pk_fp8_f32(bflo(w[st].z) * is, bfhi(w[st].z) * is, hi, false); hi = __builtin_amdgcn_cvt_pk_fp8_f32(bflo(w[st].w) * is, bfhi(w[st].w) * is, hi, true);
        const long v = (long)(((unsigned long long)(unsigned)hi << 32) | (unsigned long long)(unsigned)lo);
        qf[st] = r16 < 4 ? v : 0l;
#else
        const bf16x8 z = {0, 0, 0, 0, 0, 0, 0, 0};
        qf[st] = r16 < 4 ? __builtin_bit_cast(bf16x8, w[st]) : z;
#endif
    }
}
template <bool FULL>
__device__ __forceinline__ void at_load(const unsigned short* Hb, const unsigned char* KVb, const LAS unsigned short* list, int nsel, int step, int lane, kfrag_t& ka, vfrag_t& vw) {
    const int g = step >> 3, sb = (step & 7) * 32, r16 = lane & 15, q4 = lane >> 4;
#pragma unroll
    for (int grp = 0; grp < 2; ++grp) {
        const int slot = sb + grp * 16 + r16; const int key = list[(FULL || slot < nsel) ? slot : 0];
#if ATT_FP8
        const unsigned char* kp = KVb + (size_t)key * 512 + g * 128 + 16 * q4;
        ka[grp][0] = *(const v4u*)kp; ka[grp][1] = *(const v4u*)(kp + 64);
#else
        const unsigned short* kp = Hb + (size_t)key * LDH + HC_K + g * 128 + 8 * q4;
#pragma unroll
        for (int st = 0; st < 4; ++st) ka[grp][st] = *(const bf16x8*)(kp + 32 * st);
#endif
    }
#if ATT_FP8
#pragma unroll
    for (int i = 0; i < 4; ++i) { const int slot = sb + 8 * i + (lane >> 3); const int key = list[(FULL || slot < nsel) ? slot : 0];
        vw[i] = *(const v4u*)(KVb + (size_t)key * 512 + 256 + g * 128 + (lane & 7) * 16); }
#else
#pragma unroll
    for (int i = 0; i < 8; ++i) { const int slot = sb + 4 * i + q4; const int key = list[(FULL || slot < nsel) ? slot : 0];
        vw[i] = *(const v4u*)(Hb + (size_t)key * LDH + HC_V + g * 128 + r16 * 8); }
#endif
}
template <bool FULL>
__device__ __forceinline__ void at_comp(const kfrag_t& ka, const vfrag_t& vw, const qfrag_t (&qf)[4], int step, int nsel, int lane, LAS unsigned char* vst, const LAS unsigned char* vb, float& m, float& l, f32x4 (&o)[8]) {
    const int sb = (step & 7) * 32, r16 = lane & 15, q4 = lane >> 4;
    f32x4 c[2];
#pragma unroll
    for (int grp = 0; grp < 2; ++grp) {
        c[grp] = (f32x4){0.f, 0.f, 0.f, 0.f};
#if ATT_FP8
#pragma unroll
        for (int j = 0; j < 2; ++j) { const v4u w = ka[grp][j];
            const long a0 = (long)(((unsigned long long)w.y << 32) | w.x), a1 = (long)(((unsigned long long)w.w << 32) | w.z);
            c[grp] = __builtin_amdgcn_mfma_f32_16x16x32_fp8_fp8(a0, qf[2 * j], c[grp], 0, 0, 0); c[grp] = __builtin_amdgcn_mfma_f32_16x16x32_fp8_fp8(a1, qf[2 * j + 1], c[grp], 0, 0, 0); }
        c[grp] = c[grp] * QSCALE;
#else
#pragma unroll
        for (int st = 0; st < 4; ++st) c[grp] = __builtin_amdgcn_mfma_f32_16x16x32_bf16(ka[grp][st], qf[st], c[grp], 0, 0, 0);
#endif
        if (!FULL)
#pragma unroll
        for (int r = 0; r < 4; ++r) { const int sl = sb + grp * 16 + 4 * q4 + r; c[grp][r] = sl < nsel ? c[grp][r] : -1e30f; }
    }
    float ml = fmaxf(fmaxf(fmaxf(c[0][0], c[0][1]), fmaxf(c[0][2], c[0][3])), fmaxf(fmaxf(c[1][0], c[1][1]), fmaxf(c[1][2], c[1][3])));
    ml = xrows_max(ml);
    if (__ballot(ml > m)) {
        const float mn = fmaxf(m, ml), f = __builtin_amdgcn_exp2f(m - mn);
        m = mn; l *= f;
#pragma unroll
        for (int db = 0; db < 8; ++db) o[db] = o[db] * f;
    }
#pragma unroll
    for (int grp = 0; grp < 2; ++grp)
#pragma unroll
        for (int r = 0; r < 4; ++r) { const float p = __builtin_amdgcn_exp2f(c[grp][r] - m); c[grp][r] = p; l += p; }
    v4u pw; pw.x = cvtpk(c[0][0], c[0][1]); pw.y = cvtpk(c[0][2], c[0][3]); pw.z = cvtpk(c[1][0], c[1][1]); pw.w = cvtpk(c[1][2], c[1][3]);
    const bf16x8 pf = __builtin_bit_cast(bf16x8, pw);
#if ATT_FP8
#pragma unroll
    for (int i = 0; i < 4; ++i) { const int srow = 8 * i + (lane >> 3); const int lrow = 8 * ((srow >> 2) & 3) + 4 * (srow >> 4) + (srow & 3);
        *(LAS v4u*)(vst + lrow * 144 + (lane & 7) * 16) = vw[i]; }
#else
#pragma unroll
    for (int i = 0; i < 8; ++i) *(LAS v4u*)(vst + (4 * i + q4) * 288 + r16 * 16) = vw[i];
#endif
    LDS_WAIT();
#if ATT_FP8
    {
        int p0 = 0, p1 = 0;
        p0 = __builtin_amdgcn_cvt_pk_fp8_f32(c[0][0], c[0][1], p0, false); p0 = __builtin_amdgcn_cvt_pk_fp8_f32(c[0][2], c[0][3], p0, true);
        p1 = __builtin_amdgcn_cvt_pk_fp8_f32(c[1][0], c[1][1], p1, false); p1 = __builtin_amdgcn_cvt_pk_fp8_f32(c[1][2], c[1][3], p1, true);
        const long pf8 = (long)(((unsigned long long)(unsigned)p1 << 32) | (unsigned long long)(unsigned)p0);
        const LAS unsigned char* vb8 = vst + (8 * q4 + (r16 >> 1)) * 144 + (r16 & 1) * 8;
#pragma unroll
        for (int db = 0; db < 8; ++db) {
            const v2i_t t = __builtin_amdgcn_ds_read_tr8_b64_v2i32((LAS v2i_t*)(vb8 + db * 16));
            const long vf8 = (long)(((unsigned long long)(unsigned)t[1] << 32) | (unsigned long long)(unsigned)t[0]);
            o[db] = __builtin_amdgcn_mfma_f32_16x16x32_fp8_fp8(vf8, pf8, o[db], 0, 0, 0);
        }
    }
#else
#pragma unroll
    for (int db = 0; db < 8; ++db) {
        const s16x4 lo = __builtin_bit_cast(s16x4, __builtin_amdgcn_ds_read_tr16_b64_v4i16((LAS s16x4*)(vb + db * 32)));
        const s16x4 hi = __builtin_bit_cast(s16x4, __builtin_amdgcn_ds_read_tr16_b64_v4i16((LAS s16x4*)(vb + 16 * 288 + db * 32)));
        const bf16x8 vf = {lo[0], lo[1], lo[2], lo[3], hi[0], hi[1], hi[2], hi[3]};
        o[db] = __builtin_amdgcn_mfma_f32_16x16x32_bf16(vf, pf, o[db], 0, 0, 0);
    }
#endif
    LDS_WAIT();
}
template <bool FULL>
__device__ __forceinline__ void attn_prompt_query(const unsigned short* Hb, const unsigned char* KVb, int t, bf16* orow, const LAS unsigned short* list, int nsel, LAS unsigned char* vst, int lane) {
    const int r16 = lane & 15, q4 = lane >> 4;
    const LAS unsigned char* vb = vst + (4 * q4 + (r16 >> 2)) * 288 + (r16 & 3) * 8;
    kfrag_t kaA, kaB; vfrag_t vwA, vwB; qfrag_t qf[4];
    float m = -1e30f, l = 0.f; f32x4 o[8];
#pragma unroll
    for (int db = 0; db < 8; ++db) o[db] = (f32x4){0.f, 0.f, 0.f, 0.f};
    { const unsigned short* qp = Hb + (size_t)t * LDH + HC_Q + (r16 & 3) * 128;
      at_qfrags(qp, r16, q4, qf); }
    kfrag_t kaC; vfrag_t vwC;
#define AT_FINAL(g) do { v2u zz_[8]; const unsigned short* zp_ = Hb + (size_t)t * LDH + HC_ZA + ((g) * 4 + (r16 & 3)) * 128 + 4 * q4; \
        _Pragma("unroll") for (int db = 0; db < 8; ++db) zz_[db] = *(const v2u*)(zp_ + db * 16);     \
        l = xrows_add(l); \
        __builtin_amdgcn_sched_barrier(0); \
        if (r16 < 4) { const float rl = 1.0f / l; bf16* op = orow + ((g) * 4 + r16) * 128 + 4 * q4; \
            _Pragma("unroll") for (int db = 0; db < 8; ++db) { const v2u zz = zz_[db]; \
                v2u ww; ww.x = cvtpk(o[db][0] * rl * bflo(zz.x), o[db][1] * rl * bfhi(zz.x)); ww.y = cvtpk(o[db][2] * rl * bflo(zz.y), o[db][3] * rl * bfhi(zz.y)); \
                *(v2u*)(op + db * 16) = ww; } } } while (0)
    at_load<FULL>(Hb, KVb, list, nsel, 0, lane, kaA, vwA); at_load<FULL>(Hb, KVb, list, nsel, 1, lane, kaB, vwB);
#pragma unroll 1
    for (int it = 0; it < 5; ++it) {
        at_load<FULL>(Hb, KVb, list, nsel, 3 * it + 2, lane, kaC, vwC);
        at_comp<FULL>(kaA, vwA, qf, 3 * it, nsel, lane, vst, vb, m, l, o);
        at_load<FULL>(Hb, KVb, list, nsel, 3 * it + 3, lane, kaA, vwA);
        at_comp<FULL>(kaB, vwB, qf, 3 * it + 1, nsel, lane, vst, vb, m, l, o);
        if (it == 2) {
            AT_FINAL(0);
            m = -1e30f; l = 0.f;
#pragma unroll
            for (int db = 0; db < 8; ++db) o[db] = (f32x4){0.f, 0.f, 0.f, 0.f};
            const unsigned short* qp = Hb + (size_t)t * LDH + HC_Q + (4 + (r16 & 3)) * 128;
            at_qfrags(qp, r16, q4, qf);
        }
        if (it < 4) at_load<FULL>(Hb, KVb, list, nsel, 3 * it + 4, lane, kaB, vwB);
        at_comp<FULL>(kaC, vwC, qf, 3 * it + 2, nsel, lane, vst, vb, m, l, o);
    }
    at_comp<FULL>(kaA, vwA, qf, 15, nsel, lane, vst, vb, m, l, o);
    AT_FINAL(1);
#undef AT_FINAL
}

__device__ __forceinline__ float relu_i(float x) { const int v = __float_as_int(x); return __int_as_float(v > 0 ? v : 0); }
__device__ __forceinline__ void p2_prompt_item(Ctx& F, int j, int b) {
    const int qb = 255 - j, q0 = qb * 16, rowbase = b * SEQ;
    const int nkeys = q0 + 16, ntile = (nkeys + 63) >> 6;
    int lane = F.lane, w = F.wave, tid = F.tid;
    asm volatile("" : "+v"(lane), "+v"(tid)); asm volatile("" : "+s"(w));
    LAS unsigned char* kbuf = F.lds + RING_OFF;
    LAS unsigned short* list = (LAS unsigned short*)(F.lds + RING_OFF + 32768 + w * 10240);
    LAS unsigned char* vst = F.lds + RING_OFF + 32768 + w * 10240 + 1024;
    float* SCb = WSF(WS_SC) + (size_t)F.bid * (16 * 4096);
    const bf16* Hb = WSB(WS_H) + (size_t)rowbase * LDH;
#ifndef REP_P2
#define REP_P2 0
#endif
    unsigned long long ts_ = PRB_T();
    for (int rp_ = 0; rp_ < 1 + (REP_P2 & 1); ++rp_) {
        const int r = lane & 31, hi = lane >> 5;
#if !IDX_FP8
        const int qg = w & 3, kh = w >> 2;
        float wv[2][16];
#pragma unroll
        for (int s2 = 0; s2 < 2; ++s2) { const f32x4* wp = (const f32x4*)(WSF(WS_WI) + (size_t)(rowbase + q0 + 4 * qg + 2 * s2 + hi) * 16);
#pragma unroll
          for (int j = 0; j < 4; ++j) { const f32x4 t = wp[j]; wv[s2][4 * j] = t[0]; wv[s2][4 * j + 1] = t[1]; wv[s2][4 * j + 2] = t[2]; wv[s2][4 * j + 3] = t[3]; } }
        const int headr = (r & 3) + 4 * (r >> 3);
#else
        float wv[16];
        const int tqr = q0 + 2 * w + ((r >> 2) & 1), headr = (r & 3) + 4 * (r >> 3);
        { const f32x4* wp = (const f32x4*)(WSF(WS_WI) + (size_t)(rowbase + q0 + 2 * w + hi) * 16);
#pragma unroll
          for (int j = 0; j < 4; ++j) { const f32x4 t = wp[j]; wv[4 * j] = t[0]; wv[4 * j + 1] = t[1]; wv[4 * j + 2] = t[2]; wv[4 * j + 3] = t[3]; } }
        const int tql = q0 + 2 * w + hi;
#endif
#if IDX_FP8
        typedef int v8i_t __attribute__((ext_vector_type(8)));
        v8i_t qa[2];
        { const bf16* qsrc = Hb + (size_t)tqr * LDH + HC_QI + headr * 128 + 32 * hi;
#pragma unroll
          for (int sI = 0; sI < 2; ++sI)
#pragma unroll
            for (int c4 = 0; c4 < 4; ++c4) { const v4u wq = *(const v4u*)(qsrc + 64 * sI + 8 * c4);
                int lo = __builtin_amdgcn_cvt_pk_fp8_f32(bflo(wq.x), bfhi(wq.x), 0, false); lo = __builtin_amdgcn_cvt_pk_fp8_f32(bflo(wq.y), bfhi(wq.y), lo, true);
                int hh = __builtin_amdgcn_cvt_pk_fp8_f32(bflo(wq.z), bfhi(wq.z), 0, false); hh = __builtin_amdgcn_cvt_pk_fp8_f32(bflo(wq.w), bfhi(wq.w), hh, true);
                qa[sI][2 * c4] = lo; qa[sI][2 * c4 + 1] = hh; } }
        const unsigned char* K8 = F.ws + WS_KI8 + (size_t)rowbase * 128;
        const int skey = tid >> 3, sch = tid & 7;
        v4u pre = *(const v4u*)(K8 + (size_t)skey * 128 + sch * 16);
        *(LAS v4u*)(kbuf + skey * 128 + ((sch ^ ((skey >> 1) & 7)) * 16)) = pre;
        __syncthreads();
        for (int kt = 0; kt < ntile; ++kt) {
            const bool more = kt + 1 < ntile;
            if (more) pre = *(const v4u*)(K8 + (size_t)(64 * (kt + 1) + skey) * 128 + sch * 16);
            const LAS unsigned char* buf = kbuf + (kt & 1) * 8192;
#pragma unroll
            for (int sub = 0; sub < 2; ++sub) {
                f32x16 c = {};
                const int krow = sub * 32 + r; const LAS unsigned char* kr = buf + krow * 128; const int sw = (krow >> 1) & 7;
#pragma unroll
                for (int sI = 0; sI < 2; ++sI) {
                    const v4u b0 = *(const LAS v4u*)(kr + (((4 * sI + 2 * hi) ^ sw) * 16)), b1 = *(const LAS v4u*)(kr + (((4 * sI + 2 * hi + 1) ^ sw) * 16));
                    const v8i_t kb = {(int)b0.x, (int)b0.y, (int)b0.z, (int)b0.w, (int)b1.x, (int)b1.y, (int)b1.z, (int)b1.w};
                    c = __builtin_amdgcn_mfma_scale_f32_32x32x64_f8f6f4(qa[sI], kb, c, 0, 0, 0, 0x7f7f7f7f, 0, 0x7f7f7f7f);
                }
                float sc = 0.f;
#pragma unroll
                for (int j = 0; j < 16; ++j) sc += wv[j] * fmaxf(c[j], 0.f);
                const int key = 64 * kt + 32 * sub + r;
                __builtin_nontemporal_store(key <= tql ? sc : -INFINITY, &SCb[(2 * w + hi) * 4096 + key]);
            }
            if (more) *(LAS v4u*)(kbuf + ((kt + 1) & 1) * 8192 + skey * 128 + ((sch ^ ((skey >> 1) & 7)) * 16)) = pre;
            __syncthreads();
        }
#else
        bf16x8 qf[2][8];
#pragma unroll
        for (int s2 = 0; s2 < 2; ++s2) { const bf16* qsrc = Hb + (size_t)(q0 + 4 * qg + 2 * s2 + ((r >> 2) & 1)) * LDH + HC_QI + headr * 128 + 8 * hi;
#pragma unroll
          for (int st = 0; st < 8; ++st) qf[s2][st] = *(const bf16x8*)(qsrc + 16 * st); }
        const int ntile2 = (nkeys + 127) >> 7;
        v4u pre[4];
        const int sc_ = tid & 15;
        const bf16* kp[4];
#pragma unroll
        for (int i = 0; i < 4; ++i) kp[i] = Hb + (size_t)((tid + 512 * i) >> 4) * LDH + HC_KI + sc_ * 8;
        unsigned lo_[4];
#pragma unroll
        for (int i = 0; i < 4; ++i) { const int sk = (tid + 512 * i) >> 4; lo_[i] = sk * 256 + ((sc_ ^ (sk & 15)) * 16); }
#pragma unroll
        for (int i = 0; i < 4; ++i) pre[i] = *(const v4u*)(kp[i]);
#pragma unroll
        for (int i = 0; i < 4; ++i) *(LAS v4u*)(kbuf + lo_[i]) = pre[i];
        __syncthreads();
        f32x16 cp = {};
        float* const row0 = SCb + (4 * qg + hi) * 4096 + 64 * kh + r; float* const row1 = row0 + 2 * 4096;
        const int kq0 = q0 + 4 * qg + hi - 64 * kh - r, kq1 = kq0 + 2;
        for (int kt = 0; kt < ntile2; ++kt) {
            const int ktn = min(kt + 1, ntile2 - 1), ktp = max(kt - 1, 0);
#pragma unroll
            for (int i = 0; i < 4; ++i) pre[i] = *(const v4u*)(kp[i] + (size_t)ktn * (128 * LDH));
            const LAS unsigned char* buf = kbuf + (kt & 1) * 32768 + (kh * 64 + r) * 256;
            bf16x8 fr[8];
#pragma unroll
            for (int st = 0; st < 8; ++st) fr[st] = *(const LAS bf16x8*)(buf + (((2 * st + hi) ^ (r & 15)) * 16));
            { float s1 = 0.f;
#pragma unroll
              for (int j = 0; j < 16; ++j) s1 += wv[1][j] * relu_i(cp[j]);
              __builtin_nontemporal_store(128 * ktp + 32 <= kq1 ? s1 : -INFINITY, row1 + 128 * ktp + 32); }
            __builtin_amdgcn_sched_barrier(0);
            f32x16 c0 = {}, c1 = {};
#pragma unroll
            for (int st = 0; st < 8; ++st) c0 = __builtin_amdgcn_mfma_f32_32x32x16_bf16(qf[0][st], fr[st], c0, 0, 0, 0);
            __builtin_amdgcn_sched_barrier(0);
#pragma unroll
            for (int st = 0; st < 8; ++st) c1 = __builtin_amdgcn_mfma_f32_32x32x16_bf16(qf[1][st], fr[st], c1, 0, 0, 0);
            { float s0 = 0.f;
#pragma unroll
              for (int j = 0; j < 16; ++j) s0 += wv[0][j] * relu_i(c0[j]);
#pragma unroll
              for (int g = 0; g < 8; ++g) { __builtin_amdgcn_sched_group_barrier(0x008, 1, 0); __builtin_amdgcn_sched_group_barrier(0x002, 4, 0); }
              __builtin_nontemporal_store(128 * kt <= kq0 ? s0 : -INFINITY, row0 + 128 * kt); }
            __builtin_amdgcn_sched_barrier(0);
#pragma unroll
            for (int st = 0; st < 8; ++st) fr[st] = *(const LAS bf16x8*)(buf + 32 * 256 + (((2 * st + hi) ^ (r & 15)) * 16));
            { float s1 = 0.f;
#pragma unroll
              for (int j = 0; j < 16; ++j) s1 += wv[1][j] * relu_i(c1[j]);
              __builtin_nontemporal_store(128 * kt <= kq1 ? s1 : -INFINITY, row1 + 128 * kt); }
            __builtin_amdgcn_sched_barrier(0);
#pragma unroll
            for (int j = 0; j < 16; ++j) { c0[j] = 0.f; c1[j] = 0.f; }
#pragma unroll
            for (int st = 0; st < 8; ++st) c0 = __builtin_amdgcn_mfma_f32_32x32x16_bf16(qf[0][st], fr[st], c0, 0, 0, 0);
            __builtin_amdgcn_sched_barrier(0);
#pragma unroll
            for (int st = 0; st < 8; ++st) c1 = __builtin_amdgcn_mfma_f32_32x32x16_bf16(qf[1][st], fr[st], c1, 0, 0, 0);
            { float s0 = 0.f;
#pragma unroll
              for (int j = 0; j < 16; ++j) s0 += wv[0][j] * relu_i(c0[j]);
#pragma unroll
              for (int g = 0; g < 8; ++g) { __builtin_amdgcn_sched_group_barrier(0x008, 1, 0); __builtin_amdgcn_sched_group_barrier(0x002, 4, 0); }
              __builtin_nontemporal_store(128 * kt + 32 <= kq0 ? s0 : -INFINITY, row0 + 128 * kt + 32); }
            cp = c1;
            __builtin_amdgcn_sched_barrier(0);
            { LAS unsigned char* nb = kbuf + ((kt + 1) & 1) * 32768;
#pragma unroll
              for (int i = 0; i < 4; ++i) *(LAS v4u*)(nb + lo_[i]) = pre[i]; }
            __syncthreads();
        }
        { float s1 = 0.f;
#pragma unroll
          for (int j = 0; j < 16; ++j) s1 += wv[1][j] * relu_i(cp[j]);
          __builtin_nontemporal_store(128 * (ntile2 - 1) + 32 <= kq1 ? s1 : -INFINITY, row1 + 128 * (ntile2 - 1) + 32); }
#endif
    }
    __syncthreads();
    PRB_ADD(9, ts_);
    static_assert(ATT_FP8 == 1, "the second selection list sits behind the fp8 V staging tile");
    LAS unsigned short* listB = (LAS unsigned short*)(F.lds + RING_OFF + 32768 + w * 10240 + 5632);
    int nsA = 0, nsB = 0;
#pragma unroll 1
    for (int stp = 0; stp < 4; ++stp) {
        ts_ = PRB_T();
        const int isatt = (w & 1) ? (stp >> 1) : (stp & 1), qq = (w & 1) ? (stp & 1) : (stp >> 1);
        LAS unsigned short* lst = qq ? listB : list;
        const int ql = 2 * w + qq, t = q0 + ql, n = t + 1;
        if (!isatt) {
            int nsel;
            if (n <= 256) {
#pragma unroll
                for (int j = 0; j < 4; ++j) lst[lane + 64 * j] = (unsigned short)(lane + 64 * j);
                LDS_WAIT(); nsel = n;
            } else {
#define SEL_W(NR) do { float s[NR]; int ln = lane; asm volatile("" : "+v"(ln));     \
                _Pragma("unroll") for (int i = 0; i < NR; ++i) { const float v = __builtin_nontemporal_load(&SCb[ql * 4096 + i * 64 + lane]); s[i] = (ln <= t - i * 64) ? v : -INFINITY; } \
                asm volatile("s_waitcnt vmcnt(0)" ::: "memory"); \
                if (PROBE_ID >= 0) { PRB_ADD(14, ts_); ts_ = PRB_T(); } \
                wave_select256<NR>(s, n, lane, lst, (LAS unsigned*)vst); } while (0)
                if (n <= 1024) SEL_W(16); else if (n <= 2048) SEL_W(32); else if (n <= 3072) SEL_W(48); else SEL_W(64);
#undef SEL_W
                nsel = 256;
            }
            if (qq) nsB = nsel; else nsA = nsel;
            PRB_ADD(10, ts_);
        } else {
            const int nsel = qq ? nsB : nsA;
            asm volatile("" : "+v"(lane) :: "memory"); __builtin_amdgcn_sched_barrier(0);
            if (nsel == 256) attn_prompt_query<true>(Hb, F.ws + WS_KV8 + (size_t)rowbase * 512, t, WSB(WS_OAB) + (size_t)(rowbase + t) * DM, lst, nsel, vst, lane);
            else attn_prompt_query<false>(Hb, F.ws + WS_KV8 + (size_t)rowbase * 512, t, WSB(WS_OAB) + (size_t)(rowbase + t) * DM, lst, nsel, vst, lane);
            PRB_ADD(11, ts_);
        }
    }
}
__device__ __forceinline__ void p2_gmlp_item(Ctx& F, const In& I, int item) {
    int lane = F.lane, w = F.wave, tid = F.tid; const int c = item >> 3, g = item & 7, r0 = c * 128;
    asm volatile("" : "+v"(lane), "+v"(tid)); asm volatile("" : "+s"(w));
    LAS unsigned char* tile = F.lds + RING_OFF;
    LAS float* smu = (LAS float*)(F.lds + RING_OFF + 36864); LAS float* srs = smu + 128;
    v4u pre[4];
#pragma unroll
    for (int i = 0; i < 4; ++i) { const int p = tid + 512 * i, row = p >> 4, ch = p & 15; pre[i] = *(const v4u*)(WSB(WS_H) + (size_t)(r0 + row) * LDH + HC_VB + g * 128 + ch * 8); }
    if (tid < 128) { const f32x4* ps = (const f32x4*)(WSF(WS_PSV) + (size_t)(r0 + tid) * 32); float s1 = 0.f, s2 = 0.f;
#pragma unroll
        for (int j = 0; j < 8; ++j) { const f32x4 v = ps[j]; s1 += v[0] + v[2]; s2 += v[1] + v[3]; }
        const float mu = s1 * (1.f / 1024.f), var = fmaxf(s2 * (1.f / 1024.f) - mu * mu, 0.f);
        smu[tid] = mu; srs[tid] = 1.0f / sqrtf(var + LN_EPS); }
#pragma unroll
    for (int i = 0; i < 4; ++i) { const int p = tid + 512 * i, row = p >> 4, ch = p & 15; *(LAS v4u*)(tile + row * 288 + ch * 16) = pre[i]; }
    __syncthreads();
    const int i16 = lane & 15, q4 = lane >> 4, t = 16 * w + i16, nks = (w >> 1) + 1;
    const bf16* hrow = WSB(WS_H) + (size_t)(r0 + t) * LDH;
    f32x4 lgv[8], lbv[8]; v2u uuv[8], zzv[8];
#pragma unroll
    for (int db = 0; db < 8; ++db) { const int ch0 = g * 128 + db * 16 + 4 * q4;
        lgv[db] = *(const f32x4*)(I.lng + ch0); lbv[db] = *(const f32x4*)(I.lnb + ch0); uuv[db] = *(const v2u*)(hrow + HC_U + ch0); zzv[db] = *(const v2u*)(hrow + HC_ZB + ch0); }
    const float bt = I.bsp[g * 128 + t];
    f32x4 w0v[4], w1v[4];
#pragma unroll
    for (int ks = 0; ks < 4; ++ks) { const float* wrow = I.wsp + ((size_t)(g * 128 + t) * 128 + 32 * ks + 8 * q4); w0v[ks] = *(const f32x4*)wrow; w1v[ks] = *(const f32x4*)(wrow + 4); }
    __builtin_amdgcn_sched_barrier(0);
    f32x4 acc[8];
#pragma unroll
    for (int db = 0; db < 8; ++db) acc[db] = (f32x4){0.f, 0.f, 0.f, 0.f};
    float c1 = 0.f, c2 = 0.f;
#pragma unroll
    for (int ks = 0; ks < 4; ++ks) if (ks < nks) {
        const int s0 = 32 * ks + 8 * q4;
        const f32x4 w0 = w0v[ks], w1 = w1v[ks];
        float wv[8] = {w0[0], w0[1], w0[2], w0[3], w1[0], w1[1], w1[2], w1[3]};
#pragma unroll
        for (int j = 0; j < 8; ++j) { const int s = s0 + j; const float x = (s <= t) ? wv[j] : 0.f; c2 += x; const float xp = x * srs[s]; c1 += xp * smu[s]; wv[j] = xp; }
        const bf16x8 wf = cvt8((f32x4){wv[0], wv[1], wv[2], wv[3]}, (f32x4){wv[4], wv[5], wv[6], wv[7]});
        const LAS unsigned char* vb = tile + (32 * ks + 8 * q4 + (i16 >> 2)) * 288 + (i16 & 3) * 8;
#pragma unroll
        for (int db = 0; db < 8; ++db) {
            const s16x4 lo = __builtin_bit_cast(s16x4, __builtin_amdgcn_ds_read_tr16_b64_v4i16((LAS s16x4*)(vb + db * 32)));
            const s16x4 hi = __builtin_bit_cast(s16x4, __builtin_amdgcn_ds_read_tr16_b64_v4i16((LAS s16x4*)(vb + 4 * 288 + db * 32)));
            const bf16x8 vf = {lo[0], lo[1], lo[2], lo[3], hi[0], hi[1], hi[2], hi[3]};
            acc[db] = __builtin_amdgcn_mfma_f32_16x16x32_bf16(vf, wf, acc[db], 0, 0, 0);
        }
    }
    c1 = xrows_add(c1); c2 = xrows_add(c2);
    bf16* orow = WSB(WS_OAB) + (size_t)(r0 + t) * DM + 1024;
#pragma unroll
    for (int db = 0; db < 8; ++db) { const int ch0 = g * 128 + db * 16 + 4 * q4;
        const f32x4 lg = lgv[db], lb = lbv[db];
        const v2u uu = uuv[db], zz = zzv[db];
        float mx[4];
#pragma unroll
        for (int r = 0; r < 4; ++r) mx[r] = lg[r] * (acc[db][r] - c1) + lb[r] * c2 + bt;
        v2u ww; ww.x = cvtpk(bflo(uu.x) * mx[0] * bflo(zz.x), bfhi(uu.x) * mx[1] * bfhi(zz.x)); ww.y = cvtpk(bflo(uu.y) * mx[2] * bflo(zz.y), bfhi(uu.y) * mx[3] * bfhi(zz.y));
        *(v2u*)(orow + ch0) = ww; }
}
__device__ __forceinline__ void p2_sscore_item(Ctx& F, const In& I, int item) {
    int lane = F.lane, w = F.wave; asm volatile("" : "+v"(lane)); asm volatile("" : "+s"(w));
    const int s = item >> 4, page = (item & 15) * 8 + w, r16 = lane & 15, q4 = lane >> 4;
    const float* hs = WSF(WS_HS) + (size_t)s * LDH;
    bf16x8 qf[4];
#pragma unroll
    for (int st = 0; st < 4; ++st) { const float* p = hs + HC_QI + r16 * 128 + st * 32 + 8 * q4; qf[st] = cvt8(*(const f32x4*)p, *(const f32x4*)(p + 4)); }
    const f32x4 wv = *(const f32x4*)(hs + HC_WI + 4 * q4);
    const int phys = I.pt[s * NPAGES + page];
    const float* kb = I.cki + (size_t)phys * PAGE * 128;
#pragma unroll 1
    for (int g2 = 0; g2 < 8; g2 += 4) {
        f32x4 x[4][4][2];
#pragma unroll
        for (int u = 0; u < 4; ++u) { const float* kp = kb + (size_t)((g2 + u) * 16 + r16) * 128 + 8 * q4;
#pragma unroll
            for (int st = 0; st < 4; ++st) { x[u][st][0] = __builtin_nontemporal_load((const f32x4*)(kp + 32 * st)); x[u][st][1] = __builtin_nontemporal_load((const f32x4*)(kp + 32 * st + 4)); } }
        __builtin_amdgcn_sched_barrier(0);
#pragma unroll
        for (int u = 0; u < 4; ++u) {
            f32x4 c = {0.f, 0.f, 0.f, 0.f};
#pragma unroll
            for (int st = 0; st < 4; ++st) c = __builtin_amdgcn_mfma_f32_16x16x32_bf16(qf[st], cvt8(x[u][st][0], x[u][st][1]), c, 0, 0, 0);
            float v = wv[0] * fmaxf(c[0], 0.f) + wv[1] * fmaxf(c[1], 0.f) + wv[2] * fmaxf(c[2], 0.f) + wv[3] * fmaxf(c[3], 0.f);
            v = xrows_add(v);
            if (lane < 16) __hip_atomic_store(WSF(WS_SSC) + (size_t)s * SSC_LD + page * 128 + (g2 + u) * 16 + lane, v, __ATOMIC_RELAXED, __HIP_MEMORY_SCOPE_AGENT);
        }
    }
}

__device__ __forceinline__ void p3_sample_item(Ctx& F, const In& I, int s) {
    int lane = F.lane, w = F.wave, tid = F.tid; asm volatile("" : "+v"(lane), "+v"(tid)); asm volatile("" : "+s"(w));
    const int r16 = lane & 15, q4 = lane >> 4;
    LAS unsigned short* cand = (LAS unsigned short*)(F.lds + RING_OFF);
    LAS unsigned short* fin = (LAS unsigned short*)(F.lds + RING_OFF + 5120);
    LAS unsigned short* tmp = (LAS unsigned short*)(F.lds + RING_OFF + 5760);
    LAS float* snew = (LAS float*)(F.lds + RING_OFF + 6400);
    LAS float* comb = (LAS float*)(F.lds + RING_OFF + 8192);
    LAS unsigned char* vst = F.lds + RING_OFF + 32768 + w * 9216;
    const float* hs = WSF(WS_HS) + (size_t)s * LDH;
    float* ssc = WSF(WS_SSC) + (size_t)s * SSC_LD;
    if (w == 0) {
        const int h = lane >> 2, part = lane & 3; float d = 0.f;
        const float* qp = hs + HC_QI + h * 128 + part * 32; const float* kp = hs + HC_KI + part * 32;
#pragma unroll
        for (int j = 0; j < 32; ++j) d += bf2f((unsigned short)f2bf(qp[j])) * bf2f((unsigned short)f2bf(kp[j]));
        d += dppf<0xB1>(d); d += dppf<0x4E>(d);
        float cn = (part == 0) ? hs[HC_WI + h] * fmaxf(d, 0.f) : 0.f;
        cn = wave_sum(cn);
        if (lane == 0) { snew[0] = cn; ssc[PAST] = cn; }
    }
    {
        float sv[32];
#pragma unroll
        for (int i = 0; i < 32; ++i) sv[i] = ssc[w * 2048 + i * 64 + lane];
        wave_select256<32>(sv, 2048, lane, cand + w * 320, (LAS unsigned*)vst);
    }
    __syncthreads();
    if (w == 0) {
        float sv[33];
#pragma unroll
        for (int i = 0; i < 32; ++i) { const int cidx = i * 64 + lane; const int key = (cidx >> 8) * 2048 + cand[(cidx >> 8) * 320 + (cidx & 255)]; sv[i] = ssc[key]; }
        sv[32] = lane == 0 ? snew[0] : -INFINITY;
        wave_select256<33>(sv, 2049, lane, tmp, (LAS unsigned*)vst);
#pragma unroll
        for (int j = 0; j < 4; ++j) { const int slot = tmp[lane + 64 * j]; fin[lane + 64 * j] = (unsigned short)(slot >= 2048 ? PAST : (slot >> 8) * 2048 + cand[(slot >> 8) * 320 + (slot & 255)]); }
        LDS_WAIT();
    }
    __syncthreads();
    {
        const int g = w & 1, part = w >> 1;
        RowSrc R; R.Hb = nullptr; R.ck = I.ck; R.cv = I.cv; R.pt = I.pt + s * NPAGES; R.knew = F.out + O_KS + s * 256; R.vnew = F.out + O_VS + s * 256;
        bf16x8 qf[4]; const bf16x8 z = {0, 0, 0, 0, 0, 0, 0, 0};
        const float* qp = hs + HC_Q + (g * 4 + (r16 & 3)) * 128 + 8 * q4;
#pragma unroll
        for (int st = 0; st < 4; ++st) { qf[st] = cvt8(*(const f32x4*)(qp + 32 * st), *(const f32x4*)(qp + 32 * st + 4)); if (r16 >= 4) qf[st] = z; }
        float m, l; f32x4 o[8];
        attn_part<true>(R, g, fin, part * 64, 2, 256, vst, qf, m, l, o, lane);
        LAS float* cw = comb + w * 520;
        if (r16 < 4) {
            if (q4 == 0) { cw[r16] = m; cw[4 + r16] = l; }
#pragma unroll
            for (int db = 0; db < 8; ++db)
#pragma unroll
                for (int r = 0; r < 4; ++r) cw[8 + (db * 16 + 4 * q4 + r) * 4 + r16] = o[db][r];
        }
    }
    __syncthreads();
    for (int e = tid; e < 1024; e += 512) {
        const int hh = e >> 7, d = e & 127, g = hh >> 2, h = hh & 3;
        float M = -1e30f;
#pragma unroll
        for (int p = 0; p < 4; ++p) M = fmaxf(M, comb[(g + 2 * p) * 520 + h]);
        float num = 0.f, den = 0.f;
#pragma unroll
        for (int p = 0; p < 4; ++p) { const LAS float* cw = comb + (g + 2 * p) * 520; const float f = __builtin_amdgcn_exp2f(cw[h] - M); num += cw[8 + d * 4 + h] * f; den += cw[4 + h] * f; }
        const float v = num / den * hs[HC_ZA + hh * 128 + d];
        WSB(WS_OABS)[(size_t)s * DM + hh * 128 + d] = (bf16)f2bf(v);
    }
    if (w == 1) {
        float x[16]; float sum = 0.f;
#pragma unroll
        for (int j = 0; j < 16; ++j) { x[j] = hs[HC_VB + lane + 64 * j]; sum += x[j]; }
        const float mu = wave_sum(sum) * (1.f / 1024.f); float qv = 0.f;
#pragma unroll
        for (int j = 0; j < 16; ++j) { const float d = x[j] - mu; qv += d * d; }
        const float rs = 1.0f / sqrtf(wave_sum(qv) * (1.f / 1024.f) + LN_EPS);
#pragma unroll
        for (int j = 0; j < 16; ++j) { const int ch = lane + 64 * j, g = ch >> 7;
            const float vn = (x[j] - mu) * rs * I.lng[ch] + I.lnb[ch];
            F.out[O_GV + s * 1024 + ch] = vn;
            const float ob = hs[HC_U + ch] * (I.wsp[(size_t)g * 128 * 128] * vn + I.bsp[g * 128]) * hs[HC_ZB + ch];
            WSB(WS_OABS)[(size_t)s * DM + 1024 + ch] = (bf16)f2bf(ob); }
    }
    __syncthreads();
}

__global__ void __launch_bounds__(512, 2) mk_fwd(Args args) {
    extern __shared__ __attribute__((aligned(16))) unsigned char lds_raw[];
    Ctx F;
    F.lds = (LAS unsigned char*)lds_raw;
    F.tid = threadIdx.x; F.lane = F.tid & 63; F.wave = __builtin_amdgcn_readfirstlane(F.tid >> 6); F.G = gridDim.x; F.bid = blockIdx.x;
    F.out = args.out; F.ws = args.ws;
    volatile LAS unsigned* MISC = (volatile LAS unsigned*)(F.lds + MISC_OFF);
    for (int u = F.tid; u < (LDS_BYTES - LDSCTL_OFF) / 4; u += 512) ((LAS unsigned*)(F.lds + LDSCTL_OFF))[u] = 0u;
    __syncthreads();
    XcdBarrier bar; bar.bar = (unsigned*)(((gu32*)(F.ws + WS_CTL)) + CW_BAR); bar.x = 0; bar.st = nullptr;
    if (MK_N_LAUNCHES == 1) bar = xcd_barrier_post((unsigned*)(((gu32*)(F.ws + WS_CTL)) + CW_BAR), MISC + 8);
    const int lo = args.ph_lo, hi = args.ph_hi;
#ifndef PH_MASK
#define PH_MASK 0x7f
#endif
#define IN(k) (((PH_MASK >> (k)) & 1) && lo <= (k) && (k) < hi)
#define SEAM(k) do { if (IN(k) && IN((k) + 1)) xcd_barrier(bar); } while (0)
#ifndef REP_MASK
#define REP_MASK 0
#endif
#define REPS(k) for (int rep_ = 0; rep_ < 1 + ((REP_MASK >> (k)) & 1); ++rep_, ((REP_MASK >> (k)) & 1) && rep_ == 1 ? (xcd_barrier(bar), 0) : 0)

    unsigned long long tp_ = PRB_T(); const unsigned long long tk0_ = tp_;
    if (IN(0)) REPS(0) { In I{}; I.win = (const float*)args.in[7]; I.wpa = (const float*)args.in[8]; I.wpb = (const float*)args.in[9]; I.wo = (const float*)args.in[10]; I.xp = (const float*)args.in[0]; I.xs = (const float*)args.in[1]; I.gin = (const float*)args.in[6]; p0_prologue(F, I); }
    PRB_ADD(0, tp_);
    SEAM(0); PRB_ADD(16, tp_); tp_ = PRB_T();
    if (IN(1)) REPS(1) {
        p1_sample_inproj(F);
        pg8::Gemm g{WSB(WS_XN), WSB(WS_XN), WSB(WS_WTIN), WSB(WS_WTIN), DM, DM, DM}; pg8::StaticOrder S; S.init(MP, LDH, F.G, F.bid);
        pg8::EpiInProj E{WSB(WS_H), F.out, WSF(WS_WI), F.ws + WS_KV8, F.ws + WS_KI8, WSF(WS_PSV)};
        pg8::gemm_phase<pg8::EpiInProj, pg8::StaticOrder, true, true>(F.lds + RING_OFF, g, S, E);
    }
    PRB_ADD(1, tp_);
    SEAM(1); PRB_ADD(17, tp_); tp_ = PRB_T();
    if (IN(2)) REPS(2) {
        In I{}; I.wpa = (const float*)args.in[8]; I.wpb = (const float*)args.in[9]; I.wo = (const float*)args.in[10]; I.cki = (const float*)args.in[4]; I.pt = (const int*)args.in[5]; I.lng = (const float*)args.in[11]; I.lnb = (const float*)args.in[12]; I.wsp = (const float*)args.in[13]; I.bsp = (const float*)args.in[14];
        LAS int* slot = (LAS int*)(F.lds + LDSCTL_OFF);
        unsigned* qh = (unsigned*)(((gu32*)(F.ws + WS_CTL)) + CW_Q2 + 64 * 8 * rep_);
        unsigned* sdone = (unsigned*)(((gu32*)(F.ws + WS_CTL)) + CW_SDONE + 64 * 8 * rep_);
        const int pb = (int)(xb_xcc_id() & 1u);
        const bool stat_ = (F.G >= 128);
        int stage = stat_ ? 2 : 0, pre_ = (stat_ && F.bid < 128) ? 0 : 2;
        for (int par_ = 0;; par_ ^= 1) {
            int item, st_;
            if (pre_ >= 2 && F.tid == 0) {
                int st = stage, it = -1;
                for (; st < 6; ++st) {
                    const int q = (st == 0) ? 3 : (st == 1 ? 4 : (st == 4 ? 2 : (st == 5 ? 5 : (st == 2 ? pb : (pb ^ 1)))));
                    const int lim = (st == 0) ? 128 : (st == 1 ? NS : (st == 4 ? 512 : 256));
                    const int v = (int)__hip_atomic_fetch_add(qh + 64 * q, 1u, __ATOMIC_RELAXED, __HIP_MEMORY_SCOPE_AGENT);
                    if (v < lim) { it = v; break; }
                }
                slot[2 * par_] = it; slot[2 * par_ + 1] = st;
            }
            __syncthreads();
            if (pre_ < 2) {
                item = F.bid; st_ = pre_;
                pre_ = (pre_ == 0 && F.bid < NS) ? 1 : 2;
            } else {
                item = __builtin_amdgcn_readfirstlane(slot[2 * par_]); stage = __builtin_amdgcn_readfirstlane(slot[2 * par_ + 1]); st_ = stage;
                if (item < 0) break;
            }
            if (st_ == 0) {
                const unsigned long long tq_ = PRB_T(); p2_sscore_item(F, I, item);
                asm volatile("s_waitcnt vmcnt(0)" ::: "memory"); __syncthreads();
                if (F.tid == 0) __hip_atomic_fetch_add(sdone + 64 * (item >> 4), 1u, __ATOMIC_RELAXED, __HIP_MEMORY_SCOPE_AGENT);
                PRB_ADD(13, tq_);
            } else if (st_ == 1) {
                const unsigned long long tq_ = PRB_T();
                if (F.tid == 0) { unsigned sp = 0; while (__hip_atomic_load(sdone + 64 * item, __ATOMIC_RELAXED, __HIP_MEMORY_SCOPE_AGENT) < 16u) { __builtin_amdgcn_s_sleep(8); if (++sp > (1u << 22)) break; }
                    __builtin_amdgcn_fence(__ATOMIC_ACQUIRE, "agent"); asm volatile("s_waitcnt vmcnt(0)" ::: "memory"); }
                __syncthreads();
                In J = I; J.ck = (const float*)args.in[2]; J.cv = (const float*)args.in[3];
                p3_sample_item(F, J, item);
                PRB_ADD(15, tq_);
            } else if (st_ == 4) { const unsigned long long tq_ = PRB_T(); for (int rp_ = 0; rp_ < 1 + ((REP_P2 >> 3) & 1); ++rp_) p2_gmlp_item(F, I, item); PRB_ADD(12, tq_); }
            else if (st_ == 5) p2_wt_item(F, I, item);
            else p2_prompt_item(F, item, st_ == 2 ? pb : (pb ^ 1));
        }
    }
    PRB_ADD(2, tp_);
    SEAM(2); PRB_ADD(8, tp_); tp_ = PRB_T();
    if (IN(3)) REPS(3) {
        if (F.bid < 128) {
            LAS float* red = (LAS float*)(F.lds + RING_OFF);
            const int n0 = 16 * F.bid;
            f32x4 ya, yb; float gav[4], gbv[4];
            {
                const int r = F.lane & 15, q = F.lane >> 4, kbeg = F.wave * 128;
                const bf16* xa = WSB(WS_OABS) + (size_t)(r & 7) * DM + kbeg + 8 * q; const bf16* wa = WSB(WS_WTA) + (size_t)(n0 + r) * 1024 + kbeg + 8 * q; const bf16* wb = WSB(WS_WTB) + (size_t)(n0 + r) * 1024 + kbeg + 8 * q;
                const bf16x8 z = {0, 0, 0, 0, 0, 0, 0, 0};
                bf16x8 a0[4], a1[4], b0[4], b1[4];
#pragma unroll
                for (int j = 0; j < 4; ++j) { const int s_ = (4 * (F.lane >> 4) + j) & 7; gav[j] = WSF(WS_HS)[(size_t)s_ * LDH + HC_GA + n0 + r]; gbv[j] = WSF(WS_HS)[(size_t)s_ * LDH + HC_GB + n0 + r]; }
#pragma unroll
                for (int st = 0; st < 4; ++st) { a0[st] = *(const bf16x8*)(xa + 32 * st); a1[st] = *(const bf16x8*)(xa + 1024 + 32 * st); b0[st] = *(const bf16x8*)(wa + 32 * st); b1[st] = *(const bf16x8*)(wb + 32 * st); }
                __builtin_amdgcn_sched_barrier(0);
                ya = (f32x4){0.f, 0.f, 0.f, 0.f}; yb = ya;
#pragma unroll
                for (int st = 0; st < 4; ++st) { ya = __builtin_amdgcn_mfma_f32_16x16x32_bf16(r >= 8 ? z : a0[st], b0[st], ya, 0, 0, 0); yb = __builtin_amdgcn_mfma_f32_16x16x32_bf16(r >= 8 ? z : a1[st], b1[st], yb, 0, 0, 0); }
                *(LAS f32x4*)(red + (F.wave * 64 + F.lane) * 4) = ya; *(LAS f32x4*)(red + ((8 + F.wave) * 64 + F.lane) * 4) = yb;
                __syncthreads();
                if (F.wave == 0) { ya = (f32x4){0.f, 0.f, 0.f, 0.f}; yb = ya;
#pragma unroll
                    for (int w = 0; w < 8; ++w) { ya += *(LAS f32x4*)(red + (w * 64 + F.lane) * 4); yb += *(LAS f32x4*)(red + ((8 + w) * 64 + F.lane) * 4); } }
            }
            if (F.wave == 0 && F.lane < 32) {
#pragma unroll
                for (int j = 0; j < 4; ++j) { const int s = 4 * (F.lane >> 4) + j, n = n0 + (F.lane & 15);
                    const float v = gav[j] * ya[j] + gbv[j] * yb[j];
                    WSB(WS_MIXS)[(size_t)s * DM + n] = (bf16)f2bf(v); }
            }
            __syncthreads();
        }
        pg8::Gemm g{WSB(WS_OAB), WSB(WS_OAB) + 1024, WSB(WS_WTA), WSB(WS_WTB), DM, 1024, 1024}; pg8::PairOrder S; S.init(MP, DM, F.G, F.bid);
        pg8::EpiMix E{WSB(WS_H), WSB(WS_MIX)};
        pg8::gemm_phase<pg8::EpiMix, pg8::PairOrder, true, true>(F.lds + RING_OFF, g, S, E);
    }
    PRB_ADD(3, tp_);
    SEAM(3); PRB_ADD(19, tp_); tp_ = PRB_T();
    if (IN(4)) REPS(4) {
        if (F.bid < 128) {
            LAS float* red = (LAS float*)(F.lds + RING_OFF);
            const int n0 = 16 * F.bid;
            float xres[4];
#pragma unroll
            for (int j = 0; j < 4; ++j) xres[j] = ((const float*)args.in[1])[(size_t)((4 * (F.lane >> 4) + j) & 7) * DM + n0 + (F.lane & 15)];
            f32x4 y = sgemv_part(WSB(WS_MIXS), DM, WSB(WS_WTO), DM, n0, F.wave * 256, 8, F.lane);
            y = block_reduce8(y, red, F.wave, F.lane);
            if (F.wave == 0 && F.lane < 32) {
#pragma unroll
                for (int j = 0; j < 4; ++j) { const int s = 4 * (F.lane >> 4) + j, n = n0 + (F.lane & 15); WSF(WS_XSO)[(size_t)s * DM + n] = xres[j] + y[j]; }
            }
        }
        __syncthreads();
        pg8::Gemm g{WSB(WS_MIX), WSB(WS_MIX), WSB(WS_WTO), WSB(WS_WTO), DM, DM, DM}; pg8::StaticOrder S; S.init(MP, DM, F.G, F.bid);
        struct BarFn { const XcdBarrier* b; __device__ __forceinline__ void operator()() const { xcd_barrier(*b); } };
        pg8::EpiOut<BarFn> E{(const float*)args.in[0], F.out, WSF(WS_PS), (const float*)args.in[15], BarFn{&bar}, PROBE_ID >= 0 ? (unsigned*)(((gu32*)(F.ws + WS_CTL)) + CW_PROBE + 21) : nullptr, tp_};
        pg8::gemm_phase<pg8::EpiOut<BarFn>, pg8::StaticOrder, false, true>(F.lds + RING_OFF, g, S, E);
        PRB_ADD(20, tk0_);
        const int gw = F.bid * 8 + F.wave, NGW = F.G * 8;
        if (gw >= NGW - NS) { const int sr = gw - (NGW - NS);
            const f32x4* xr = (const f32x4*)(WSF(WS_XSO) + (size_t)sr * DM) + F.lane; const f32x4* gr = (const f32x4*)args.in[15] + F.lane;
            f32x4 v[8]; float s = 0.f;
#pragma unroll
            for (int j = 0; j < 8; ++j) { v[j] = xr[64 * j]; s += (v[j].x * v[j].x + v[j].y * v[j].y) + (v[j].z * v[j].z + v[j].w * v[j].w); }
            const float rstd = 1.0f / sqrtf(wave_sum(s) * (1.f / DM) + RMS_EPS);
            f32x4* o = (f32x4*)(F.out + O_YS + (size_t)sr * DM) + F.lane;
            float prb_ = 1.0f; if (PROBE_ID >= 0) prb_ += (float)PRB_Q(__hip_atomic_load((unsigned*)(((gu32*)(F.ws + WS_CTL)) + CW_PROBE + (PROBE_ID >= 0 ? PROBE_ID : 0)), __ATOMIC_RELAXED, __HIP_MEMORY_SCOPE_AGENT)) * (0.01f / 256.f / 1000.f);
#pragma unroll
            for (int j = 0; j < 8; ++j) o[64 * j] = v[j] * rstd * gr[64 * j] * prb_;
        }

    }
    PRB_ADD(4, tp_);
#undef IN
#undef SEAM
}

extern "C" void kernel_launch(void* const* d_in, const int* in_sizes, int n_in, void* d_out, int out_size, void* d_ws, size_t ws_size, hipStream_t stream) {
    static int grid = 0;
    if (grid == 0) {
        if (n_in != 16 || out_size != (int)O_END || ws_size < WS_END) { fprintf(stderr, "kernel_launch: unexpected shapes: n_in %d out %d ws %zu\n", n_in, out_size, ws_size); grid = -1; return; }
        int dev = 0, cus = 0;
        if (hipGetDevice(&dev) != hipSuccess || hipDeviceGetAttribute(&cus, hipDeviceAttributeMultiprocessorCount, dev) != hipSuccess) { grid = -1; return; }
        if (hipFuncSetAttribute((const void*)mk_fwd, hipFuncAttributeMaxDynamicSharedMemorySize, LDS_BYTES) != hipSuccess) { fprintf(stderr, "kernel_launch: hipFuncSetAttribute failed\n"); grid = -1; return; }
        int per_cu = 0;
        if (hipOccupancyMaxActiveBlocksPerMultiprocessor(&per_cu, (const void*)mk_fwd, 512, LDS_BYTES) != hipSuccess || per_cu < 1) fprintf(stderr, "kernel_launch: occupancy query reports %d\n", per_cu);
        (void)hipGetLastError();
        grid = cus;
        if (grid != 256) fprintf(stderr, "kernel_launch: %d CUs; this kernel is laid out for 256\n", grid);
    }
    if (grid < 0) return;
    (void)hipMemsetAsync((char*)d_ws + WS_CTL, 0, CTL_ZERO_BYTES, stream);
    Args a{};
    for (int i = 0; i < 16; ++i) a.in[i] = d_in[i];
    a.out = (float*)d_out; a.ws = (unsigned char*)d_ws;
    constexpr int NPH = 5;
    if (MK_N_LAUNCHES == 1) { a.ph_lo = 0; a.ph_hi = NPH; a.li = 0; hipLaunchKernelGGL(mk_fwd, dim3(grid), dim3(512), LDS_BYTES, stream, a); }
    else for (int p = 0; p < NPH; ++p) { a.ph_lo = p; a.ph_hi = p + 1; a.li = p; hipLaunchKernelGGL(mk_fwd, dim3(grid), dim3(512), LDS_BYTES, stream, a); }
}
```

```cpp
#include <hip/hip_runtime.h>
#include <cstdio>
#include <cstdint>
#include <cmath>

#ifndef MK_N_LAUNCHES
#define MK_N_LAUNCHES 1
#endif

constexpr int DM = 2048, SEQ = 4096, NBATCH = 2, MP = NBATCH * SEQ, NS = 8, PAST = 16384, NPAGES = 128, PAGE = 128;
constexpr int LDH = 12032;
constexpr int HC_Q = 0, HC_K = 1024, HC_V = 1280, HC_QI = 1536, HC_WI = 3584, HC_KI = 3600, HC_ZA = 3840, HC_U = 4864, HC_VB = 5888, HC_ZB = 6912, HC_GA = 7936, HC_GB = 9984;
constexpr int IN_WIDTH = 11920;
constexpr float QSCALE = 0.08838834764831845f * 1.4426950408889634f;
constexpr float WSCALE = 0.25f * 0.08838834764831845f;
constexpr float RMS_EPS = 1e-6f, LN_EPS = 1e-5f;
constexpr size_t O_YP = 0, O_YS = 16777216, O_KP = 16793600, O_VP = 18890752, O_KIP = 20987904, O_KS = 22036480, O_VS = 22038528, O_KIS = 22040576, O_GV = 22041600, O_END = 22049792;
constexpr size_t MiB = 1u << 20;
constexpr size_t WS_CTL = 0, CTL_ZERO_BYTES = 32768;
constexpr size_t WS_WTIN = 2 * MiB, WS_WTA = 50 * MiB, WS_WTB = 54 * MiB, WS_WTO = 58 * MiB, WS_XN = 66 * MiB, WS_XNS = 98 * MiB, WS_HS = 99 * MiB, WS_SSC = 100 * MiB;
constexpr size_t WS_OABS = 101 * MiB, WS_MIXS = 101 * MiB + 256 * 1024, WS_XSO = 101 * MiB + 512 * 1024, WS_PS = 102 * MiB, WS_WI = 103 * MiB;
constexpr size_t WS_H = 104 * MiB, WS_OAB = 292 * MiB, WS_MIX = 324 * MiB, WS_SC = 356 * MiB, WS_KV8 = 420 * MiB, WS_PSV = 424 * MiB, WS_KI8 = 425 * MiB, WS_END = 426 * MiB;
#ifndef IDX_FP8
#define IDX_FP8 0
#endif
#ifndef ATT_FP8
#define ATT_FP8 1
#endif
constexpr int SSC_LD = 16448;
static_assert(WS_WTIN + (size_t)LDH * DM * 2 <= WS_WTA && WS_H + (size_t)MP * LDH * 2 <= WS_OAB && WS_WI + (size_t)MP * 16 * 4 <= WS_H, "ws map");
constexpr int CW_Q2 = 64;
constexpr int CW_SDONE = 1152;
constexpr int CW_BAR = 4096;

#define GAS __attribute__((address_space(1)))
#define LAS __attribute__((address_space(3)))
typedef unsigned short bf16;
typedef unsigned v4u __attribute__((ext_vector_type(4)));
typedef unsigned v2u __attribute__((ext_vector_type(2)));
typedef float f32x4 __attribute__((ext_vector_type(4)));
typedef float f32x2 __attribute__((ext_vector_type(2)));
typedef float f32x16 __attribute__((ext_vector_type(16)));
typedef short bf16x8 __attribute__((ext_vector_type(8)));
typedef short s16x4 __attribute__((ext_vector_type(4)));
typedef __bf16 bf16x2_t __attribute__((ext_vector_type(2)));
typedef int v2i_t __attribute__((ext_vector_type(2)));
typedef GAS unsigned gu32;
#define LDS_WAIT() asm volatile("s_waitcnt lgkmcnt(0)" ::: "memory")
#define VM_WAIT() asm volatile("s_waitcnt vmcnt(0)" ::: "memory")

__device__ __forceinline__ unsigned cvtpk(float lo, float hi) { f32x2 v = {lo, hi}; bf16x2_t b = __builtin_convertvector(v, bf16x2_t); return __builtin_bit_cast(unsigned, b); }
__device__ __forceinline__ float bf2f(unsigned short h) { return __uint_as_float((unsigned)h << 16); }
__device__ __forceinline__ float bflo(unsigned w) { return __uint_as_float(w << 16); }
__device__ __forceinline__ float bfhi(unsigned w) { return __uint_as_float(w & 0xffff0000u); }
__device__ __forceinline__ bf16x8 cvt8(f32x4 a, f32x4 b) { v4u w; w.x = cvtpk(a[0], a[1]); w.y = cvtpk(a[2], a[3]); w.z = cvtpk(b[0], b[1]); w.w = cvtpk(b[2], b[3]); return __builtin_bit_cast(bf16x8, w); }
__device__ __forceinline__ void store16_wt(void* p, v4u v) { asm volatile("global_store_dwordx4 %0, %1, off sc1\n\ts_nop 1" :: "v"(p), "v"(v) : "memory"); }
__device__ __forceinline__ float sigmoid_(float x) { return __builtin_amdgcn_rcpf(1.f + __builtin_amdgcn_exp2f(-1.4426950408889634f * x)); }
__device__ __forceinline__ float silu_(float x) { return x * sigmoid_(x); }
template <int CTRL> __device__ __forceinline__ float dppf(float v) { return __int_as_float(__builtin_amdgcn_mov_dpp(__float_as_int(v), CTRL, 0xF, 0xF, true)); }
template <int CTRL> __device__ __forceinline__ int dppi(int v) { return __builtin_amdgcn_mov_dpp(v, CTRL, 0xF, 0xF, true); }
__device__ __forceinline__ float x16_add(float v) { const auto x = __builtin_amdgcn_permlane16_swap(__float_as_uint(v), __float_as_uint(v), false, false); return __uint_as_float(x[0]) + __uint_as_float(x[1]); }
__device__ __forceinline__ float x32_add(float v) { const auto x = __builtin_amdgcn_permlane32_swap(__float_as_uint(v), __float_as_uint(v), false, false); return __uint_as_float(x[0]) + __uint_as_float(x[1]); }
__device__ __forceinline__ float x16_max(float v) { const auto x = __builtin_amdgcn_permlane16_swap(__float_as_uint(v), __float_as_uint(v), false, false); return fmaxf(__uint_as_float(x[0]), __uint_as_float(x[1])); }
__device__ __forceinline__ float x32_max(float v) { const auto x = __builtin_amdgcn_permlane32_swap(__float_as_uint(v), __float_as_uint(v), false, false); return fmaxf(__uint_as_float(x[0]), __uint_as_float(x[1])); }
__device__ __forceinline__ float x16_min(float v) { const auto x = __builtin_amdgcn_permlane16_swap(__float_as_uint(v), __float_as_uint(v), false, false); return fminf(__uint_as_float(x[0]), __uint_as_float(x[1])); }
__device__ __forceinline__ float x32_min(float v) { const auto x = __builtin_amdgcn_permlane32_swap(__float_as_uint(v), __float_as_uint(v), false, false); return fminf(__uint_as_float(x[0]), __uint_as_float(x[1])); }
__device__ __forceinline__ float xrows_add(float v) { return x32_add(x16_add(v)); }
__device__ __forceinline__ float xrows_max(float v) { return x32_max(x16_max(v)); }
__device__ __forceinline__ float wave_sum(float v) { v += dppf<0xB1>(v); v += dppf<0x4E>(v); v += dppf<0x141>(v); v += dppf<0x140>(v); return xrows_add(v); }
__device__ __forceinline__ int wave_sum_i(int v) { v += dppi<0xB1>(v); v += dppi<0x4E>(v); v += dppi<0x141>(v); v += dppi<0x140>(v);
    { const auto x = __builtin_amdgcn_permlane16_swap((unsigned)v, (unsigned)v, false, false); v = (int)(x[0] + x[1]); }
    { const auto x = __builtin_amdgcn_permlane32_swap((unsigned)v, (unsigned)v, false, false); v = (int)(x[0] + x[1]); } return v; }
__device__ __forceinline__ float wave_max(float v) { v = fmaxf(v, dppf<0xB1>(v)); v = fmaxf(v, dppf<0x4E>(v)); v = fmaxf(v, dppf<0x141>(v)); v = fmaxf(v, dppf<0x140>(v)); return xrows_max(v); }
__device__ __forceinline__ float wave_min(float v) { v = fminf(v, dppf<0xB1>(v)); v = fminf(v, dppf<0x4E>(v)); v = fminf(v, dppf<0x141>(v)); v = fminf(v, dppf<0x140>(v)); return x32_min(x16_min(v)); }

namespace pg8 {
#define PG8_LAS __attribute__((address_space(3)))
typedef unsigned short bf16_t;
typedef unsigned u32x4 __attribute__((ext_vector_type(4)));
constexpr int BM = 256, BK = 64, HALF = 128, HTB = HALF * BK * 2, STAGE_BYTES = 8 * HTB, NXCD = 8, WGM = 8;
__host__ __device__ __forceinline__ int lds_byte(int r, int c) { const int st = (r >> 4) * 2 + (c >> 5), rr = r & 15, cc = c & 31, ob = rr * 64 + cc * 2; return st * 1024 + (ob ^ (((ob >> 9) & 1) << 5)); }
__host__ __device__ __forceinline__ void stage_rc(int b, int& R, int& C) { const int st = b / 1024, sb = b % 1024, swz = sb ^ (((sb >> 9) & 1) << 5); R = (st >> 1) * 16 + swz / 64; C = (st & 1) * 32 + (swz % 64) / 2; }
__host__ __device__ __forceinline__ int perm32(int rho) { const int n = rho >> 4, i = rho & 15; return 8 * (i >> 2) + 4 * n + (i & 3); }
struct Unit { int pm, pn, kind; };
struct Gemm { const bf16_t* A0; const bf16_t* A1; const bf16_t* B0; const bf16_t* B1; int lda, ldb, K; };
struct StaticOrder {
    int nM, nN, nwg, G, c;
    __host__ __device__ void init(int M, int N, int G_, int c_) { nM = M / BM; nN = N / BM; nwg = nM * nN; G = G_; c = c_; }
    __host__ __device__ bool tile(long L, Unit& u) const {
        if (L >= nwg) return false;
        int wgid = (int)L; { const int q = nwg / NXCD, r = nwg % NXCD, xcd = wgid % NXCD, off = wgid / NXCD; wgid = (xcd < r ? xcd * (q + 1) : r * (q + 1) + (xcd - r) * q) + off; }
        const int nig = WGM * nN, gid = wgid / nig, fm = gid * WGM, gsz = (nM - fm) < WGM ? (nM - fm) : WGM;
        u.pm = fm + ((wgid % nig) % gsz); u.pn = (wgid % nig) / gsz; u.kind = 0; return true;
    }
    __host__ __device__ bool next(int i, Unit& u) const { return tile((long)i * G + c, u); }
};
struct PairOrder : StaticOrder {
    __host__ __device__ bool next(int i, Unit& u) const { if (i >= 2) return false; const bool ok = tile((long)c, u); u.kind = i; return ok; }
};

template <class Epi, class Sched, bool ALIGN_EPI = false, bool SP2 = false>
__device__ __forceinline__ void gemm_phase(PG8_LAS unsigned char* lds, const Gemm g, const Sched& S, const Epi& E) {
    const int tid = threadIdx.x, wid = __builtin_amdgcn_readfirstlane(tid >> 6), lane = tid & 63, wr = wid >> 2, wc = wid & 3, fr = lane & 15, fq = lane >> 4;
    const int K = g.K, nt = K / BK;
    unsigned voffA[2], voffB[2];
#pragma unroll
    for (int i = 0; i < 2; ++i) { int R, C; stage_rc(tid * 16 + i * 8192, R, C); const int Rb = Epi::PERM ? ((R & ~31) + perm32(R & 31)) : R;
        voffA[i] = (unsigned)(R * g.lda + C) * 2u; voffB[i] = (unsigned)(Rb * g.ldb + C) * 2u; }
    const size_t kstep = (size_t)(BK * 2);
    const size_t hstepA = (size_t)HALF * g.lda * 2, hstepB = (size_t)HALF * g.ldb * 2;
    const size_t tstepA = 2 * hstepA, tstepB = 2 * hstepB;
    const unsigned ldsw = (unsigned)wid * 1024u;
    const int aoff = lds_byte(wr * 64 + fr, fq * 8), boff = lds_byte(wc * 32 + fr, fq * 8);
#define PG8_SA(b, h) (((b) * 2 + (h)) * HTB)
#define PG8_SB(b, h) ((4 + (b) * 2 + (h)) * HTB)
#define PG8_STAGE(bufoff, gbase, voff) do { _Pragma("unroll") for (int _i = 0; _i < 2; ++_i) \
        __builtin_amdgcn_global_load_lds((const unsigned*)((const char*)(gbase) + (voff)[_i]), (PG8_LAS unsigned*)(lds + (bufoff) + ldsw + _i * 8192), 16, 0, 0); } while (0)
#define PG8_LDA(dst, b, h) do { _Pragma("unroll") for (int m = 0; m < 4; ++m) _Pragma("unroll") for (int k = 0; k < 2; ++k) dst[m][k] = *(const PG8_LAS bf16x8*)(lds + PG8_SA(b, h) + aoff + m * 2048 + k * 1024); } while (0)
#define PG8_LDB(dst, b, h) do { _Pragma("unroll") for (int n = 0; n < 2; ++n) _Pragma("unroll") for (int k = 0; k < 2; ++k) dst[n][k] = *(const PG8_LAS bf16x8*)(lds + PG8_SB(b, h) + boff + n * 2048 + k * 1024); } while (0)
#define PG8_MMA(ai, bj, At, Bt) do { __builtin_amdgcn_s_setprio(1); _Pragma("unroll") for (int m = 0; m < 4; ++m) _Pragma("unroll") for (int n = 0; n < 2; ++n) _Pragma("unroll") for (int k = 0; k < 2; ++k) \
        acc[ai][bj][m][n] = __builtin_amdgcn_mfma_f32_16x16x32_bf16(Bt[n][k], At[m][k], acc[ai][bj][m][n], 0, 0, 0); __builtin_amdgcn_s_setprio(0); } while (0)
#define PG8_WAIT_V(n) asm volatile("s_waitcnt vmcnt(" #n ")" ::: "memory")
#define PG8_WAIT_L(n) asm volatile("s_waitcnt lgkmcnt(" #n ")" ::: "memory")
#define PG8_BAR __builtin_amdgcn_s_barrier()
#define PG8_SCHED __builtin_amdgcn_sched_barrier(0)
#define PG8_OPA(u) ((const char*)((u).kind ? g.A1 : g.A0) + (size_t)(u).pm * tstepA)
#define PG8_OPB(u) ((const char*)((u).kind ? g.B1 : g.B0) + (size_t)(u).pn * tstepB)
    Unit cur, nxt; int ui = 0;
    if (!S.next(0, cur)) return;
    f32x4 acc[2][2][4][2];
#pragma unroll
    for (int a = 0; a < 2; ++a)
#pragma unroll
        for (int b = 0; b < 2; ++b)
#pragma unroll
            for (int m = 0; m < 4; ++m)
#pragma unroll
                for (int n = 0; n < 2; ++n) acc[a][b][m][n] = (f32x4){0.f, 0.f, 0.f, 0.f};
    bf16x8 At[4][2], B0[2][2], B1[2][2];
    const char* cA = PG8_OPA(cur); const char* cB = PG8_OPB(cur);
    if constexpr (SP2) {
        PG8_STAGE(PG8_SB(0, 0), cB, voffB); PG8_STAGE(PG8_SB(0, 1), cB + hstepB, voffB); PG8_STAGE(PG8_SA(0, 0), cA, voffA); PG8_STAGE(PG8_SA(0, 1), cA + hstepA, voffA);
        if (wr == 1) PG8_BAR;
        PG8_WAIT_V(2); PG8_BAR;
        PG8_STAGE(PG8_SB(1, 0), cB + kstep, voffB); PG8_STAGE(PG8_SA(1, 0), cA + kstep, voffA); PG8_STAGE(PG8_SB(1, 1), cB + hstepB + kstep, voffB);
        PG8_WAIT_V(6); PG8_BAR;
    } else {
        PG8_STAGE(PG8_SB(0, 0), cB, voffB); PG8_STAGE(PG8_SA(0, 0), cA, voffA); PG8_STAGE(PG8_SB(0, 1), cB + hstepB, voffB); PG8_STAGE(PG8_SA(0, 1), cA + hstepA, voffA);
        if (wr == 1) PG8_BAR;
        PG8_WAIT_V(4); PG8_BAR;
        PG8_STAGE(PG8_SB(1, 0), cB + kstep, voffB); PG8_STAGE(PG8_SA(1, 0), cA + kstep, voffA); PG8_STAGE(PG8_SB(1, 1), cB + hstepB + kstep, voffB);
        PG8_WAIT_V(6); PG8_BAR;
    }
    for (;;) {
        const bool has_next = S.next(ui + 1, nxt);
        const char* nA = has_next ? PG8_OPA(nxt) : cA; const char* nB = has_next ? PG8_OPB(nxt) : cB;
        for (int t = 0; t < nt; t += 2) {
            const bool last = (t == nt - 2);
            const char* a1 = cA + (size_t)(t + 1) * kstep;
            const char* a2 = last ? nA : cA + (size_t)(t + 2) * kstep; const char* b2 = last ? nB : cB + (size_t)(t + 2) * kstep;
            const char* a3 = a2 + kstep; const char* b3 = b2 + kstep;
            if constexpr (SP2) {
            PG8_LDB(B0, 0, 0); PG8_LDB(B1, 0, 1); PG8_SCHED; PG8_LDA(At, 0, 0); PG8_STAGE(PG8_SA(1, 1), a1 + hstepA, voffA);
            PG8_WAIT_V(8); PG8_WAIT_L(0); PG8_BAR; PG8_MMA(0, 0, At, B0); PG8_MMA(0, 1, At, B1); PG8_BAR; PG8_SCHED;
            PG8_LDA(At, 0, 1); PG8_STAGE(PG8_SB(0, 0), b2, voffB); PG8_STAGE(PG8_SB(0, 1), b2 + hstepB, voffB); PG8_STAGE(PG8_SA(0, 0), a2, voffA);
            PG8_WAIT_V(8); PG8_WAIT_L(0); PG8_BAR; PG8_MMA(1, 0, At, B0); PG8_MMA(1, 1, At, B1); PG8_BAR; PG8_SCHED;
            PG8_LDB(B0, 1, 0); PG8_LDB(B1, 1, 1); PG8_SCHED; PG8_LDA(At, 1, 0); PG8_STAGE(PG8_SA(0, 1), a2 + hstepA, voffA);
            PG8_WAIT_V(8); PG8_WAIT_L(0); PG8_BAR; PG8_MMA(0, 0, At, B0); PG8_MMA(0, 1, At, B1); PG8_BAR; PG8_SCHED;
            PG8_LDA(At, 1, 1); PG8_STAGE(PG8_SB(1, 0), b3, voffB); PG8_STAGE(PG8_SB(1, 1), b3 + hstepB, voffB); PG8_STAGE(PG8_SA(1, 0), a3, voffA);
            PG8_WAIT_V(8); PG8_WAIT_L(0); PG8_BAR; PG8_MMA(1, 0, At, B0); PG8_MMA(1, 1, At, B1); PG8_BAR; PG8_SCHED;
            } else {
            PG8_LDB(B0, 0, 0); PG8_SCHED; PG8_LDA(At, 0, 0); PG8_STAGE(PG8_SA(1, 1), a1 + hstepA, voffA);
            PG8_WAIT_L(8); PG8_BAR; PG8_WAIT_L(0); PG8_MMA(0, 0, At, B0); PG8_BAR; PG8_SCHED;
            PG8_LDB(B1, 0, 1); PG8_STAGE(PG8_SB(0, 0), b2, voffB);
            PG8_BAR; PG8_WAIT_L(0); PG8_MMA(0, 1, At, B1); PG8_BAR;
            PG8_LDA(At, 0, 1); PG8_STAGE(PG8_SA(0, 0), a2, voffA);
            PG8_BAR; PG8_WAIT_L(0); PG8_MMA(1, 0, At, B0); PG8_BAR; PG8_SCHED;
            PG8_STAGE(PG8_SB(0, 1), b2 + hstepB, voffB);
            PG8_WAIT_V(6); PG8_BAR; PG8_MMA(1, 1, At, B1); PG8_BAR;
            PG8_LDB(B0, 1, 0); PG8_SCHED; PG8_LDA(At, 1, 0); PG8_STAGE(PG8_SA(0, 1), a2 + hstepA, voffA);
            PG8_WAIT_L(8); PG8_BAR; PG8_WAIT_L(0); PG8_MMA(0, 0, At, B0); PG8_BAR; PG8_SCHED;
            PG8_LDB(B1, 1, 1); PG8_STAGE(PG8_SB(1, 0), b3, voffB);
            PG8_BAR; PG8_WAIT_L(0); PG8_MMA(0, 1, At, B1); PG8_BAR;
            PG8_LDA(At, 1, 1); PG8_STAGE(PG8_SA(1, 0), a3, voffA);
            PG8_BAR; PG8_WAIT_L(0); PG8_MMA(1, 0, At, B0); PG8_BAR; PG8_SCHED;
            PG8_STAGE(PG8_SB(1, 1), b3 + hstepB, voffB);
            PG8_WAIT_V(6); PG8_BAR; PG8_MMA(1, 1, At, B1); PG8_BAR;
            }
        }
        if constexpr (ALIGN_EPI) { if (wr == 0) PG8_BAR; }
        if constexpr (!Epi::AFTER_DRAIN) { E(acc, cur, wr, wc, fr, fq); }
        if (!has_next) break;
        if (!(Epi::KEEP && cur.kind == 0)) {
#pragma unroll
        for (int a = 0; a < 2; ++a)
#pragma unroll
            for (int b = 0; b < 2; ++b)
#pragma unroll
                for (int m = 0; m < 4; ++m)
#pragma unroll
                    for (int n = 0; n < 2; ++n) acc[a][b][m][n] = (f32x4){0.f, 0.f, 0.f, 0.f};
        }
        cur = nxt; cA = nA; cB = nB; ++ui;
        if constexpr (ALIGN_EPI) { if (wr == 1) PG8_BAR; }
    }
    PG8_WAIT_V(0);
    if constexpr (!ALIGN_EPI) { if (wr == 0) PG8_BAR; }
    PG8_BAR;
    if constexpr (Epi::AFTER_DRAIN) { E.fused(acc, cur, wr, wc, fr, fq, lds, wid, lane); }
#undef PG8_SA
#undef PG8_SB
#undef PG8_STAGE
#undef PG8_LDA
#undef PG8_LDB
#undef PG8_MMA
#undef PG8_WAIT_V
#undef PG8_WAIT_L
#undef PG8_BAR
#undef PG8_SCHED
#undef PG8_OPA
#undef PG8_OPB
}

__device__ __forceinline__ f32x2 gelu_pk(f32x2 v) {
    const f32x2 av = __builtin_elementwise_abs(v), d = av * 0.2316418882f + 1.0f;
    f32x2 t; t.x = __builtin_amdgcn_rcpf(d.x); t.y = __builtin_amdgcn_rcpf(d.y);
    f32x2 q = t * 0.5307027145f + (-0.7265760135f); q = q * t + 0.7107068705f; q = q * t + (-0.142248368f); q = q * t + 0.127414796f; q = q * t;
    const f32x2 s = (v * v) * (-0.72134752044f);
    f32x2 e; e.x = __builtin_amdgcn_exp2f(s.x); e.y = __builtin_amdgcn_exp2f(s.y);
    const f32x2 m = v * (q * e), r = v - m;
    f32x2 o; o.x = v.x < 0.f ? m.x : r.x; o.y = v.y < 0.f ? m.y : r.y; return o;
}

struct EpiInProj {
    static constexpr bool PERM = true, AFTER_DRAIN = false, KEEP = false;
    bf16_t* H; float* out; float* WI; unsigned char* KV8; unsigned char* KI8; float* PSV;
    __device__ __forceinline__ void operator()(f32x4 (&acc)[2][2][4][2], const Unit& u, int wr, int wc, int fr, int fq) const {
        const int pn = u.pn;
        int act;
        if (pn < 4) act = 1; else if (pn == 4) act = 5; else if (pn == 5) act = 6; else if (pn < 14) act = 0; else if (pn == 14) act = 7;
        else if (pn < 19) act = 2; else if (pn < 27) act = 3; else if (pn < 31) act = 2; else act = 4;
        const int row0 = u.pm * BM + wr * 64 + fr, col0 = pn * BM + wc * 32 + 8 * fq;
#pragma unroll
        for (int ai = 0; ai < 2; ++ai)
#pragma unroll
            for (int m = 0; m < 4; ++m) { const int row = row0 + ai * HALF + m * 16; bf16_t* hrow = H + (size_t)row * LDH; float s1 = 0.f, s2 = 0.f;
#pragma unroll
                for (int bj = 0; bj < 2; ++bj) { f32x4 v0 = acc[ai][bj][m][0], v1 = acc[ai][bj][m][1]; const int c = col0 + bj * HALF;
                    bool st = true;
                    if (act == 1) { v0 = v0 * QSCALE; v1 = v1 * QSCALE; }
                    else if (act == 2) {
#pragma unroll
                        for (int j = 0; j < 4; ++j) { v0[j] = silu_(v0[j]); v1[j] = silu_(v1[j]); } }
                    else if (act == 3) { f32x2 a = gelu_pk((f32x2){v0[0], v0[1]}), b = gelu_pk((f32x2){v0[2], v0[3]}), cc = gelu_pk((f32x2){v1[0], v1[1]}), d = gelu_pk((f32x2){v1[2], v1[3]});
                        v0 = (f32x4){a.x, a.y, b.x, b.y}; v1 = (f32x4){cc.x, cc.y, d.x, d.y};
                        s1 += ((v0[0] + v0[1]) + (v0[2] + v0[3])) + ((v1[0] + v1[1]) + (v1[2] + v1[3]));
                        s2 += ((v0[0] * v0[0] + v0[1] * v0[1]) + (v0[2] * v0[2] + v0[3] * v0[3])) + ((v1[0] * v1[0] + v1[1] * v1[1]) + (v1[2] * v1[2] + v1[3] * v1[3])); }
                    else if (act == 4) {
#pragma unroll
                        for (int j = 0; j < 4; ++j) { v0[j] = sigmoid_(v0[j]); v1[j] = sigmoid_(v1[j]); } }
                    else if (act == 5 || act == 6) { float* o = out + (act == 5 ? O_KP : O_VP) + (size_t)row * 256 + (c - (act == 5 ? HC_K : HC_V)); *(f32x4*)o = v0; *(f32x4*)(o + 4) = v1;
                        if (ATT_FP8) { int w0 = __builtin_amdgcn_cvt_pk_fp8_f32(v0[0], v0[1], 0, false); w0 = __builtin_amdgcn_cvt_pk_fp8_f32(v0[2], v0[3], w0, true);
                            int w1 = __builtin_amdgcn_cvt_pk_fp8_f32(v1[0], v1[1], 0, false); w1 = __builtin_amdgcn_cvt_pk_fp8_f32(v1[2], v1[3], w1, true);
                            *(v2u*)(KV8 + (size_t)row * 512 + (act == 5 ? 0 : 256) + (c - (act == 5 ? HC_K : HC_V))) = (v2u){(unsigned)w0, (unsigned)w1}; st = false; } }
                    else if (act == 7) { const int cl = c - HC_WI;
                        if (cl < 16) { float* o = WI + (size_t)row * 16 + cl; *(f32x4*)o = v0 * WSCALE; *(f32x4*)(o + 4) = v1 * WSCALE; st = false; }
                        else if (cl < 144) { float* o = out + O_KIP + (size_t)row * 128 + (cl - 16); *(f32x4*)o = v0; *(f32x4*)(o + 4) = v1;
                            if (IDX_FP8) { int w0 = __builtin_amdgcn_cvt_pk_fp8_f32(v0[0], v0[1], 0, false); w0 = __builtin_amdgcn_cvt_pk_fp8_f32(v0[2], v0[3], w0, true);
                                int w1 = __builtin_amdgcn_cvt_pk_fp8_f32(v1[0], v1[1], 0, false); w1 = __builtin_amdgcn_cvt_pk_fp8_f32(v1[2], v1[3], w1, true);
                                *(v2u*)(KI8 + (size_t)row * 128 + (cl - 16)) = (v2u){(unsigned)w0, (unsigned)w1}; } }
                        else st = false; }
                    if (st) { u32x4 w; w.x = cvtpk(v0[0], v0[1]); w.y = cvtpk(v0[2], v0[3]); w.z = cvtpk(v1[0], v1[1]); w.w = cvtpk(v1[2], v1[3]); store16_wt(hrow + c, w); } }
                if (pn >= 23 && pn < 27) {
                    s1 = xrows_add(s1); s2 = xrows_add(s2);
                    if (fq == 0) *(f32x2*)(PSV + ((size_t)row * 16 + (pn - 23) * 4 + wc) * 2) = (f32x2){s1, s2}; } }
    }
};
struct EpiMix {
    static constexpr bool PERM = true, AFTER_DRAIN = false, KEEP = true;
    const bf16_t* H; bf16_t* MIX;
    __device__ __forceinline__ void operator()(f32x4 (&acc)[2][2][4][2], const Unit& u, int wr, int wc, int fr, int fq) const {
        const int row0 = u.pm * BM + wr * 64 + fr, col0 = u.pn * BM + wc * 32 + 8 * fq;
#pragma unroll
        for (int ai = 0; ai < 2; ++ai) {
            u32x4 gb[4][2], ga[4][2];
#pragma unroll
            for (int m = 0; m < 4; ++m)
#pragma unroll
                for (int bj = 0; bj < 2; ++bj) { const bf16_t* hp = H + (size_t)(row0 + ai * HALF + m * 16) * LDH + col0 + bj * HALF;
                    gb[m][bj] = *(const u32x4*)(hp + HC_GB); if (u.kind == 0) ga[m][bj] = *(const u32x4*)(hp + HC_GA); }
            __builtin_amdgcn_sched_barrier(0);
#pragma unroll
            for (int m = 0; m < 4; ++m) { const int row = row0 + ai * HALF + m * 16;
#pragma unroll
                for (int bj = 0; bj < 2; ++bj) { const int c = col0 + bj * HALF; const u32x4 gbv = gb[m][bj];
                    float b[8] = {bflo(gbv.x), bfhi(gbv.x), bflo(gbv.y), bfhi(gbv.y), bflo(gbv.z), bfhi(gbv.z), bflo(gbv.w), bfhi(gbv.w)};
                    if (u.kind == 0) {
                        const u32x4 gav = ga[m][bj];
                        float a[8] = {bflo(gav.x), bfhi(gav.x), bflo(gav.y), bfhi(gav.y), bflo(gav.z), bfhi(gav.z), bflo(gav.w), bfhi(gav.w)};
#pragma unroll
                        for (int j = 0; j < 4; ++j) { acc[ai][bj][m][0][j] *= a[j] * __builtin_amdgcn_rcpf(fmaxf(b[j], 1e-30f)); acc[ai][bj][m][1][j] *= a[4 + j] * __builtin_amdgcn_rcpf(fmaxf(b[4 + j], 1e-30f)); }
                    } else {
                        f32x4 v0 = acc[ai][bj][m][0], v1 = acc[ai][bj][m][1];
#pragma unroll
                        for (int j = 0; j < 4; ++j) { v0[j] *= b[j]; v1[j] *= b[4 + j]; }
                        u32x4 w; w.x = cvtpk(v0[0], v0[1]); w.y = cvtpk(v0[2], v0[3]); w.z = cvtpk(v1[0], v1[1]); w.w = cvtpk(v1[2], v1[3]); *(u32x4*)(MIX + (size_t)row * DM + c) = w; } } }
            __builtin_amdgcn_sched_barrier(0);
        }
    }
};
template <class Bar>
struct EpiOut {
    static constexpr bool PERM = false, AFTER_DRAIN = true, KEEP = false;
    const float* X; float* out; float* PS; const float* gf; Bar bar; unsigned* prb; unsigned long long t0;
    __device__ __forceinline__ void fused(f32x4 (&acc)[2][2][4][2], const Unit& u, int wr, int wc, int fr, int fq, PG8_LAS unsigned char* lds, int wid, int lane) const {
        PG8_LAS float* P = (PG8_LAS float*)lds;
        PG8_LAS float* R = (PG8_LAS float*)(lds + 4096);
        const int col0 = u.pn * BM + wc * 32 + 4 * fq;
#pragma unroll
        for (int ai = 0; ai < 2; ++ai) {
            f32x4 xv[4][2][2];
#pragma unroll
            for (int m = 0; m < 4; ++m) { const size_t off = (size_t)(u.pm * BM + ai * HALF + wr * 64 + m * 16 + fr) * DM + col0;
#pragma unroll
                for (int bj = 0; bj < 2; ++bj)
#pragma unroll
                    for (int n = 0; n < 2; ++n) xv[m][bj][n] = *(const f32x4*)(X + off + bj * HALF + n * 16); }
            __builtin_amdgcn_sched_barrier(0);
#pragma unroll
            for (int m = 0; m < 4; ++m) { const int rl = ai * HALF + wr * 64 + m * 16 + fr; float s = 0.f;
#pragma unroll
                for (int bj = 0; bj < 2; ++bj)
#pragma unroll
                    for (int n = 0; n < 2; ++n) { const f32x4 v = acc[ai][bj][m][n] + xv[m][bj][n];
                        acc[ai][bj][m][n] = v; s += (v[0] * v[0] + v[1] * v[1]) + (v[2] * v[2] + v[3] * v[3]); }
                s = xrows_add(s);
                if (fq == 0) P[rl * 4 + wc] = s; }
            __builtin_amdgcn_sched_barrier(0);
        }
        asm volatile("s_waitcnt lgkmcnt(0)" ::: "memory"); __builtin_amdgcn_s_barrier(); asm volatile("" ::: "memory");
        const int tid = wid * 64 + lane;
        if (tid < 256) { const float t = (P[tid * 4 + 0] + P[tid * 4 + 1]) + (P[tid * 4 + 2] + P[tid * 4 + 3]); PS[(size_t)(u.pm * BM + tid) * 8 + u.pn] = t; }
        if (prb && threadIdx.x == 0) atomicAdd(prb, (unsigned)(__builtin_amdgcn_s_memrealtime() - t0));
        bar();
        if (tid < 256) { const float* ps = PS + (size_t)(u.pm * BM + tid) * 8; const f32x4 p0 = *(const f32x4*)ps, p1 = *(const f32x4*)(ps + 4);
            const float ss = ((p0[0] + p0[1]) + (p0[2] + p0[3])) + ((p1[0] + p1[1]) + (p1[2] + p1[3]));
            R[tid] = 1.0f / sqrtf(ss * (1.f / DM) + RMS_EPS); }
        asm volatile("s_waitcnt lgkmcnt(0)" ::: "memory"); __builtin_amdgcn_s_barrier(); asm volatile("" ::: "memory");
        f32x4 gv[2][2];
#pragma unroll
        for (int bj = 0; bj < 2; ++bj)
#pragma unroll
            for (int n = 0; n < 2; ++n) gv[bj][n] = *(const f32x4*)(gf + col0 + bj * HALF + n * 16);
#pragma unroll
        for (int ai = 0; ai < 2; ++ai)
#pragma unroll
            for (int m = 0; m < 4; ++m) { const int rl = ai * HALF + wr * 64 + m * 16 + fr; const size_t off = (size_t)(u.pm * BM + rl) * DM + col0; const float rs = R[rl];
#pragma unroll
                for (int bj = 0; bj < 2; ++bj)
#pragma unroll
                    for (int n = 0; n < 2; ++n) *(f32x4*)(out + off + bj * HALF + n * 16) = acc[ai][bj][m][n] * rs * gv[bj][n]; }
    }
};
}

constexpr int RING_OFF = 0, RING_BYTES = 131072;
constexpr int LDSCTL_OFF = RING_BYTES, MISC_OFF = LDSCTL_OFF + 320;
constexpr int LDS_BYTES = 147456;

#define XB_TMO      128
#define XB_XCNT(j)  (256  + 64 * (j))
#define XB_XSUB(j)  (1280 + 64 * (j))
#define XB_XGEN(j)  (2304 + 64 * (j))
#define XB_TOP      3328
#define XB_TOPGEN   3392
#define XCD_BAR_WORDS 3456
#define XB_SPIN_CAP (1u << 18)
__device__ __forceinline__ unsigned xb_ld(unsigned* p)              { return __hip_atomic_load(p, __ATOMIC_RELAXED, __HIP_MEMORY_SCOPE_AGENT); }
__device__ __forceinline__ unsigned xb_add(unsigned* p, unsigned v) { return __hip_atomic_fetch_add(p, v, __ATOMIC_RELAXED, __HIP_MEMORY_SCOPE_AGENT); }
__device__ __forceinline__ unsigned xb_xcc_id() { return (unsigned)__builtin_amdgcn_s_getreg((3 << 11) | 20) & 0xFu; }
#define XB_SPIN(cond, bar) do { unsigned _sp = 0; while (cond) { __builtin_amdgcn_s_sleep(1); \
    if ((++_sp & 255u) == 0u) { if (xb_ld(&(bar)[XB_TMO])) break; if (_sp > XB_SPIN_CAP) { atomicAdd(&(bar)[XB_TMO], 1u); break; } } } } while (0)
struct XcdBarrier { unsigned* bar; unsigned x; volatile LAS unsigned* st; };
__device__ __forceinline__ XcdBarrier xcd_barrier_post(unsigned* bar, volatile LAS unsigned* st) {
    XcdBarrier b; b.bar = bar; b.x = xb_xcc_id(); b.st = st;
    if (threadIdx.x == 0) (void)xb_add(&bar[XB_XCNT(b.x)], 1u);
    return b;
}
__device__ __forceinline__ void xcd_barrier_complete(unsigned* bar, unsigned x, unsigned& nloc, unsigned& nx) {
    const unsigned G = gridDim.x * gridDim.y * gridDim.z;
    unsigned sum, cnt, mine, sp = 0u;
    for (;;) {
        sum = 0u; cnt = 0u; mine = 0u;
#pragma unroll
        for (unsigned j = 0; j < 16; ++j) { const unsigned c = xb_ld(&bar[XB_XCNT(j)]); sum += c; cnt += (c > 0u) ? 1u : 0u; mine = (j == x) ? c : mine; }
        if (sum == G) break;
        __builtin_amdgcn_s_sleep(1);
        if ((++sp & 255u) == 0u) { if (xb_ld(&bar[XB_TMO])) break; if (sp > XB_SPIN_CAP) { atomicAdd(&bar[XB_TMO], 1u); break; } }
    }
    nloc = mine > 0u ? mine : 1u; nx = cnt > 0u ? cnt : 1u;
}
__device__ __forceinline__ void xcd_barrier(const XcdBarrier& b) {
    asm volatile("s_waitcnt vmcnt(0)" ::: "memory");
    __syncthreads();
    if (threadIdx.x == 0) {
        unsigned* bar = b.bar;
        __builtin_amdgcn_s_waitcnt(0);
        unsigned nloc = b.st[0], nx = b.st[1];
        if (nloc == 0u) { xcd_barrier_complete(bar, b.x, nloc, nx); b.st[0] = nloc; b.st[1] = nx; }
        const unsigned old = xb_add(&bar[XB_XSUB(b.x)], 1u);
        const unsigned gen = old / nloc;
        asm volatile("buffer_inv sc1" ::: "memory");
        if (old + 1u == (gen + 1u) * nloc) {
            __builtin_amdgcn_fence(__ATOMIC_RELEASE, "agent");
            asm volatile("s_waitcnt vmcnt(0)" ::: "memory");
            const unsigned og = xb_add(&bar[XB_TOP], 1u);
            const unsigned tg = og / nx;
            if (og + 1u == (tg + 1u) * nx) xb_add(&bar[XB_TOPGEN], 1u);
            else XB_SPIN(xb_ld(&bar[XB_TOPGEN]) == tg, bar);
            xb_add(&bar[XB_XGEN(b.x)], 1u);
            asm volatile("s_waitcnt vmcnt(0)" ::: "memory");
        } else {
            XB_SPIN(xb_ld(&bar[XB_XGEN(b.x)]) == gen, bar);
            asm volatile("s_waitcnt vmcnt(0)" ::: "memory");
        }
    }
    __syncthreads();
}

#ifndef PROBE_ID
#define PROBE_ID -1
#endif
constexpr int CW_PROBE = 2048;
#ifndef PROBE_QUANT
#define PROBE_QUANT 1u
#endif
#define PRB_Q(x) (((x) / PROBE_QUANT) * PROBE_QUANT)
#define PRB_T() (PROBE_ID >= 0 ? __builtin_amdgcn_s_memrealtime() : 0ull)
#define PRB_ADD(k, t0) do { if (PROBE_ID >= 0 && threadIdx.x == 0) atomicAdd((unsigned*)(((gu32*)(F.ws + WS_CTL)) + CW_PROBE + (k)), (unsigned)(__builtin_amdgcn_s_memrealtime() - (t0))); } while (0)
struct Args { const void* in[16]; float* out; unsigned char* ws; int ph_lo, ph_hi, li, pad; };
#define WSB(off) ((bf16*)(F.ws + (off)))
#define WSF(off) ((float*)(F.ws + (off)))
struct In { const float *xp, *xs, *ck, *cv, *cki, *gin, *win, *wpa, *wpb, *wo, *lng, *lnb, *wsp, *bsp, *gf; const int* pt; };
struct Ctx {
    LAS unsigned char* lds; int tid, lane, wave, G, bid;
    float* out; unsigned char* ws;
};

__device__ __forceinline__ unsigned f2bf(float f) { unsigned u = __builtin_bit_cast(unsigned, f); return (u + 0x7fffu + ((u >> 16) & 1u)) >> 16; }
__device__ __forceinline__ unsigned pk2(float lo, float hi) { return f2bf(lo) | (f2bf(hi) << 16); }
template <bool SAMP = false>
__device__ __forceinline__ void p0_transpose_item(const float* W, int K, int Nsrc, bf16* WT, bool remap, int kb, int nb, int lane, const float* xs = nullptr, const float* gn = nullptr, float* part = nullptr) {
    const int k0 = 64 * kb, nd = 64 * nb + lane; int ns = nd; bool ok = true;
    if (remap) { if (nd >= 3840) ns = nd - 112; else if (nd >= 3728) { ok = false; ns = 0; } }
    const float* src = W + (size_t)k0 * Nsrc + ns;
    float v[64];
#pragma unroll
    for (int i = 0; i < 64; ++i) v[i] = __builtin_nontemporal_load(&src[(size_t)i * Nsrc]);
    if (SAMP) {
        float xv[8], acc[8];
        const float gk = gn[k0 + lane];
#pragma unroll
        for (int s_ = 0; s_ < 8; ++s_) { xv[s_] = xs[(size_t)s_ * DM + k0 + lane] * gk; acc[s_] = 0.f; }
#pragma unroll
        for (int i = 0; i < 64; ++i)
#pragma unroll
            for (int s_ = 0; s_ < 8; ++s_) acc[s_] += __builtin_bit_cast(float, __builtin_amdgcn_readlane(__builtin_bit_cast(int, xv[s_]), i)) * v[i];
#pragma unroll
        for (int s_ = 0; s_ < 8; ++s_) part[(size_t)(kb * 8 + s_) * LDH + nd] = acc[s_];
    }
    v4u* dst = (v4u*)(WT + (size_t)nd * K + k0);
#pragma unroll
    for (int j = 0; j < 8; ++j) { v4u o; o.x = cvtpk(v[8 * j], v[8 * j + 1]); o.y = cvtpk(v[8 * j + 2], v[8 * j + 3]); o.z = cvtpk(v[8 * j + 4], v[8 * j + 5]); o.w = cvtpk(v[8 * j + 6], v[8 * j + 7]);
        if (!ok) o = (v4u){0u, 0u, 0u, 0u};
        dst[j] = o; }
}
__device__ __forceinline__ void rms_row_to_bf16(const float* xrow, const float* g, bf16* orow, int lane) {
    const f32x4* xr = (const f32x4*)xrow + lane; const f32x4* gr = (const f32x4*)g + lane;
    f32x4 v[8]; float s = 0.f;
#pragma unroll
    for (int j = 0; j < 8; ++j) { v[j] = __builtin_nontemporal_load(&xr[64 * j]); s += (v[j].x * v[j].x + v[j].y * v[j].y) + (v[j].z * v[j].z + v[j].w * v[j].w); }
    const float rstd = 1.0f / sqrtf(wave_sum(s) * (1.f / DM) + RMS_EPS);
    v2u* o8 = (v2u*)orow + lane;
#pragma unroll
    for (int j = 0; j < 8; ++j) { const f32x4 gg = gr[64 * j]; v2u w; w.x = cvtpk(v[j].x * rstd * gg.x, v[j].y * rstd * gg.y); w.y = cvtpk(v[j].z * rstd * gg.z, v[j].w * rstd * gg.w); o8[64 * j] = w; }
}
__device__ __forceinline__ void p0_prologue(Ctx& F, const In& I) {
    int lane = F.lane; asm volatile("" : "+v"(lane));
    const int gw = F.bid * 8 + F.wave, NGW = F.G * 8;
    constexpr int NB_IN = LDH / 64, I_IN = (DM / 64) * NB_IN;
    constexpr int I_A = (1024 / 64) * (DM / 64), I_O = (DM / 64) * (DM / 64);
    constexpr int NITEMS = I_IN + 2 * I_A + I_O;
#pragma unroll 1
    for (int it = gw; it < I_IN; it += NGW) p0_transpose_item<true>(I.win, DM, IN_WIDTH, WSB(WS_WTIN), true, it / NB_IN, it % NB_IN, lane, I.xs, I.gin, WSF(WS_SC));
    for (int m = gw; m < MP + NS; m += NGW) {
        if (m < MP) rms_row_to_bf16(I.xp + (size_t)m * DM, I.gin, WSB(WS_XN) + (size_t)m * DM, lane);
        else rms_row_to_bf16(I.xs + (size_t)(m - MP) * DM, I.gin, WSB(WS_XNS) + (size_t)(m - MP) * DM, lane);
    }
}

__device__ __forceinline__ void p2_wt_item(Ctx& F, const In& I, int item) {
    int lane = F.lane; asm volatile("" : "+v"(lane));
    constexpr int I_A = (1024 / 64) * (DM / 64);
    int r = item * 8 + F.wave;
    if (r < I_A) p0_transpose_item(I.wpa, 1024, DM, WSB(WS_WTA), false, r / (DM / 64), r % (DM / 64), lane);
    else if (r < 2 * I_A) { r -= I_A; p0_transpose_item(I.wpb, 1024, DM, WSB(WS_WTB), false, r / (DM / 64), r % (DM / 64), lane); }
    else { r -= 2 * I_A; p0_transpose_item(I.wo, DM, DM, WSB(WS_WTO), false, r / (DM / 64), r % (DM / 64), lane); }
}

template <int NSTEPS>
__device__ __forceinline__ f32x4 sgemv_part_t(const bf16* X, int ldx, const bf16* Wt, int ldw, int n0, int kbeg, int lane) {
    const int r = lane & 15, q = lane >> 4;
    const bf16* xp = X + (size_t)(r & 7) * ldx + kbeg + 8 * q; const bf16* wp = Wt + (size_t)(n0 + r) * ldw + kbeg + 8 * q;
    const bf16x8 z = {0, 0, 0, 0, 0, 0, 0, 0};
    bf16x8 a[NSTEPS], b[NSTEPS];
#pragma unroll
    for (int st = 0; st < NSTEPS; ++st) { a[st] = *(const bf16x8*)(xp + 32 * st); b[st] = *(const bf16x8*)(wp + 32 * st); }
    __builtin_amdgcn_sched_barrier(0);
    f32x4 acc = {0.f, 0.f, 0.f, 0.f};
#pragma unroll
    for (int st = 0; st < NSTEPS; ++st) acc = __builtin_amdgcn_mfma_f32_16x16x32_bf16(r >= 8 ? z : a[st], b[st], acc, 0, 0, 0);
    return acc;
}
__device__ __forceinline__ f32x4 sgemv_part(const bf16* X, int ldx, const bf16* Wt, int ldw, int n0, int kbeg, int nsteps, int lane) {
    return nsteps == 8 ? sgemv_part_t<8>(X, ldx, Wt, ldw, n0, kbeg, lane) : sgemv_part_t<4>(X, ldx, Wt, ldw, n0, kbeg, lane);
}
__device__ __forceinline__ f32x4 block_reduce8(f32x4 v, LAS float* red, int wave, int lane) {
    *(LAS f32x4*)(red + (wave * 64 + lane) * 4) = v;
    __syncthreads();
    f32x4 s = {0.f, 0.f, 0.f, 0.f};
    if (wave == 0) {
#pragma unroll
        for (int w = 0; w < 8; ++w) s += *(LAS f32x4*)(red + (w * 64 + lane) * 4);
    }
    __syncthreads();
    return s;
}
__device__ __forceinline__ void finish_sample_col(Ctx& F, int s, int n, float v) {
    float h = v;
    if (n < HC_K) h = v * QSCALE;
    else if (n < HC_V) F.out[O_KS + s * 256 + (n - HC_K)] = v;
    else if (n < HC_QI) F.out[O_VS + s * 256 + (n - HC_V)] = v;
    else if (n < HC_WI) {}
    else if (n < HC_KI) h = v * WSCALE;
    else if (n < 3728) F.out[O_KIS + s * 128 + (n - HC_KI)] = v;
    else if (n < HC_ZA) h = 0.f;
    else if (n < HC_U) h = silu_(v);
    else if (n < HC_ZB) h = 0.5f * v * (1.0f + erff(v * 0.70710678118654752f));
    else if (n < HC_GA) h = silu_(v);
    else h = sigmoid_(v);
    WSF(WS_HS)[(size_t)s * LDH + n] = h;
}
__device__ __forceinline__ void p1_sample_inproj(Ctx& F) {
    LAS float* red = (LAS float*)(F.lds + RING_OFF);
    int lane = F.lane; asm volatile("" : "+v"(lane));
    const int r = lane & 15, q = lane >> 4, kbeg = F.wave * 256;
    const bf16x8 z = {0, 0, 0, 0, 0, 0, 0, 0};
    for (int it0 = F.bid; it0 < LDH / 16; it0 += 3 * F.G) {
        const bf16* xp = WSB(WS_XNS) + (size_t)(r & 7) * DM + kbeg + 8 * q;
        bf16x8 a[8], b[3][8];
#pragma unroll
        for (int st = 0; st < 8; ++st) a[st] = *(const bf16x8*)(xp + 32 * st);
#pragma unroll
        for (int i = 0; i < 3; ++i) { const int it = min(it0 + i * F.G, LDH / 16 - 1); const bf16* wp = WSB(WS_WTIN) + (size_t)(16 * it + r) * DM + kbeg + 8 * q;
#pragma unroll
            for (int st = 0; st < 8; ++st) b[i][st] = *(const bf16x8*)(wp + 32 * st); }
        __builtin_amdgcn_sched_barrier(0);
#pragma unroll
        for (int i = 0; i < 3; ++i) { f32x4 acc = {0.f, 0.f, 0.f, 0.f};
#pragma unroll
            for (int st = 0; st < 8; ++st) acc = __builtin_amdgcn_mfma_f32_16x16x32_bf16(r >= 8 ? z : a[st], b[i][st], acc, 0, 0, 0);
            *(LAS f32x4*)(red + ((i * 8 + F.wave) * 64 + lane) * 4) = acc; }
        __syncthreads();
        if (F.wave < 3 && it0 + F.wave * F.G < LDH / 16) {
            f32x4 sacc = {0.f, 0.f, 0.f, 0.f};
#pragma unroll
            for (int w = 0; w < 8; ++w) sacc += *(LAS f32x4*)(red + ((F.wave * 8 + w) * 64 + lane) * 4);
            const int n0 = 16 * (it0 + F.wave * F.G);
            if (lane < 32) {
#pragma unroll
                for (int j = 0; j < 4; ++j) finish_sample_col(F, 4 * (lane >> 4) + j, n0 + (lane & 15), sacc[j]);
            }
        }
        __syncthreads();
    }
}

__device__ __forceinline__ void p1_sample_finish(Ctx& F, const float* xs, int first, int nwg) {
    LAS float* rs = (LAS float*)(F.lds + RING_OFF);
    { const f32x4* xr = (const f32x4*)(xs + (size_t)F.wave * DM) + F.lane; float q = 0.f;
#pragma unroll
      for (int j = 0; j < 8; ++j) { const f32x4 v = xr[64 * j]; q += (v.x * v.x + v.y * v.y) + (v.z * v.z + v.w * v.w); }
      const float rstd = 1.0f / sqrtf(wave_sum(q) * (1.f / DM) + RMS_EPS);
      if (F.lane == 0) rs[F.wave] = rstd; }
    __syncthreads();
    const float* part = WSF(WS_SC);
    for (int idx = (F.bid - first) * 512 + F.tid; idx < NS * LDH; idx += nwg * 512) {
        const int s_ = idx / LDH, n = idx - s_ * LDH;
        float pv[32];
#pragma unroll
        for (int kb = 0; kb < 32; ++kb) pv[kb] = part[(size_t)(kb * 8 + s_) * LDH + n];
        float acc = 0.f;
#pragma unroll
        for (int kb = 0; kb < 32; ++kb) acc += pv[kb];
        finish_sample_col(F, s_, n, acc * rs[s_]);
    }
    __syncthreads();
}

__device__ __forceinline__ int wave_excl_scan(int v, int lane) {
    int x = v;
    x += dppi<0x111>(x); x += dppi<0x112>(x); x += dppi<0x114>(x); x += dppi<0x118>(x);
    const int t0 = __builtin_amdgcn_readlane(x, 15), t1 = __builtin_amdgcn_readlane(x, 31), t2 = __builtin_amdgcn_readlane(x, 47);
    x += (lane >= 16 ? t0 : 0) + (lane >= 32 ? t1 : 0) + (lane >= 48 ? t2 : 0);
    return x - v;
}
__device__ __forceinline__ void hist_find(const LAS unsigned* hist, int lane, int need, int& bin, int& above, int& cnt) {
    const v4u h0 = *(const LAS v4u*)(hist + 504 - 8 * lane), h1 = *(const LAS v4u*)(hist + 508 - 8 * lane);
    const int a[8] = {(int)h1.w, (int)h1.z, (int)h1.y, (int)h1.x, (int)h0.w, (int)h0.z, (int)h0.y, (int)h0.x};
    const int tot = ((a[0] + a[1]) + (a[2] + a[3])) + ((a[4] + a[5]) + (a[6] + a[7]));
    const int ex = wave_excl_scan(tot, lane);
    const unsigned long long m = __ballot(ex + tot >= need);
    const int L = m ? (int)__builtin_ctzll(m) : 63;
    int acc = ex, fb = 0, fa = 0, fc = 0; bool done = false;
#pragma unroll
    for (int j = 0; j < 8; ++j) { const bool hit = !done && (acc + a[j] >= need); if (hit) { fb = 511 - 8 * lane - j; fa = acc; fc = a[j]; done = true; } acc += a[j]; }
    bin = __builtin_amdgcn_readlane(fb, L); above = __builtin_amdgcn_readlane(fa, L); cnt = __builtin_amdgcn_readlane(fc, L);
}
template <int NREG>
__device__ __forceinline__ void wave_select256(const float (&s)[NREG], int n_valid, int lane, LAS unsigned short* list, LAS unsigned* hist) {
    float mx = -INFINITY, mn = INFINITY;
#pragma unroll
    for (int i = 0; i < NREG; ++i) { mx = fmaxf(mx, s[i]); mn = fminf(mn, s[i] == -INFINITY ? INFINITY : s[i]); }
    mx = wave_max(mx); mn = wave_min(mn);
    const float scale = (mx > mn) ? 262143.0f / (mx - mn) : 0.f;
    int k[NREG];
#pragma unroll
    for (int i = 0; i < NREG; ++i) { const int q = (int)((s[i] - mn) * scale); k[i] = (s[i] == -INFINITY) ? -1 : (q < 0 ? 0 : (q > 262143 ? 262143 : q)); }
    *(LAS v4u*)(hist + 8 * lane) = (v4u){0u, 0u, 0u, 0u}; *(LAS v4u*)(hist + 8 * lane + 4) = (v4u){0u, 0u, 0u, 0u};
    LDS_WAIT();
#pragma unroll
    for (int i = 0; i < NREG; ++i) __hip_atomic_fetch_add(hist + (k[i] >= 0 ? (k[i] >> 9) : 512 + lane), 1u, __ATOMIC_RELAXED, __HIP_MEMORY_SCOPE_WAVEFRONT);
    LDS_WAIT();
    int b1, ab1, c1; hist_find(hist, lane, 256, b1, ab1, c1);
    LDS_WAIT();
    *(LAS v4u*)(hist + 8 * lane) = (v4u){0u, 0u, 0u, 0u}; *(LAS v4u*)(hist + 8 * lane + 4) = (v4u){0u, 0u, 0u, 0u};
    LDS_WAIT();
#pragma unroll
    for (int i = 0; i < NREG; ++i) __hip_atomic_fetch_add(hist + ((k[i] >> 9) == b1 ? (k[i] & 511) : 512 + lane), 1u, __ATOMIC_RELAXED, __HIP_MEMORY_SCOPE_WAVEFRONT);
    LDS_WAIT();
    int b2, ab2, c2; hist_find(hist, lane, 256 - ab1, b2, ab2, c2);
    const int T = (b1 << 9) | b2; const int need_eq = 256 - ab1 - ab2;
    int cg = 0, ce = 0;
#pragma unroll
    for (int i = 0; i < NREG; ++i) { cg += (k[i] > T) ? 1 : 0; ce += (k[i] == T) ? 1 : 0; }
    const int ex = wave_excl_scan(cg | (ce << 16), lane);
    int pg = ex & 0xffff, re = ex >> 16;
    const int ngt = 256 - need_eq;
    int T2 = T; asm volatile("" : "+s"(T2));
    int sl = lane;
#pragma unroll
    for (int i = 0; i < NREG; ++i) {
        const bool g_ = k[i] > T2, e_ = k[i] == T2;
        const int pos = g_ ? pg : ((e_ && re < need_eq) ? ngt + re : 256 + lane);
        list[pos] = (unsigned short)sl; pg += g_ ? 1 : 0; re += e_ ? 1 : 0;
        sl += 64; asm volatile("" : "+v"(sl));
    }
    LDS_WAIT();
}

struct RowSrc { const unsigned short* Hb; const float* ck; const float* cv; const int* pt; const float* knew; const float* vnew; };
template <bool SAMPLE>
__device__ __forceinline__ void attn_part(const RowSrc& R, int g, const LAS unsigned short* list, int k0, int nstep, int nsel, LAS unsigned char* vst, const bf16x8 (&qf)[4], float& m_out, float& l_out, f32x4 (&o)[8], int lane) {
    const int r16 = lane & 15, q4 = lane >> 4;
    float m = -1e30f, l = 0.f;
#pragma unroll
    for (int db = 0; db < 8; ++db) o[db] = (f32x4){0.f, 0.f, 0.f, 0.f};
    const LAS unsigned char* vb = vst + (4 * q4 + (r16 >> 2)) * 288 + (r16 & 3) * 8;
#pragma unroll 1
    for (int ks = 0; ks < nstep; ++ks) {
        const int sb = k0 + ks * 32;
        bf16x8 ka[2][4]; v4u vw[8];
#pragma unroll
        for (int grp = 0; grp < 2; ++grp) {
            const int slot = sb + grp * 16 + r16; const int key = list[slot < nsel ? slot : 0];
            if constexpr (!SAMPLE) {
                const unsigned short* kp = R.Hb + (size_t)key * LDH + HC_K + g * 128 + 8 * q4;
#pragma unroll
                for (int st = 0; st < 4; ++st) ka[grp][st] = *(const bf16x8*)(kp + 32 * st);
            } else {
                const float* kp = (key < PAST) ? R.ck + ((size_t)(R.pt[key >> 7] * PAGE + (key & 127)) * 2 + g) * 128 : R.knew + g * 128;
                kp += 8 * q4;
#pragma unroll
                for (int st = 0; st < 4; ++st) ka[grp][st] = cvt8(*(const f32x4*)(kp + 32 * st), *(const f32x4*)(kp + 32 * st + 4));
            }
        }
#pragma unroll
        for (int i = 0; i < 8; ++i) {
            const int slot = sb + 4 * i + q4; const int key = list[slot < nsel ? slot : 0];
            if constexpr (!SAMPLE) vw[i] = *(const v4u*)(R.Hb + (size_t)key * LDH + HC_V + g * 128 + r16 * 8);
            else { const float* vp = (key < PAST) ? R.cv + ((size_t)(R.pt[key >> 7] * PAGE + (key & 127)) * 2 + g) * 128 : R.vnew + g * 128;
                   vw[i] = __builtin_bit_cast(v4u, cvt8(*(const f32x4*)(vp + r16 * 8), *(const f32x4*)(vp + r16 * 8 + 4))); }
        }
        f32x4 c[2];
#pragma unroll
        for (int grp = 0; grp < 2; ++grp) {
            c[grp] = (f32x4){0.f, 0.f, 0.f, 0.f};
#pragma unroll
            for (int st = 0; st < 4; ++st) c[grp] = __builtin_amdgcn_mfma_f32_16x16x32_bf16(ka[grp][st], qf[st], c[grp], 0, 0, 0);
#pragma unroll
            for (int r = 0; r < 4; ++r) { const int sl = sb + grp * 16 + 4 * q4 + r; c[grp][r] = sl < nsel ? c[grp][r] : -1e30f; }
        }
        float ml = fmaxf(fmaxf(fmaxf(c[0][0], c[0][1]), fmaxf(c[0][2], c[0][3])), fmaxf(fmaxf(c[1][0], c[1][1]), fmaxf(c[1][2], c[1][3])));
        ml = xrows_max(ml);
        const float mn = fmaxf(m, ml), f = __builtin_amdgcn_exp2f(m - mn);
        m = mn; l *= f;
#pragma unroll
        for (int db = 0; db < 8; ++db) o[db] = o[db] * f;
#pragma unroll
        for (int grp = 0; grp < 2; ++grp)
#pragma unroll
            for (int r = 0; r < 4; ++r) { const float p = __builtin_amdgcn_exp2f(c[grp][r] - m); c[grp][r] = p; l += p; }
        v4u pw; pw.x = cvtpk(c[0][0], c[0][1]); pw.y = cvtpk(c[0][2], c[0][3]); pw.z = cvtpk(c[1][0], c[1][1]); pw.w = cvtpk(c[1][2], c[1][3]);
        const bf16x8 pf = __builtin_bit_cast(bf16x8, pw);
#pragma unroll
        for (int i = 0; i < 8; ++i) *(LAS v4u*)(vst + (4 * i + q4) * 288 + r16 * 16) = vw[i];
        LDS_WAIT();
#pragma unroll
        for (int db = 0; db < 8; ++db) {
            const s16x4 lo = __builtin_bit_cast(s16x4, __builtin_amdgcn_ds_read_tr16_b64_v4i16((LAS s16x4*)(vb + db * 32)));
            const s16x4 hi = __builtin_bit_cast(s16x4, __builtin_amdgcn_ds_read_tr16_b64_v4i16((LAS s16x4*)(vb + 16 * 288 + db * 32)));
            const bf16x8 vf = {lo[0], lo[1], lo[2], lo[3], hi[0], hi[1], hi[2], hi[3]};
            o[db] = __builtin_amdgcn_mfma_f32_16x16x32_bf16(vf, pf, o[db], 0, 0, 0);
        }
        LDS_WAIT();
    }
    l = xrows_add(l);
    m_out = m; l_out = l;
}

#if ATT_FP8
typedef v4u kfrag_t[2][2];
typedef v4u vfrag_t[4];
#define AT_NV 4
__device__ __forceinline__ void cvt16_fp8(const v4u w, bf16x8& lo, bf16x8& hi) {
    unsigned r[8];
#pragma unroll
    for (int j = 0; j < 4; ++j) { const f32x2 a = __builtin_amdgcn_cvt_pk_f32_fp8((int)w[j], false), b = __builtin_amdgcn_cvt_pk_f32_fp8((int)w[j], true); r[2 * j] = cvtpk(a.x, a.y); r[2 * j + 1] = cvtpk(b.x, b.y); }
    lo = __builtin_bit_cast(bf16x8, (v4u){r[0], r[1], r[2], r[3]}); hi = __builtin_bit_cast(bf16x8, (v4u){r[4], r[5], r[6], r[7]});
}
typedef long qfrag_t;
#else
typedef bf16x8 kfrag_t[2][4];
typedef v4u vfrag_t[8];
typedef bf16x8 qfrag_t;
#define AT_NV 8
#endif
__device__ __forceinline__ void at_qfrags(const unsigned short* qrow, int r16, int q4, qfrag_t (&qf)[4]) {
    v4u w[4];
#pragma unroll
    for (int st = 0; st < 4; ++st) w[st] = *(const v4u*)(qrow + (ATT_FP8 ? 64 * (st >> 1) + 16 * q4 + 8 * (st & 1) : 32 * st + 8 * q4));
    __builtin_amdgcn_sched_barrier(0);
#pragma unroll
    for (int st = 0; st < 4; ++st) {
#if ATT_FP8
        const float is = 1.0f / QSCALE; int lo = 0, hi = 0;
        lo = __builtin_amdgcn_cvt_pk_fp8_f32(bflo(w[st].x) * is, bfhi(w[st].x) * is, lo, false); lo = __builtin_amdgcn_cvt_pk_fp8_f32(bflo(w[st].y) * is, bfhi(w[st].y) * is, lo, true);
        hi = __builtin_amdgcn_cvt_pk_fp8_f32(bflo(w[st].z) * is, bfhi(w[st].z) * is, hi, false); hi = __builtin_amdgcn_cvt_pk_fp8_f32(bflo(w[st].w) * is, bfhi(w[st].w) * is, hi, true);
        const long v = (long)(((unsigned long long)(unsigned)hi << 32) | (unsigned long long)(unsigned)lo);
        qf[st] = r16 < 4 ? v : 0l;
#else
        const bf16x8 z = {0, 0, 0, 0, 0, 0, 0, 0};
        qf[st] = r16 < 4 ? __builtin_bit_cast(bf16x8, w[st]) : z;
#endif
    }
}
template <bool FULL>
__device__ __forceinline__ void at_load(const unsigned short* Hb, const unsigned char* KVb, const LAS unsigned short* list, int nsel, int step, int lane, kfrag_t& ka, vfrag_t& vw) {
    const int g = step >> 3, sb = (step & 7) * 32, r16 = lane & 15, q4 = lane >> 4;
#pragma unroll
    for (int grp = 0; grp < 2; ++grp) {
        const int slot = sb + grp * 16 + r16; const int key = list[(FULL || slot < nsel) ? slot : 0];
#if ATT_FP8
        const unsigned char* kp = KVb + (size_t)key * 512 + g * 128 + 16 * q4;
        ka[grp][0] = *(const v4u*)kp; ka[grp][1] = *(const v4u*)(kp + 64);
#else
        const unsigned short* kp = Hb + (size_t)key * LDH + HC_K + g * 128 + 8 * q4;
#pragma unroll
        for (int st = 0; st < 4; ++st) ka[grp][st] = *(const bf16x8*)(kp + 32 * st);
#endif
    }
#if ATT_FP8
#pragma unroll
    for (int i = 0; i < 4; ++i) { const int slot = sb + 8 * i + (lane >> 3); const int key = list[(FULL || slot < nsel) ? slot : 0];
        vw[i] = *(const v4u*)(KVb + (size_t)key * 512 + 256 + g * 128 + (lane & 7) * 16); }
#else
#pragma unroll
    for (int i = 0; i < 8; ++i) { const int slot = sb + 4 * i + q4; const int key = list[(FULL || slot < nsel) ? slot : 0];
        vw[i] = *(const v4u*)(Hb + (size_t)key * LDH + HC_V + g * 128 + r16 * 8); }
#endif
}
template <bool FULL>
__device__ __forceinline__ void at_comp(const kfrag_t& ka, const vfrag_t& vw, const qfrag_t (&qf)[4], int step, int nsel, int lane, LAS unsigned char* vst, const LAS unsigned char* vb, float& m, float& l, f32x4 (&o)[8]) {
    const int sb = (step & 7) * 32, r16 = lane & 15, q4 = lane >> 4;
    f32x4 c[2];
#pragma unroll
    for (int grp = 0; grp < 2; ++grp) {
        c[grp] = (f32x4){0.f, 0.f, 0.f, 0.f};
#if ATT_FP8
#pragma unroll
        for (int j = 0; j < 2; ++j) { const v4u w = ka[grp][j];
            const long a0 = (long)(((unsigned long long)w.y << 32) | w.x), a1 = (long)(((unsigned long long)w.w << 32) | w.z);
            c[grp] = __builtin_amdgcn_mfma_f32_16x16x32_fp8_fp8(a0, qf[2 * j], c[grp], 0, 0, 0); c[grp] = __builtin_amdgcn_mfma_f32_16x16x32_fp8_fp8(a1, qf[2 * j + 1], c[grp], 0, 0, 0); }
        c[grp] = c[grp] * QSCALE;
#else
#pragma unroll
        for (int st = 0; st < 4; ++st) c[grp] = __builtin_amdgcn_mfma_f32_16x16x32_bf16(ka[grp][st], qf[st], c[grp], 0, 0, 0);
#endif
        if (!FULL)
#pragma unroll
        for (int r = 0; r < 4; ++r) { const int sl = sb + grp * 16 + 4 * q4 + r; c[grp][r] = sl < nsel ? c[grp][r] : -1e30f; }
    }
    float ml = fmaxf(fmaxf(fmaxf(c[0][0], c[0][1]), fmaxf(c[0][2], c[0][3])), fmaxf(fmaxf(c[1][0], c[1][1]), fmaxf(c[1][2], c[1][3])));
    ml = xrows_max(ml);
    if (__ballot(ml > m)) {
        const float mn = fmaxf(m, ml), f = __builtin_amdgcn_exp2f(m - mn);
        m = mn; l *= f;
#pragma unroll
        for (int db = 0; db < 8; ++db) o[db] = o[db] * f;
    }
#pragma unroll
    for (int grp = 0; grp < 2; ++grp)
#pragma unroll
        for (int r = 0; r < 4; ++r) { const float p = __builtin_amdgcn_exp2f(c[grp][r] - m); c[grp][r] = p; l += p; }
    v4u pw; pw.x = cvtpk(c[0][0], c[0][1]); pw.y = cvtpk(c[0][2], c[0][3]); pw.z = cvtpk(c[1][0], c[1][1]); pw.w = cvtpk(c[1][2], c[1][3]);
    const bf16x8 pf = __builtin_bit_cast(bf16x8, pw);
#if ATT_FP8
#pragma unroll
    for (int i = 0; i < 4; ++i) { const int srow = 8 * i + (lane >> 3); const int lrow = 8 * ((srow >> 2) & 3) + 4 * (srow >> 4) + (srow & 3);
        *(LAS v4u*)(vst + lrow * 144 + (lane & 7) * 16) = vw[i]; }
#else
#pragma unroll
    for (int i = 0; i < 8; ++i) *(LAS v4u*)(vst + (4 * i + q4) * 288 + r16 * 16) = vw[i];
#endif
    LDS_WAIT();
#if ATT_FP8
    {
        int p0 = 0, p1 = 0;
        p0 = __builtin_amdgcn_cvt_pk_fp8_f32(c[0][0], c[0][1], p0, false); p0 = __builtin_amdgcn_cvt_pk_fp8_f32(c[0][2], c[0][3], p0, true);
        p1 = __builtin_amdgcn_cvt_pk_fp8_f32(c[1][0], c[1][1], p1, false); p1 = __builtin_amdgcn_cvt_pk_fp8_f32(c[1][2], c[1][3], p1, true);
        const long pf8 = (long)(((unsigned long long)(unsigned)p1 << 32) | (unsigned long long)(unsigned)p0);
        const LAS unsigned char* vb8 = vst + (8 * q4 + (r16 >> 1)) * 144 + (r16 & 1) * 8;
#pragma unroll
        for (int db = 0; db < 8; ++db) {
            const v2i_t t = __builtin_amdgcn_ds_read_tr8_b64_v2i32((LAS v2i_t*)(vb8 + db * 16));
            const long vf8 = (long)(((unsigned long long)(unsigned)t[1] << 32) | (unsigned long long)(unsigned)t[0]);
            o[db] = __builtin_amdgcn_mfma_f32_16x16x32_fp8_fp8(vf8, pf8, o[db], 0, 0, 0);
        }
    }
#else
#pragma unroll
    for (int db = 0; db < 8; ++db) {
        const s16x4 lo = __builtin_bit_cast(s16x4, __builtin_amdgcn_ds_read_tr16_b64_v4i16((LAS s16x4*)(vb + db * 32)));
        const s16x4 hi = __builtin_bit_cast(s16x4, __builtin_amdgcn_ds_read_tr16_b64_v4i16((LAS s16x4*)(vb + 16 * 288 + db * 32)));
        const bf16x8 vf = {lo[0], lo[1], lo[2], lo[3], hi[0], hi[1], hi[2], hi[3]};
        o[db] = __builtin_amdgcn_mfma_f32_16x16x32_bf16(vf, pf, o[db], 0, 0, 0);
    }
#endif
    LDS_WAIT();
}
template <bool FULL>
__device__ __forceinline__ void attn_prompt_query(const unsigned short* Hb, const unsigned char* KVb, int t, bf16* orow, const LAS unsigned short* list, int nsel, LAS unsigned char* vst, int lane) {
    const int r16 = lane & 15, q4 = lane >> 4;
    const LAS unsigned char* vb = vst + (4 * q4 + (r16 >> 2)) * 288 + (r16 & 3) * 8;
    kfrag_t kaA, kaB; vfrag_t vwA, vwB; qfrag_t qf[4];
    float m = -1e30f, l = 0.f; f32x4 o[8];
#pragma unroll
    for (int db = 0; db < 8; ++db) o[db] = (f32x4){0.f, 0.f, 0.f, 0.f};
    { const unsigned short* qp = Hb + (size_t)t * LDH + HC_Q + (r16 & 3) * 128;
      at_qfrags(qp, r16, q4, qf); }
    kfrag_t kaC; vfrag_t vwC;
#define AT_FINAL(g) do { v2u zz_[8]; const unsigned short* zp_ = Hb + (size_t)t * LDH + HC_ZA + ((g) * 4 + (r16 & 3)) * 128 + 4 * q4; \
        _Pragma("unroll") for (int db = 0; db < 8; ++db) zz_[db] = *(const v2u*)(zp_ + db * 16);     \
        l = xrows_add(l); \
        __builtin_amdgcn_sched_barrier(0); \
        if (r16 < 4) { const float rl = 1.0f / l; bf16* op = orow + ((g) * 4 + r16) * 128 + 4 * q4; \
            _Pragma("unroll") for (int db = 0; db < 8; ++db) { const v2u zz = zz_[db]; \
                v2u ww; ww.x = cvtpk(o[db][0] * rl * bflo(zz.x), o[db][1] * rl * bfhi(zz.x)); ww.y = cvtpk(o[db][2] * rl * bflo(zz.y), o[db][3] * rl * bfhi(zz.y)); \
                *(v2u*)(op + db * 16) = ww; } } } while (0)
    at_load<FULL>(Hb, KVb, list, nsel, 0, lane, kaA, vwA); at_load<FULL>(Hb, KVb, list, nsel, 1, lane, kaB, vwB);
#pragma unroll 1
    for (int it = 0; it < 5; ++it) {
        at_load<FULL>(Hb, KVb, list, nsel, 3 * it + 2, lane, kaC, vwC);
        at_comp<FULL>(kaA, vwA, qf, 3 * it, nsel, lane, vst, vb, m, l, o);
        at_load<FULL>(Hb, KVb, list, nsel, 3 * it + 3, lane, kaA, vwA);
        at_comp<FULL>(kaB, vwB, qf, 3 * it + 1, nsel, lane, vst, vb, m, l, o);
        if (it == 2) {
            AT_FINAL(0);
            m = -1e30f; l = 0.f;
#pragma unroll
            for (int db = 0; db < 8; ++db) o[db] = (f32x4){0.f, 0.f, 0.f, 0.f};
            const unsigned short* qp = Hb + (size_t)t * LDH + HC_Q + (4 + (r16 & 3)) * 128;
            at_qfrags(qp, r16, q4, qf);
        }
        if (it < 4) at_load<FULL>(Hb, KVb, list, nsel, 3 * it + 4, lane, kaB, vwB);
        at_comp<FULL>(kaC, vwC, qf, 3 * it + 2, nsel, lane, vst, vb, m, l, o);
    }
    at_comp<FULL>(kaA, vwA, qf, 15, nsel, lane, vst, vb, m, l, o);
    AT_FINAL(1);
#undef AT_FINAL
}

__device__ __forceinline__ float relu_i(float x) { const int v = __float_as_int(x); return __int_as_float(v > 0 ? v : 0); }
__device__ __forceinline__ void p2_prompt_item(Ctx& F, int j, int b) {
    const int qb = 255 - j, q0 = qb * 16, rowbase = b * SEQ;
    const int nkeys = q0 + 16, ntile = (nkeys + 63) >> 6;
    int lane = F.lane, w = F.wave, tid = F.tid;
    asm volatile("" : "+v"(lane), "+v"(tid)); asm volatile("" : "+s"(w));
    LAS unsigned char* kbuf = F.lds + RING_OFF;
    LAS unsigned short* list = (LAS unsigned short*)(F.lds + RING_OFF + 32768 + w * 10240);
    LAS unsigned char* vst = F.lds + RING_OFF + 32768 + w * 10240 + 1024;
    float* SCb = WSF(WS_SC) + (size_t)F.bid * (16 * 4096);
    const bf16* Hb = WSB(WS_H) + (size_t)rowbase * LDH;
#ifndef REP_P2
#define REP_P2 0
#endif
    unsigned long long ts_ = PRB_T();
    for (int rp_ = 0; rp_ < 1 + (REP_P2 & 1); ++rp_) {
        const int r = lane & 31, hi = lane >> 5;
#if !IDX_FP8
        const int qg = w & 3, kh = w >> 2;
        float wv[2][16];
#pragma unroll
        for (int s2 = 0; s2 < 2; ++s2) { const f32x4* wp = (const f32x4*)(WSF(WS_WI) + (size_t)(rowbase + q0 + 4 * qg + 2 * s2 + hi) * 16);
#pragma unroll
          for (int j = 0; j < 4; ++j) { const f32x4 t = wp[j]; wv[s2][4 * j] = t[0]; wv[s2][4 * j + 1] = t[1]; wv[s2][4 * j + 2] = t[2]; wv[s2][4 * j + 3] = t[3]; } }
        const int headr = (r & 3) + 4 * (r >> 3);
#else
        float wv[16];
        const int tqr = q0 + 2 * w + ((r >> 2) & 1), headr = (r & 3) + 4 * (r >> 3);
        { const f32x4* wp = (const f32x4*)(WSF(WS_WI) + (size_t)(rowbase + q0 + 2 * w + hi) * 16);
#pragma unroll
          for (int j = 0; j < 4; ++j) { const f32x4 t = wp[j]; wv[4 * j] = t[0]; wv[4 * j + 1] = t[1]; wv[4 * j + 2] = t[2]; wv[4 * j + 3] = t[3]; } }
        const int tql = q0 + 2 * w + hi;
#endif
#if IDX_FP8
        typedef int v8i_t __attribute__((ext_vector_type(8)));
        v8i_t qa[2];
        { const bf16* qsrc = Hb + (size_t)tqr * LDH + HC_QI + headr * 128 + 32 * hi;
#pragma unroll
          for (int sI = 0; sI < 2; ++sI)
#pragma unroll
            for (int c4 = 0; c4 < 4; ++c4) { const v4u wq = *(const v4u*)(qsrc + 64 * sI + 8 * c4);
                int lo = __builtin_amdgcn_cvt_pk_fp8_f32(bflo(wq.x), bfhi(wq.x), 0, false); lo = __builtin_amdgcn_cvt_pk_fp8_f32(bflo(wq.y), bfhi(wq.y), lo, true);
                int hh = __builtin_amdgcn_cvt_pk_fp8_f32(bflo(wq.z), bfhi(wq.z), 0, false); hh = __builtin_amdgcn_cvt_pk_fp8_f32(bflo(wq.w), bfhi(wq.w), hh, true);
                qa[sI][2 * c4] = lo; qa[sI][2 * c4 + 1] = hh; } }
        const unsigned char* K8 = F.ws + WS_KI8 + (size_t)rowbase * 128;
        const int skey = tid >> 3, sch = tid & 7;
        v4u pre = *(const v4u*)(K8 + (size_t)skey * 128 + sch * 16);
        *(LAS v4u*)(kbuf + skey * 128 + ((sch ^ ((skey >> 1) & 7)) * 16)) = pre;
        __syncthreads();
        for (int kt = 0; kt < ntile; ++kt) {
            const bool more = kt + 1 < ntile;
            if (more) pre = *(const v4u*)(K8 + (size_t)(64 * (kt + 1) + skey) * 128 + sch * 16);
            const LAS unsigned char* buf = kbuf + (kt & 1) * 8192;
#pragma unroll
            for (int sub = 0; sub < 2; ++sub) {
                f32x16 c = {};
                const int krow = sub * 32 + r; const LAS unsigned char* kr = buf + krow * 128; const int sw = (krow >> 1) & 7;
#pragma unroll
                for (int sI = 0; sI < 2; ++sI) {
                    const v4u b0 = *(const LAS v4u*)(kr + (((4 * sI + 2 * hi) ^ sw) * 16)), b1 = *(const LAS v4u*)(kr + (((4 * sI + 2 * hi + 1) ^ sw) * 16));
                    const v8i_t kb = {(int)b0.x, (int)b0.y, (int)b0.z, (int)b0.w, (int)b1.x, (int)b1.y, (int)b1.z, (int)b1.w};
                    c = __builtin_amdgcn_mfma_scale_f32_32x32x64_f8f6f4(qa[sI], kb, c, 0, 0, 0, 0x7f7f7f7f, 0, 0x7f7f7f7f);
                }
                float sc = 0.f;
#pragma unroll
                for (int j = 0; j < 16; ++j) sc += wv[j] * fmaxf(c[j], 0.f);
                const int key = 64 * kt + 32 * sub + r;
                __builtin_nontemporal_store(key <= tql ? sc : -INFINITY, &SCb[(2 * w + hi) * 4096 + key]);
            }
            if (more) *(LAS v4u*)(kbuf + ((kt + 1) & 1) * 8192 + skey * 128 + ((sch ^ ((skey >> 1) & 7)) * 16)) = pre;
            __syncthreads();
        }
#else
        bf16x8 qf[2][8];
#pragma unroll
        for (int s2 = 0; s2 < 2; ++s2) { const bf16* qsrc = Hb + (size_t)(q0 + 4 * qg + 2 * s2 + ((r >> 2) & 1)) * LDH + HC_QI + headr * 128 + 8 * hi;
#pragma unroll
          for (int st = 0; st < 8; ++st) qf[s2][st] = *(const bf16x8*)(qsrc + 16 * st); }
        const int ntile2 = (nkeys + 127) >> 7;
        v4u pre[4];
        const int sc_ = tid & 15;
        const bf16* kp[4];
#pragma unroll
        for (int i = 0; i < 4; ++i) kp[i] = Hb + (size_t)((tid + 512 * i) >> 4) * LDH + HC_KI + sc_ * 8;
        unsigned lo_[4];
#pragma unroll
        for (int i = 0; i < 4; ++i) { const int sk = (tid + 512 * i) >> 4; lo_[i] = sk * 256 + ((sc_ ^ (sk & 15)) * 16); }
#pragma unroll
        for (int i = 0; i < 4; ++i) pre[i] = *(const v4u*)(kp[i]);
#pragma unroll
        for (int i = 0; i < 4; ++i) *(LAS v4u*)(kbuf + lo_[i]) = pre[i];
        __syncthreads();
        f32x16 cp = {};
        float* const row0 = SCb + (4 * qg + hi) * 4096 + 64 * kh + r; float* const row1 = row0 + 2 * 4096;
        const int kq0 = q0 + 4 * qg + hi - 64 * kh - r, kq1 = kq0 + 2;
        for (int kt = 0; kt < ntile2; ++kt) {
            const int ktn = min(kt + 1, ntile2 - 1), ktp = max(kt - 1, 0);
#pragma unroll
            for (int i = 0; i < 4; ++i) pre[i] = *(const v4u*)(kp[i] + (size_t)ktn * (128 * LDH));
            const LAS unsigned char* buf = kbuf + (kt & 1) * 32768 + (kh * 64 + r) * 256;
            bf16x8 fr[8];
#pragma unroll
            for (int st = 0; st < 8; ++st) fr[st] = *(const LAS bf16x8*)(buf + (((2 * st + hi) ^ (r & 15)) * 16));
            { float s1 = 0.f;
#pragma unroll
              for (int j = 0; j < 16; ++j) s1 += wv[1][j] * relu_i(cp[j]);
              __builtin_nontemporal_store(128 * ktp + 32 <= kq1 ? s1 : -INFINITY, row1 + 128 * ktp + 32); }
            __builtin_amdgcn_sched_barrier(0);
            f32x16 c0 = {}, c1 = {};
#pragma unroll
            for (int st = 0; st < 8; ++st) c0 = __builtin_amdgcn_mfma_f32_32x32x16_bf16(qf[0][st], fr[st], c0, 0, 0, 0);
            __builtin_amdgcn_sched_barrier(0);
#pragma unroll
            for (int st = 0; st < 8; ++st) c1 = __builtin_amdgcn_mfma_f32_32x32x16_bf16(qf[1][st], fr[st], c1, 0, 0, 0);
            { float s0 = 0.f;
#pragma unroll
              for (int j = 0; j < 16; ++j) s0 += wv[0][j] * relu_i(c0[j]);
#pragma unroll
              for (int g = 0; g < 8; ++g) { __builtin_amdgcn_sched_group_barrier(0x008, 1, 0); __builtin_amdgcn_sched_group_barrier(0x002, 4, 0); }
              __builtin_nontemporal_store(128 * kt <= kq0 ? s0 : -INFINITY, row0 + 128 * kt); }
            __builtin_amdgcn_sched_barrier(0);
#pragma unroll
            for (int st = 0; st < 8; ++st) fr[st] = *(const LAS bf16x8*)(buf + 32 * 256 + (((2 * st + hi) ^ (r & 15)) * 16));
            { float s1 = 0.f;
#pragma unroll
              for (int j = 0; j < 16; ++j) s1 += wv[1][j] * relu_i(c1[j]);
              __builtin_nontemporal_store(128 * kt <= kq1 ? s1 : -INFINITY, row1 + 128 * kt); }
            __builtin_amdgcn_sched_barrier(0);
#pragma unroll
            for (int j = 0; j < 16; ++j) { c0[j] = 0.f; c1[j] = 0.f; }
#pragma unroll
            for (int st = 0; st < 8; ++st) c0 = __builtin_amdgcn_mfma_f32_32x32x16_bf16(qf[0][st], fr[st], c0, 0, 0, 0);
            __builtin_amdgcn_sched_barrier(0);
#pragma unroll
            for (int st = 0; st < 8; ++st) c1 = __builtin_amdgcn_mfma_f32_32x32x16_bf16(qf[1][st], fr[st], c1, 0, 0, 0);
            { float s0 = 0.f;
#pragma unroll
              for (int j = 0; j < 16; ++j) s0 += wv[0][j] * relu_i(c0[j]);
#pragma unroll
              for (int g = 0; g < 8; ++g) { __builtin_amdgcn_sched_group_barrier(0x008, 1, 0); __builtin_amdgcn_sched_group_barrier(0x002, 4, 0); }
              __builtin_nontemporal_store(128 * kt + 32 <= kq0 ? s0 : -INFINITY, row0 + 128 * kt + 32); }
            cp = c1;
            __builtin_amdgcn_sched_barrier(0);
            { LAS unsigned char* nb = kbuf + ((kt + 1) & 1) * 32768;
#pragma unroll
              for (int i = 0; i < 4; ++i) *(LAS v4u*)(nb + lo_[i]) = pre[i]; }
            __syncthreads();
        }
        { float s1 = 0.f;
#pragma unroll
          for (int j = 0; j < 16; ++j) s1 += wv[1][j] * relu_i(cp[j]);
          __builtin_nontemporal_store(128 * (ntile2 - 1) + 32 <= kq1 ? s1 : -INFINITY, row1 + 128 * (ntile2 - 1) + 32); }
#endif
    }
    __syncthreads();
    PRB_ADD(9, ts_);
    static_assert(ATT_FP8 == 1, "the second selection list sits behind the fp8 V staging tile");
    LAS unsigned short* listB = (LAS unsigned short*)(F.lds + RING_OFF + 32768 + w * 10240 + 5632);
    int nsA = 0, nsB = 0;
#pragma unroll 1
    for (int stp = 0; stp < 4; ++stp) {
        ts_ = PRB_T();
        const int isatt = (w & 1) ? (stp >> 1) : (stp & 1), qq = (w & 1) ? (stp & 1) : (stp >> 1);
        LAS unsigned short* lst = qq ? listB : list;
        const int ql = 2 * w + qq, t = q0 + ql, n = t + 1;
        if (!isatt) {
            int nsel;
            if (n <= 256) {
#pragma unroll
                for (int j = 0; j < 4; ++j) lst[lane + 64 * j] = (unsigned short)(lane + 64 * j);
                LDS_WAIT(); nsel = n;
            } else {
#define SEL_W(NR) do { float s[NR]; int ln = lane; asm volatile("" : "+v"(ln));     \
                _Pragma("unroll") for (int i = 0; i < NR; ++i) { const float v = __builtin_nontemporal_load(&SCb[ql * 4096 + i * 64 + lane]); s[i] = (ln <= t - i * 64) ? v : -INFINITY; } \
                asm volatile("s_waitcnt vmcnt(0)" ::: "memory"); \
                if (PROBE_ID >= 0) { PRB_ADD(14, ts_); ts_ = PRB_T(); } \
                wave_select256<NR>(s, n, lane, lst, (LAS unsigned*)vst); } while (0)
                if (n <= 1024) SEL_W(16); else if (n <= 2048) SEL_W(32); else if (n <= 3072) SEL_W(48); else SEL_W(64);
#undef SEL_W
                nsel = 256;
            }
            if (qq) nsB = nsel; else nsA = nsel;
            PRB_ADD(10, ts_);
        } else {
            const int nsel = qq ? nsB : nsA;
            asm volatile("" : "+v"(lane) :: "memory"); __builtin_amdgcn_sched_barrier(0);
            if (nsel == 256) attn_prompt_query<true>(Hb, F.ws + WS_KV8 + (size_t)rowbase * 512, t, WSB(WS_OAB) + (size_t)(rowbase + t) * DM, lst, nsel, vst, lane);
            else attn_prompt_query<false>(Hb, F.ws + WS_KV8 + (size_t)rowbase * 512, t, WSB(WS_OAB) + (size_t)(rowbase + t) * DM, lst, nsel, vst, lane);
            PRB_ADD(11, ts_);
        }
    }
}
__device__ __forceinline__ void p2_gmlp_item(Ctx& F, const In& I, int item) {
    int lane = F.lane, w = F.wave, tid = F.tid; const int c = item >> 3, g = item & 7, r0 = c * 128;
    asm volatile("" : "+v"(lane), "+v"(tid)); asm volatile("" : "+s"(w));
    LAS unsigned char* tile = F.lds + RING_OFF;
    LAS float* smu = (LAS float*)(F.lds + RING_OFF + 36864); LAS float* srs = smu + 128;
    v4u pre[4];
#pragma unroll
    for (int i = 0; i < 4; ++i) { const int p = tid + 512 * i, row = p >> 4, ch = p & 15; pre[i] = *(const v4u*)(WSB(WS_H) + (size_t)(r0 + row) * LDH + HC_VB + g * 128 + ch * 8); }
    if (tid < 128) { const f32x4* ps = (const f32x4*)(WSF(WS_PSV) + (size_t)(r0 + tid) * 32); float s1 = 0.f, s2 = 0.f;
#pragma unroll
        for (int j = 0; j < 8; ++j) { const f32x4 v = ps[j]; s1 += v[0] + v[2]; s2 += v[1] + v[3]; }
        const float mu = s1 * (1.f / 1024.f), var = fmaxf(s2 * (1.f / 1024.f) - mu * mu, 0.f);
        smu[tid] = mu; srs[tid] = 1.0f / sqrtf(var + LN_EPS); }
#pragma unroll
    for (int i = 0; i < 4; ++i) { const int p = tid + 512 * i, row = p >> 4, ch = p & 15; *(LAS v4u*)(tile + row * 288 + ch * 16) = pre[i]; }
    __syncthreads();
    const int i16 = lane & 15, q4 = lane >> 4, t = 16 * w + i16, nks = (w >> 1) + 1;
    const bf16* hrow = WSB(WS_H) + (size_t)(r0 + t) * LDH;
    f32x4 lgv[8], lbv[8]; v2u uuv[8], zzv[8];
#pragma unroll
    for (int db = 0; db < 8; ++db) { const int ch0 = g * 128 + db * 16 + 4 * q4;
        lgv[db] = *(const f32x4*)(I.lng + ch0); lbv[db] = *(const f32x4*)(I.lnb + ch0); uuv[db] = *(const v2u*)(hrow + HC_U + ch0); zzv[db] = *(const v2u*)(hrow + HC_ZB + ch0); }
    const float bt = I.bsp[g * 128 + t];
    f32x4 w0v[4], w1v[4];
#pragma unroll
    for (int ks = 0; ks < 4; ++ks) { const float* wrow = I.wsp + ((size_t)(g * 128 + t) * 128 + 32 * ks + 8 * q4); w0v[ks] = *(const f32x4*)wrow; w1v[ks] = *(const f32x4*)(wrow + 4); }
    __builtin_amdgcn_sched_barrier(0);
    f32x4 acc[8];
#pragma unroll
    for (int db = 0; db < 8; ++db) acc[db] = (f32x4){0.f, 0.f, 0.f, 0.f};
    float c1 = 0.f, c2 = 0.f;
#pragma unroll
    for (int ks = 0; ks < 4; ++ks) if (ks < nks) {
        const int s0 = 32 * ks + 8 * q4;
        const f32x4 w0 = w0v[ks], w1 = w1v[ks];
        float wv[8] = {w0[0], w0[1], w0[2], w0[3], w1[0], w1[1], w1[2], w1[3]};
#pragma unroll
        for (int j = 0; j < 8; ++j) { const int s = s0 + j; const float x = (s <= t) ? wv[j] : 0.f; c2 += x; const float xp = x * srs[s]; c1 += xp * smu[s]; wv[j] = xp; }
        const bf16x8 wf = cvt8((f32x4){wv[0], wv[1], wv[2], wv[3]}, (f32x4){wv[4], wv[5], wv[6], wv[7]});
        const LAS unsigned char* vb = tile + (32 * ks + 8 * q4 + (i16 >> 2)) * 288 + (i16 & 3) * 8;
#pragma unroll
        for (int db = 0; db < 8; ++db) {
            const s16x4 lo = __builtin_bit_cast(s16x4, __builtin_amdgcn_ds_read_tr16_b64_v4i16((LAS s16x4*)(vb + db * 32)));
            const s16x4 hi = __builtin_bit_cast(s16x4, __builtin_amdgcn_ds_read_tr16_b64_v4i16((LAS s16x4*)(vb + 4 * 288 + db * 32)));
            const bf16x8 vf = {lo[0], lo[1], lo[2], lo[3], hi[0], hi[1], hi[2], hi[3]};
            acc[db] = __builtin_amdgcn_mfma_f32_16x16x32_bf16(vf, wf, acc[db], 0, 0, 0);
        }
    }
    c1 = xrows_add(c1); c2 = xrows_add(c2);
    bf16* orow = WSB(WS_OAB) + (size_t)(r0 + t) * DM + 1024;
#pragma unroll
    for (int db = 0; db < 8; ++db) { const int ch0 = g * 128 + db * 16 + 4 * q4;
        const f32x4 lg = lgv[db], lb = lbv[db];
        const v2u uu = uuv[db], zz = zzv[db];
        float mx[4];
#pragma unroll
        for (int r = 0; r < 4; ++r) mx[r] = lg[r] * (acc[db][r] - c1) + lb[r] * c2 + bt;
        v2u ww; ww.x = cvtpk(bflo(uu.x) * mx[0] * bflo(zz.x), bfhi(uu.x) * mx[1] * bfhi(zz.x)); ww.y = cvtpk(bflo(uu.y) * mx[2] * bflo(zz.y), bfhi(uu.y) * mx[3] * bfhi(zz.y));
        *(v2u*)(orow + ch0) = ww; }
}
__device__ __forceinline__ void p2_sscore_item(Ctx& F, const In& I, int item) {
    int lane = F.lane, w = F.wave; asm volatile("" : "+v"(lane)); asm volatile("" : "+s"(w));
    const int s = item >> 4, page = (item & 15) * 8 + w, r16 = lane & 15, q4 = lane >> 4;
    const float* hs = WSF(WS_HS) + (size_t)s * LDH;
    bf16x8 qf[4];
#pragma unroll
    for (int st = 0; st < 4; ++st) { const float* p = hs + HC_QI + r16 * 128 + st * 32 + 8 * q4; qf[st] = cvt8(*(const f32x4*)p, *(const f32x4*)(p + 4)); }
    const f32x4 wv = *(const f32x4*)(hs + HC_WI + 4 * q4);
    const int phys = I.pt[s * NPAGES + page];
    const float* kb = I.cki + (size_t)phys * PAGE * 128;
#pragma unroll 1
    for (int g2 = 0; g2 < 8; g2 += 4) {
        f32x4 x[4][4][2];
#pragma unroll
        for (int u = 0; u < 4; ++u) { const float* kp = kb + (size_t)((g2 + u) * 16 + r16) * 128 + 8 * q4;
#pragma unroll
            for (int st = 0; st < 4; ++st) { x[u][st][0] = __builtin_nontemporal_load((const f32x4*)(kp + 32 * st)); x[u][st][1] = __builtin_nontemporal_load((const f32x4*)(kp + 32 * st + 4)); } }
        __builtin_amdgcn_sched_barrier(0);
#pragma unroll
        for (int u = 0; u < 4; ++u) {
            f32x4 c = {0.f, 0.f, 0.f, 0.f};
#pragma unroll
            for (int st = 0; st < 4; ++st) c = __builtin_amdgcn_mfma_f32_16x16x32_bf16(qf[st], cvt8(x[u][st][0], x[u][st][1]), c, 0, 0, 0);
            float v = wv[0] * fmaxf(c[0], 0.f) + wv[1] * fmaxf(c[1], 0.f) + wv[2] * fmaxf(c[2], 0.f) + wv[3] * fmaxf(c[3], 0.f);
            v = xrows_add(v);
            if (lane < 16) __hip_atomic_store(WSF(WS_SSC) + (size_t)s * SSC_LD + page * 128 + (g2 + u) * 16 + lane, v, __ATOMIC_RELAXED, __HIP_MEMORY_SCOPE_AGENT);
        }
    }
}

__device__ __forceinline__ void p3_sample_item(Ctx& F, const In& I, int s) {
    int lane = F.lane, w = F.wave, tid = F.tid; asm volatile("" : "+v"(lane), "+v"(tid)); asm volatile("" : "+s"(w));
    const int r16 = lane & 15, q4 = lane >> 4;
    LAS unsigned short* cand = (LAS unsigned short*)(F.lds + RING_OFF);
    LAS unsigned short* fin = (LAS unsigned short*)(F.lds + RING_OFF + 5120);
    LAS unsigned short* tmp = (LAS unsigned short*)(F.lds + RING_OFF + 5760);
    LAS float* snew = (LAS float*)(F.lds + RING_OFF + 6400);
    LAS float* comb = (LAS float*)(F.lds + RING_OFF + 8192);
    LAS unsigned char* vst = F.lds + RING_OFF + 32768 + w * 9216;
    const float* hs = WSF(WS_HS) + (size_t)s * LDH;
    float* ssc = WSF(WS_SSC) + (size_t)s * SSC_LD;
    if (w == 0) {
        const int h = lane >> 2, part = lane & 3; float d = 0.f;
        const float* qp = hs + HC_QI + h * 128 + part * 32; const float* kp = hs + HC_KI + part * 32;
#pragma unroll
        for (int j = 0; j < 32; ++j) d += bf2f((unsigned short)f2bf(qp[j])) * bf2f((unsigned short)f2bf(kp[j]));
        d += dppf<0xB1>(d); d += dppf<0x4E>(d);
        float cn = (part == 0) ? hs[HC_WI + h] * fmaxf(d, 0.f) : 0.f;
        cn = wave_sum(cn);
        if (lane == 0) { snew[0] = cn; ssc[PAST] = cn; }
    }
    {
        float sv[32];
#pragma unroll
        for (int i = 0; i < 32; ++i) sv[i] = ssc[w * 2048 + i * 64 + lane];
        wave_select256<32>(sv, 2048, lane, cand + w * 320, (LAS unsigned*)vst);
    }
    __syncthreads();
    if (w == 0) {
        float sv[33];
#pragma unroll
        for (int i = 0; i < 32; ++i) { const int cidx = i * 64 + lane; const int key = (cidx >> 8) * 2048 + cand[(cidx >> 8) * 320 + (cidx & 255)]; sv[i] = ssc[key]; }
        sv[32] = lane == 0 ? snew[0] : -INFINITY;
        wave_select256<33>(sv, 2049, lane, tmp, (LAS unsigned*)vst);
#pragma unroll
        for (int j = 0; j < 4; ++j) { const int slot = tmp[lane + 64 * j]; fin[lane + 64 * j] = (unsigned short)(slot >= 2048 ? PAST : (slot >> 8) * 2048 + cand[(slot >> 8) * 320 + (slot & 255)]); }
        LDS_WAIT();
    }
    __syncthreads();
    {
        const int g = w & 1, part = w >> 1;
        RowSrc R; R.Hb = nullptr; R.ck = I.ck; R.cv = I.cv; R.pt = I.pt + s * NPAGES; R.knew = F.out + O_KS + s * 256; R.vnew = F.out + O_VS + s * 256;
        bf16x8 qf[4]; const bf16x8 z = {0, 0, 0, 0, 0, 0, 0, 0};
        const float* qp = hs + HC_Q + (g * 4 + (r16 & 3)) * 128 + 8 * q4;
#pragma unroll
        for (int st = 0; st < 4; ++st) { qf[st] = cvt8(*(const f32x4*)(qp + 32 * st), *(const f32x4*)(qp + 32 * st + 4)); if (r16 >= 4) qf[st] = z; }
        float m, l; f32x4 o[8];
        attn_part<true>(R, g, fin, part * 64, 2, 256, vst, qf, m, l, o, lane);
        LAS float* cw = comb + w * 520;
        if (r16 < 4) {
            if (q4 == 0) { cw[r16] = m; cw[4 + r16] = l; }
#pragma unroll
            for (int db = 0; db < 8; ++db)
#pragma unroll
                for (int r = 0; r < 4; ++r) cw[8 + (db * 16 + 4 * q4 + r) * 4 + r16] = o[db][r];
        }
    }
    __syncthreads();
    for (int e = tid; e < 1024; e += 512) {
        const int hh = e >> 7, d = e & 127, g = hh >> 2, h = hh & 3;
        float M = -1e30f;
#pragma unroll
        for (int p = 0; p < 4; ++p) M = fmaxf(M, comb[(g + 2 * p) * 520 + h]);
        float num = 0.f, den = 0.f;
#pragma unroll
        for (int p = 0; p < 4; ++p) { const LAS float* cw = comb + (g + 2 * p) * 520; const float f = __builtin_amdgcn_exp2f(cw[h] - M); num += cw[8 + d * 4 + h] * f; den += cw[4 + h] * f; }
        const float v = num / den * hs[HC_ZA + hh * 128 + d];
        WSB(WS_OABS)[(size_t)s * DM + hh * 128 + d] = (bf16)f2bf(v);
    }
    if (w == 1) {
        float x[16]; float sum = 0.f;
#pragma unroll
        for (int j = 0; j < 16; ++j) { x[j] = hs[HC_VB + lane + 64 * j]; sum += x[j]; }
        const float mu = wave_sum(sum) * (1.f / 1024.f); float qv = 0.f;
#pragma unroll
        for (int j = 0; j < 16; ++j) { const float d = x[j] - mu; qv += d * d; }
        const float rs = 1.0f / sqrtf(wave_sum(qv) * (1.f / 1024.f) + LN_EPS);
#pragma unroll
        for (int j = 0; j < 16; ++j) { const int ch = lane + 64 * j, g = ch >> 7;
            const float vn = (x[j] - mu) * rs * I.lng[ch] + I.lnb[ch];
            F.out[O_GV + s * 1024 + ch] = vn;
            const float ob = hs[HC_U + ch] * (I.wsp[(size_t)g * 128 * 128] * vn + I.bsp[g * 128]) * hs[HC_ZB + ch];
            WSB(WS_OABS)[(size_t)s * DM + 1024 + ch] = (bf16)f2bf(ob); }
    }
    __syncthreads();
}

__global__ void __launch_bounds__(512, 2) mk_fwd(Args args) {
    extern __shared__ __attribute__((aligned(16))) unsigned char lds_raw[];
    Ctx F;
    F.lds = (LAS unsigned char*)lds_raw;
    F.tid = threadIdx.x; F.lane = F.tid & 63; F.wave = __builtin_amdgcn_readfirstlane(F.tid >> 6); F.G = gridDim.x; F.bid = blockIdx.x;
    F.out = args.out; F.ws = args.ws;
    volatile LAS unsigned* MISC = (volatile LAS unsigned*)(F.lds + MISC_OFF);
    for (int u = F.tid; u < (LDS_BYTES - LDSCTL_OFF) / 4; u += 512) ((LAS unsigned*)(F.lds + LDSCTL_OFF))[u] = 0u;
    __syncthreads();
    XcdBarrier bar; bar.bar = (unsigned*)(((gu32*)(F.ws + WS_CTL)) + CW_BAR); bar.x = 0; bar.st = nullptr;
    if (MK_N_LAUNCHES == 1) bar = xcd_barrier_post((unsigned*)(((gu32*)(F.ws + WS_CTL)) + CW_BAR), MISC + 8);
    const int lo = args.ph_lo, hi = args.ph_hi;
#ifndef PH_MASK
#define PH_MASK 0x7f
#endif
#define IN(k) (((PH_MASK >> (k)) & 1) && lo <= (k) && (k) < hi)
#define SEAM(k) do { if (IN(k) && IN((k) + 1)) xcd_barrier(bar); } while (0)
#ifndef REP_MASK
#define REP_MASK 0
#endif
#define REPS(k) for (int rep_ = 0; rep_ < 1 + ((REP_MASK >> (k)) & 1); ++rep_, ((REP_MASK >> (k)) & 1) && rep_ == 1 ? (xcd_barrier(bar), 0) : 0)

    unsigned long long tp_ = PRB_T(); const unsigned long long tk0_ = tp_;
    if (IN(0)) REPS(0) { In I{}; I.win = (const float*)args.in[7]; I.wpa = (const float*)args.in[8]; I.wpb = (const float*)args.in[9]; I.wo = (const float*)args.in[10]; I.xp = (const float*)args.in[0]; I.xs = (const float*)args.in[1]; I.gin = (const float*)args.in[6]; p0_prologue(F, I); }
    PRB_ADD(0, tp_);
    SEAM(0); PRB_ADD(16, tp_); tp_ = PRB_T();
    if (IN(1)) REPS(1) {
        const int ntl_ = (MP / 256) * (LDH / 256), rem_ = ntl_ % F.G;
        const bool tail_ = rem_ != 0 && F.G - rem_ >= 16;
        if (!tail_) p1_sample_finish(F, (const float*)args.in[1], 0, F.G);
        pg8::Gemm g{WSB(WS_XN), WSB(WS_XN), WSB(WS_WTIN), WSB(WS_WTIN), DM, DM, DM}; pg8::StaticOrder S; S.init(MP, LDH, F.G, F.bid);
        pg8::EpiInProj E{WSB(WS_H), F.out, WSF(WS_WI), F.ws + WS_KV8, F.ws + WS_KI8, WSF(WS_PSV)};
        pg8::gemm_phase<pg8::EpiInProj, pg8::StaticOrder, true, true>(F.lds + RING_OFF, g, S, E);
        if (tail_ && F.bid >= rem_) { __syncthreads(); p1_sample_finish(F, (const float*)args.in[1], rem_, F.G - rem_); }
    }
    PRB_ADD(1, tp_);
    SEAM(1); PRB_ADD(17, tp_); tp_ = PRB_T();
    if (IN(2)) REPS(2) {
        In I{}; I.wpa = (const float*)args.in[8]; I.wpb = (const float*)args.in[9]; I.wo = (const float*)args.in[10]; I.cki = (const float*)args.in[4]; I.pt = (const int*)args.in[5]; I.lng = (const float*)args.in[11]; I.lnb = (const float*)args.in[12]; I.wsp = (const float*)args.in[13]; I.bsp = (const float*)args.in[14];
        LAS int* slot = (LAS int*)(F.lds + LDSCTL_OFF);
        unsigned* qh = (unsigned*)(((gu32*)(F.ws + WS_CTL)) + CW_Q2 + 64 * 8 * rep_);
        unsigned* sdone = (unsigned*)(((gu32*)(F.ws + WS_CTL)) + CW_SDONE + 64 * 8 * rep_);
        const int pb = (int)(xb_xcc_id() & 1u);
        const bool stat_ = (F.G >= 128);
        int stage = stat_ ? 2 : 0, pre_ = (stat_ && F.bid < 128) ? 0 : 2;
        for (int par_ = 0;; par_ ^= 1) {
            int item, st_;
            if (pre_ >= 2 && F.tid == 0) {
                int st = stage, it = -1;
                for (; st < 6; ++st) {
                    const int q = (st == 0) ? 3 : (st == 1 ? 4 : (st == 4 ? 2 : (st == 5 ? 5 : (st == 2 ? pb : (pb ^ 1)))));
                    const int lim = (st == 0) ? 128 : (st == 1 ? NS : (st == 4 ? 512 : 256));
                    const int v = (int)__hip_atomic_fetch_add(qh + 64 * q, 1u, __ATOMIC_RELAXED, __HIP_MEMORY_SCOPE_AGENT);
                    if (v < lim) { it = v; break; }
                }
                slot[2 * par_] = it; slot[2 * par_ + 1] = st;
            }
            __syncthreads();
            if (pre_ < 2) {
                item = F.bid; st_ = pre_;
                pre_ = (pre_ == 0 && F.bid < NS) ? 1 : 2;
            } else {
                item = __builtin_amdgcn_readfirstlane(slot[2 * par_]); stage = __builtin_amdgcn_readfirstlane(slot[2 * par_ + 1]); st_ = stage;
                if (item < 0) break;
            }
            if (st_ == 0) {
                const unsigned long long tq_ = PRB_T(); p2_sscore_item(F, I, item);
                asm volatile("s_waitcnt vmcnt(0)" ::: "memory"); __syncthreads();
                if (F.tid == 0) __hip_atomic_fetch_add(sdone + 64 * (item >> 4), 1u, __ATOMIC_RELAXED, __HIP_MEMORY_SCOPE_AGENT);
                PRB_ADD(13, tq_);
            } else if (st_ == 1) {
                const unsigned long long tq_ = PRB_T();
                if (F.tid == 0) { unsigned sp = 0; while (__hip_atomic_load(sdone + 64 * item, __ATOMIC_RELAXED, __HIP_MEMORY_SCOPE_AGENT) < 16u) { __builtin_amdgcn_s_sleep(8); if (++sp > (1u << 22)) break; }
                    __builtin_amdgcn_fence(__ATOMIC_ACQUIRE, "agent"); asm volatile("s_waitcnt vmcnt(0)" ::: "memory"); }
                __syncthreads();
                In J = I; J.ck = (const float*)args.in[2]; J.cv = (const float*)args.in[3];
                p3_sample_item(F, J, item);
                PRB_ADD(15, tq_);
            } else if (st_ == 4) { const unsigned long long tq_ = PRB_T(); for (int rp_ = 0; rp_ < 1 + ((REP_P2 >> 3) & 1); ++rp_) p2_gmlp_item(F, I, item); PRB_ADD(12, tq_); }
            else if (st_ == 5) p2_wt_item(F, I, item);
            else p2_prompt_item(F, item, st_ == 2 ? pb : (pb ^ 1));
        }
    }
    PRB_ADD(2, tp_);
    SEAM(2); PRB_ADD(8, tp_); tp_ = PRB_T();
    if (IN(3)) REPS(3) {
        if (F.bid < 128) {
            LAS float* red = (LAS float*)(F.lds + RING_OFF);
            const int n0 = 16 * F.bid;
            f32x4 ya, yb; float gav[4], gbv[4];
            {
                const int r = F.lane & 15, q = F.lane >> 4, kbeg = F.wave * 128;
                const bf16* xa = WSB(WS_OABS) + (size_t)(r & 7) * DM + kbeg + 8 * q; const bf16* wa = WSB(WS_WTA) + (size_t)(n0 + r) * 1024 + kbeg + 8 * q; const bf16* wb = WSB(WS_WTB) + (size_t)(n0 + r) * 1024 + kbeg + 8 * q;
                const bf16x8 z = {0, 0, 0, 0, 0, 0, 0, 0};
                bf16x8 a0[4], a1[4], b0[4], b1[4];
#pragma unroll
                for (int j = 0; j < 4; ++j) { const int s_ = (4 * (F.lane >> 4) + j) & 7; gav[j] = WSF(WS_HS)[(size_t)s_ * LDH + HC_GA + n0 + r]; gbv[j] = WSF(WS_HS)[(size_t)s_ * LDH + HC_GB + n0 + r]; }
#pragma unroll
                for (int st = 0; st < 4; ++st) { a0[st] = *(const bf16x8*)(xa + 32 * st); a1[st] = *(const bf16x8*)(xa + 1024 + 32 * st); b0[st] = *(const bf16x8*)(wa + 32 * st); b1[st] = *(const bf16x8*)(wb + 32 * st); }
                __builtin_amdgcn_sched_barrier(0);
                ya = (f32x4){0.f, 0.f, 0.f, 0.f}; yb = ya;
#pragma unroll
                for (int st = 0; st < 4; ++st) { ya = __builtin_amdgcn_mfma_f32_16x16x32_bf16(r >= 8 ? z : a0[st], b0[st], ya, 0, 0, 0); yb = __builtin_amdgcn_mfma_f32_16x16x32_bf16(r >= 8 ? z : a1[st], b1[st], yb, 0, 0, 0); }
                *(LAS f32x4*)(red + (F.wave * 64 + F.lane) * 4) = ya; *(LAS f32x4*)(red + ((8 + F.wave) * 64 + F.lane) * 4) = yb;
                __syncthreads();
                if (F.wave == 0) { ya = (f32x4){0.f, 0.f, 0.f, 0.f}; yb = ya;
#pragma unroll
                    for (int w = 0; w < 8; ++w) { ya += *(LAS f32x4*)(red + (w * 64 + F.lane) * 4); yb += *(LAS f32x4*)(red + ((8 + w) * 64 + F.lane) * 4); } }
            }
            if (F.wave == 0 && F.lane < 32) {
#pragma unroll
                for (int j = 0; j < 4; ++j) { const int s = 4 * (F.lane >> 4) + j, n = n0 + (F.lane & 15);
                    const float v = gav[j] * ya[j] + gbv[j] * yb[j];
                    WSB(WS_MIXS)[(size_t)s * DM + n] = (bf16)f2bf(v); }
            }
            __syncthreads();
        }
        pg8::Gemm g{WSB(WS_OAB), WSB(WS_OAB) + 1024, WSB(WS_WTA), WSB(WS_WTB), DM, 1024, 1024}; pg8::PairOrder S; S.init(MP, DM, F.G, F.bid);
        pg8::EpiMix E{WSB(WS_H), WSB(WS_MIX)};
        pg8::gemm_phase<pg8::EpiMix, pg8::PairOrder, true, true>(F.lds + RING_OFF, g, S, E);
    }
    PRB_ADD(3, tp_);
    SEAM(3); PRB_ADD(19, tp_); tp_ = PRB_T();
    if (IN(4)) REPS(4) {
        if (F.bid < 128) {
            LAS float* red = (LAS float*)(F.lds + RING_OFF);
            const int n0 = 16 * F.bid;
            float xres[4];
#pragma unroll
            for (int j = 0; j < 4; ++j) xres[j] = ((const float*)args.in[1])[(size_t)((4 * (F.lane >> 4) + j) & 7) * DM + n0 + (F.lane & 15)];
            f32x4 y = sgemv_part(WSB(WS_MIXS), DM, WSB(WS_WTO), DM, n0, F.wave * 256, 8, F.lane);
            y = block_reduce8(y, red, F.wave, F.lane);
            if (F.wave == 0 && F.lane < 32) {
#pragma unroll
                for (int j = 0; j < 4; ++j) { const int s = 4 * (F.lane >> 4) + j, n = n0 + (F.lane & 15); WSF(WS_XSO)[(size_t)s * DM + n] = xres[j] + y[j]; }
            }
        }
        __syncthreads();
        pg8::Gemm g{WSB(WS_MIX), WSB(WS_MIX), WSB(WS_WTO), WSB(WS_WTO), DM, DM, DM}; pg8::StaticOrder S; S.init(MP, DM, F.G, F.bid);
        struct BarFn { const XcdBarrier* b; __device__ __forceinline__ void operator()() const { xcd_barrier(*b); } };
        pg8::EpiOut<BarFn> E{(const float*)args.in[0], F.out, WSF(WS_PS), (const float*)args.in[15], BarFn{&bar}, PROBE_ID >= 0 ? (unsigned*)(((gu32*)(F.ws + WS_CTL)) + CW_PROBE + 21) : nullptr, tp_};
        pg8::gemm_phase<pg8::EpiOut<BarFn>, pg8::StaticOrder, false, true>(F.lds + RING_OFF, g, S, E);
        PRB_ADD(20, tk0_);
        const int gw = F.bid * 8 + F.wave, NGW = F.G * 8;
        if (gw >= NGW - NS) { const int sr = gw - (NGW - NS);
            const f32x4* xr = (const f32x4*)(WSF(WS_XSO) + (size_t)sr * DM) + F.lane; const f32x4* gr = (const f32x4*)args.in[15] + F.lane;
            f32x4 v[8]; float s = 0.f;
#pragma unroll
            for (int j = 0; j < 8; ++j) { v[j] = xr[64 * j]; s += (v[j].x * v[j].x + v[j].y * v[j].y) + (v[j].z * v[j].z + v[j].w * v[j].w); }
            const float rstd = 1.0f / sqrtf(wave_sum(s) * (1.f / DM) + RMS_EPS);
            f32x4* o = (f32x4*)(F.out + O_YS + (size_t)sr * DM) + F.lane;
            float prb_ = 1.0f; if (PROBE_ID >= 0) prb_ += (float)PRB_Q(__hip_atomic_load((unsigned*)(((gu32*)(F.ws + WS_CTL)) + CW_PROBE + (PROBE_ID >= 0 ? PROBE_ID : 0)), __ATOMIC_RELAXED, __HIP_MEMORY_SCOPE_AGENT)) * (0.01f / 256.f / 1000.f);
#pragma unroll
            for (int j = 0; j < 8; ++j) o[64 * j] = v[j] * rstd * gr[64 * j] * prb_;
        }

    }
    PRB_ADD(4, tp_);
#undef IN
#undef SEAM
}

extern "C" void kernel_launch(void* const* d_in, const int* in_sizes, int n_in, void* d_out, int out_size, void* d_ws, size_t ws_size, hipStream_t stream) {
    static int grid = 0;
    if (grid == 0) {
        if (n_in != 16 || out_size != (int)O_END || ws_size < WS_END) { fprintf(stderr, "kernel_launch: unexpected shapes: n_in %d out %d ws %zu\n", n_in, out_size, ws_size); grid = -1; return; }
        int dev = 0, cus = 0;
        if (hipGetDevice(&dev) != hipSuccess || hipDeviceGetAttribute(&cus, hipDeviceAttributeMultiprocessorCount, dev) != hipSuccess) { grid = -1; return; }
        if (hipFuncSetAttribute((const void*)mk_fwd, hipFuncAttributeMaxDynamicSharedMemorySize, LDS_BYTES) != hipSuccess) { fprintf(stderr, "kernel_launch: hipFuncSetAttribute failed\n"); grid = -1; return; }
        int per_cu = 0;
        if (hipOccupancyMaxActiveBlocksPerMultiprocessor(&per_cu, (const void*)mk_fwd, 512, LDS_BYTES) != hipSuccess || per_cu < 1) fprintf(stderr, "kernel_launch: occupancy query reports %d\n", per_cu);
        (void)hipGetLastError();
        grid = cus;
        if (grid != 256) fprintf(stderr, "kernel_launch: %d CUs; this kernel is laid out for 256\n", grid);
    }
    if (grid < 0) return;
    (void)hipMemsetAsync((char*)d_ws + WS_CTL, 0, CTL_ZERO_BYTES, stream);
    Args a{};
    for (int i = 0; i < 16; ++i) a.in[i] = d_in[i];
    a.out = (float*)d_out; a.ws = (unsigned char*)d_ws;
    constexpr int NPH = 5;
    if (MK_N_LAUNCHES == 1) { a.ph_lo = 0; a.ph_hi = NPH; a.li = 0; hipLaunchKernelGGL(mk_fwd, dim3(grid), dim3(512), LDS_BYTES, stream, a); }
    else for (int p = 0; p < NPH; ++p) { a.ph_lo = p; a.ph_hi = p + 1; a.li = p; hipLaunchKernelGGL(mk_fwd, dim3(grid), dim3(512), LDS_BYTES, stream, a); }
}
```
